# Optimizing an MI355X kernel written in HIP

```python
import math
import jax
import jax.numpy as jnp
from jax import lax
import numpy as np


D_MODEL = 2048
BATCH = 2
SEQ = 16384
DEPTH = 2

GRID_W = 64
CTX_LEN = 256
N_EVEN = (DEPTH + 1) // 2
N_ODD = DEPTH // 2
NORM_EPS = 1e-6
DIFF_HEADS = 8
DIFF_QK_DIM = 64
DIFF_V_DIM = 2 * DIFF_QK_DIM
DIFF_SCALE = DIFF_QK_DIM ** -0.5
A_WIDTH = DIFF_HEADS * DIFF_V_DIM
Q_COLS = DIFF_HEADS * 2 * DIFF_QK_DIM
ROPE_THETA = 10000.0
ROPE_AXIS_DIM = DIFF_QK_DIM // 2
Q_BLOCK = 128
SUBLN_EPS = 1e-5
SGU_GROUPS = 8
SGU_CHUNK = 128
SGU_CH = 128
B_WIDTH = SGU_GROUPS * SGU_CH
LN_EPS = 1e-5
EVEN_SPLITS = (Q_COLS, 2 * Q_COLS, 2 * Q_COLS + A_WIDTH, 2 * Q_COLS + A_WIDTH + B_WIDTH)
EVEN_IN = 2 * Q_COLS + A_WIDTH + 2 * B_WIDTH
EVEN_OUT = A_WIDTH + B_WIDTH
HYENA_ORDER = 2
HYENA_WIDTH = D_MODEL
SHORT_CONV = 3
FILTER_EMB = 33
FILTER_BANDS = (FILTER_EMB - 1) // 2
FILTER_HIDDEN = 64
DECAY_TARGET = 1e-2
FAST_DECAY_PCT = 0.3
SLOW_DECAY_PCT = 1.5
MAX_DECAY = math.log(DECAY_TARGET) / FAST_DECAY_PCT
MIN_DECAY = math.log(DECAY_TARGET) / SLOW_DECAY_PCT
D_FF = ((8 * D_MODEL + 3 * 256 - 1) // (3 * 256)) * 256

kernel_name = 'hybrid_diffattn_sgu_hyena_block'


def rms_norm(x, g, eps=NORM_EPS):
    x32 = x.astype(jnp.float32)
    y = x32 * lax.rsqrt(jnp.mean(x32 * x32, axis=-1, keepdims=True) + eps)
    return (y * g.astype(jnp.float32)).astype(x.dtype)


def layer_norm(x, g, b, eps=LN_EPS):
    x32 = x.astype(jnp.float32)
    mu = jnp.mean(x32, axis=-1, keepdims=True)
    var = jnp.mean(jnp.square(x32 - mu), axis=-1, keepdims=True)
    y = (x32 - mu) * lax.rsqrt(var + eps)
    return (y * g.astype(jnp.float32) + b.astype(jnp.float32)).astype(x.dtype)


def adaln(cond, w, b):
    m = jax.nn.silu(cond) @ w + b
    parts = jnp.split(m, 6, axis=-1)
    if m.ndim == 2:
        parts = [p[:, None, :] for p in parts]
    return parts


def modulate(h, shift, scale):
    return h * (1.0 + scale) + shift


def swiglu(h, w_gate, w_up, w_down):
    return (jax.nn.silu(h @ w_gate) * (h @ w_up)) @ w_down


def axial_rope_tables(n_tokens):
    rows = n_tokens // GRID_W
    row = jnp.repeat(jnp.arange(rows), GRID_W).astype(jnp.float32)
    col = jnp.tile(jnp.arange(GRID_W), rows).astype(jnp.float32)
    inv = 1.0 / (ROPE_THETA ** (jnp.arange(0, ROPE_AXIS_DIM, 2, dtype=jnp.float32) / ROPE_AXIS_DIM))
    ang_r = row[:, None] * inv
    ang_c = col[:, None] * inv
    return (jnp.cos(ang_r), jnp.sin(ang_r), jnp.cos(ang_c), jnp.sin(ang_c))


def _rotate(x, cos, sin):
    x1, x2 = jnp.split(x, 2, axis=-1)
    return jnp.concatenate([x1 * cos - x2 * sin, x2 * cos + x1 * sin], axis=-1)


def apply_axial_rope(x, tables):
    cr, sr, cc, sc = [t[None, :, None, None, :].astype(x.dtype) for t in tables]
    xr, xc = x[..., :ROPE_AXIS_DIM], x[..., ROPE_AXIS_DIM:]
    return jnp.concatenate([_rotate(xr, cr, sr), _rotate(xc, cc, sc)], axis=-1)


def diff_attend(q, k, v, lam):
    s = jnp.einsum('bqhmd,bkhmd->bhmqk', q, k).astype(jnp.float32) * DIFF_SCALE
    p = jax.nn.softmax(s, axis=-1)
    w = (p[:, :, 0] - lam * p[:, :, 1]).astype(v.dtype)
    return jnp.einsum('bhqk,bkhe->bqhe', w, v)


def diff_attention_blocked(q, k, v, lam):
    b, s = q.shape[0], q.shape[1]
    nblk = s // Q_BLOCK
    qb = q.reshape(b, nblk, Q_BLOCK, DIFF_HEADS, 2, DIFF_QK_DIM).swapaxes(0, 1)
    ob = lax.map(lambda qq: diff_attend(qq, k, v, lam), qb)
    return ob.swapaxes(0, 1).reshape(b, s, DIFF_HEADS, DIFF_V_DIM)


def diff_post(o, subln_g, lam_init):
    b, l = o.shape[0], o.shape[1]
    o = rms_norm(o, subln_g, eps=SUBLN_EPS) * (1.0 - lam_init)
    return o.reshape(b, l, A_WIDTH)


def spatial_gating(u, vg, norm_g, norm_b, w_s, b_s):
    b, l = u.shape[0], u.shape[1]
    n = l // SGU_CHUNK
    vv = layer_norm(vg.reshape(b, n, SGU_CHUNK, SGU_GROUPS, SGU_CH), norm_g, norm_b)
    mixed = jnp.einsum('gpq,bnqgc->bnpgc', w_s, vv) + b_s.T[:, :, None]
    return u * mixed.reshape(b, l, B_WIDTH)


def even_mixer(h_ctx, h_lat, w_in, w_out, lam_params, subln_g, sgu_norm_g, sgu_norm_b, sgu_w, sgu_b, layer_idx, need_ctx):
    lam_init = 0.8 - 0.6 * math.exp(-0.3 * layer_idx)
    lp = lam_params.astype(jnp.float32)
    lam = jnp.exp(jnp.sum(lp[0] * lp[1])) - jnp.exp(jnp.sum(lp[2] * lp[3])) + lam_init
    b, s = h_lat.shape[0], h_lat.shape[1]
    n_ctx = h_ctx.shape[1]
    q_l, k_l, v_l, u_l, g_l = jnp.split(h_lat @ w_in, EVEN_SPLITS, axis=-1)
    rope = axial_rope_tables(s)
    q_l = apply_axial_rope(q_l.reshape(b, s, DIFF_HEADS, 2, DIFF_QK_DIM), rope)
    k_l = apply_axial_rope(k_l.reshape(b, s, DIFF_HEADS, 2, DIFF_QK_DIM), rope)
    v_l = v_l.reshape(b, s, DIFF_HEADS, DIFF_V_DIM)
    if need_ctx:
        q_c, k_c, v_c, u_c, g_c = jnp.split(h_ctx @ w_in, EVEN_SPLITS, axis=-1)
    else:
        k_c, v_c = jnp.split(h_ctx @ w_in[:, Q_COLS:2 * Q_COLS + A_WIDTH], [Q_COLS], axis=-1)
    k_c = k_c.reshape(b, n_ctx, DIFF_HEADS, 2, DIFF_QK_DIM)
    v_c = v_c.reshape(b, n_ctx, DIFF_HEADS, DIFF_V_DIM)
    k_all = jnp.concatenate([k_c, k_l], axis=1)
    v_all = jnp.concatenate([v_c, v_l], axis=1)
    a_l = diff_post(diff_attention_blocked(q_l, k_all, v_all, lam), subln_g, lam_init)
    s_l = spatial_gating(jax.nn.gelu(u_l), jax.nn.gelu(g_l), sgu_norm_g, sgu_norm_b, sgu_w, sgu_b)
    y_lat = jnp.concatenate([a_l, s_l], axis=-1) @ w_out
    y_ctx = None
    if need_ctx:
        q_c = q_c.reshape(b, n_ctx, DIFF_HEADS, 2, DIFF_QK_DIM)
        a_c = diff_post(diff_attend(q_c, k_c, v_c, lam), subln_g, lam_init)
        s_c = spatial_gating(jax.nn.gelu(u_c), jax.nn.gelu(g_c), sgu_norm_g, sgu_norm_b, sgu_w, sgu_b)
        y_ctx = jnp.concatenate([a_c, s_c], axis=-1) @ w_out
    return y_ctx, y_lat


def short_conv(z, w, b):
    l = z.shape[1]
    half = SHORT_CONV // 2
    zp = jnp.pad(z, ((0, 0), (half, half), (0, 0)))
    y = b
    for j in range(SHORT_CONV):
        y = y + zp[:, j:j + l] * w[j]
    return y


def hyena_filters(l, w1, b1, w2, b2, w3, b3, freq, w4):
    f32 = jnp.float32
    t = jnp.linspace(0.0, 1.0, l, dtype=f32)[:, None]
    w = 2.0 * math.pi * jnp.arange(l, dtype=f32)[:, None] / l
    f = jnp.linspace(1e-4, FILTER_BANDS - 1, FILTER_BANDS, dtype=f32)[None, :]
    feats = jnp.concatenate([t, jnp.cos(f * w), -jnp.sin(f * w)], axis=-1)
    fr = freq.astype(f32)
    h = jnp.sin(fr[0] * (feats @ w1.astype(f32) + b1.astype(f32)))
    h = jnp.sin(fr[1] * (h @ w2.astype(f32) + b2.astype(f32)))
    h = jnp.sin(fr[2] * (h @ w3.astype(f32) + b3.astype(f32)))
    h = (h @ w4.astype(f32)).reshape(l, HYENA_ORDER, 2, HYENA_WIDTH)
    deltas = jnp.abs(jnp.linspace(MIN_DECAY, MAX_DECAY, HYENA_WIDTH, dtype=f32))
    h = h * jnp.exp(-t * deltas)[:, None, None, :]
    fwd, bwd = h[:, :, 0], h[:, :, 1]
    k2 = jnp.concatenate([fwd, jnp.zeros((1, HYENA_ORDER, HYENA_WIDTH), f32), bwd[1:][::-1]], axis=0)
    k2 = k2 / jnp.sum(jnp.abs(k2), axis=0, keepdims=True)
    return jnp.fft.rfft(k2, axis=0)


def fft_conv(z, kf):
    l = z.shape[1]
    zf = jnp.fft.rfft(z.astype(jnp.float32), n=2 * l, axis=1)
    y = jnp.fft.irfft(zf * kf[None], n=2 * l, axis=1)[:, :l]
    return y.astype(z.dtype)


def hyena_mixer(h, w_in, conv_w, conv_b, fw1, fb1, fw2, fb2, fw3, fb3, ffreq, fw4, fbias, w_out):
    l = h.shape[1]
    v, x1, x2 = jnp.split(short_conv(h @ w_in, conv_w, conv_b), 3, axis=-1)
    kf = hyena_filters(l, fw1, fb1, fw2, fb2, fw3, fb3, ffreq, fw4)
    y = v
    for n, gate in enumerate((x1, x2)):
        y = gate * (fft_conv(y, kf[:, n]) + y * fbias[n])
    return y @ w_out


def setup_inputs(seed: int = 0) -> dict:
    key = jax.random.key(seed)
    ks = iter(jax.random.split(key, 40))
    f32 = jnp.float32

    def nrm(shape, scale):
        return jax.random.normal(next(ks), shape, f32) * scale

    D = D_MODEL
    return {
        'x': nrm((BATCH, SEQ, D), 1.0),
        'c': nrm((BATCH, D), 1.0),
        'ctx': nrm((BATCH, CTX_LEN, D), 1.0),
        'c_ctx': nrm((D,), 1.0),
        'ada_w': nrm((DEPTH, D, 6 * D), 0.5 * D ** -0.5),
        'ada_b': nrm((DEPTH, 6 * D), 0.01),
        'norm1': 1.0 + nrm((DEPTH, D), 0.02),
        'norm2': 1.0 + nrm((DEPTH, D), 0.02),
        'ffn_w_gate': nrm((DEPTH, D, D_FF), D ** -0.5),
        'ffn_w_up': nrm((DEPTH, D, D_FF), D ** -0.5),
        'ffn_w_down': nrm((DEPTH, D_FF, D), D_FF ** -0.5),
        'e_w_in': nrm((N_EVEN, D, EVEN_IN), D ** -0.5),
        'e_w_out': nrm((N_EVEN, EVEN_OUT, D), EVEN_OUT ** -0.5),
        'e_lambda': nrm((N_EVEN, 4, DIFF_QK_DIM), 0.1),
        'e_subln': 1.0 + nrm((N_EVEN, DIFF_V_DIM), 0.02),
        'e_sgu_norm_g': 1.0 + nrm((N_EVEN, SGU_GROUPS, SGU_CH), 0.02),
        'e_sgu_norm_b': nrm((N_EVEN, SGU_GROUPS, SGU_CH), 0.02),
        'e_sgu_w': nrm((N_EVEN, SGU_GROUPS, SGU_CHUNK, SGU_CHUNK), SGU_CHUNK ** -0.5),
        'e_sgu_b': 1.0 + nrm((N_EVEN, SGU_GROUPS, SGU_CHUNK), 0.02),
        'o_w_in': nrm((N_ODD, D, 3 * HYENA_WIDTH), D ** -0.5),
        'o_conv_w': nrm((N_ODD, SHORT_CONV, 3 * HYENA_WIDTH), SHORT_CONV ** -0.5),
        'o_conv_b': nrm((N_ODD, 3 * HYENA_WIDTH), 0.02),
        'o_filt_w1': nrm((N_ODD, FILTER_EMB, FILTER_HIDDEN), FILTER_EMB ** -0.5),
        'o_filt_b1': nrm((N_ODD, FILTER_HIDDEN), 0.02),
        'o_filt_w2': nrm((N_ODD, FILTER_HIDDEN, FILTER_HIDDEN), FILTER_HIDDEN ** -0.5),
        'o_filt_b2': nrm((N_ODD, FILTER_HIDDEN), 0.02),
        'o_filt_w3': nrm((N_ODD, FILTER_HIDDEN, FILTER_HIDDEN), FILTER_HIDDEN ** -0.5),
        'o_filt_b3': nrm((N_ODD, FILTER_HIDDEN), 0.02),
        'o_filt_freq': 1.0 + nrm((N_ODD, 3, FILTER_HIDDEN), 0.02),
        'o_filt_w4': nrm((N_ODD, FILTER_HIDDEN, HYENA_ORDER * 2 * HYENA_WIDTH), FILTER_HIDDEN ** -0.5),
        'o_filt_bias': nrm((N_ODD, HYENA_ORDER, HYENA_WIDTH), 0.5),
        'o_w_out': nrm((N_ODD, HYENA_WIDTH, D), HYENA_WIDTH ** -0.5),
        'final_norm': 1.0 + nrm((D,), 0.02),
    }


def reference(x, c, ctx, c_ctx, ada_w, ada_b, norm1, norm2, ffn_w_gate, ffn_w_up, ffn_w_down,
              e_w_in, e_w_out, e_lambda, e_subln, e_sgu_norm_g, e_sgu_norm_b, e_sgu_w, e_sgu_b,
              o_w_in, o_conv_w, o_conv_b, o_filt_w1, o_filt_b1, o_filt_w2, o_filt_b2, o_filt_w3,
              o_filt_b3, o_filt_freq, o_filt_w4, o_filt_bias, o_w_out, final_norm):
    xc = ctx
    for i in range(DEPTH):
        is_even = i % 2 == 0
        j = i // 2
        ctx_out = i < DEPTH - 1
        ctx_in = ctx_out or is_even
        sh1, sc1, g1, sh2, sc2, g2 = adaln(c, ada_w[i], ada_b[i])
        h_lat = modulate(rms_norm(x, norm1[i]), sh1, sc1)
        h_ctx = None
        if ctx_in:
            csh1, csc1, cg1, csh2, csc2, cg2 = adaln(c_ctx, ada_w[i], ada_b[i])
            h_ctx = modulate(rms_norm(xc, norm1[i]), csh1, csc1)
        if is_even:
            y_ctx, y_lat = even_mixer(h_ctx, h_lat, e_w_in[j], e_w_out[j], e_lambda[j], e_subln[j],
                                      e_sgu_norm_g[j], e_sgu_norm_b[j], e_sgu_w[j], e_sgu_b[j], i, ctx_out)
        else:
            hy = (o_w_in[j], o_conv_w[j], o_conv_b[j], o_filt_w1[j], o_filt_b1[j], o_filt_w2[j],
                  o_filt_b2[j], o_filt_w3[j], o_filt_b3[j], o_filt_freq[j], o_filt_w4[j],
                  o_filt_bias[j], o_w_out[j])
            y_lat = hyena_mixer(h_lat, *hy)
            y_ctx = hyena_mixer(h_ctx, *hy) if ctx_out else None
        x = x + g1 * y_lat
        x = x + g2 * swiglu(modulate(rms_norm(x, norm2[i]), sh2, sc2), ffn_w_gate[i], ffn_w_up[i], ffn_w_down[i])
        if ctx_out:
            xc = xc + cg1 * y_ctx
            xc = xc + cg2 * swiglu(modulate(rms_norm(xc, norm2[i]), csh2, csc2), ffn_w_gate[i], ffn_w_up[i], ffn_w_down[i])
    return rms_norm(x, final_norm)
```

```cpp
#include <hip/hip_runtime.h>
#include <hip/hip_cooperative_groups.h>
#include <cstdio>
#include <cstdint>
namespace cg = cooperative_groups;
#ifndef N_LAUNCH_MODE
#define N_LAUNCH_MODE 1
#endif
constexpr int DM = 2048, SEQ = 16384, NB = 2, MLAT = NB * SEQ  , NCTX = 256, MCTX = NB * NCTX  , MALL = MLAT + MCTX  ;
constexpr int DFF = 5632, EVEN_IN = 5120, HY_IN = 6144;
constexpr float MIN_DECAY_F = -3.0701134573253945f, MAX_DECAY_F = -15.350567286626973f;
__device__ __forceinline__ int opaque_tid() { int t = threadIdx.x; asm volatile("" : "+v"(t)); return t; }
namespace pg8 {
#define PG8_LAS __attribute__((address_space(3)))
typedef unsigned short bf16_t;
typedef short bf16x8 __attribute__((ext_vector_type(8)));
typedef float f32x4 __attribute__((ext_vector_type(4)));
typedef unsigned u32x4 __attribute__((ext_vector_type(4)));
constexpr int BM = 256, BK = 64, HALF = 128, HTB = HALF * BK * 2  , STAGE_BYTES = 8 * HTB, NXCD = 8, WGM = 8;

__host__ __device__ __forceinline__ int lds_byte(int r, int c) { const int st = (r >> 4) * 2 + (c >> 5), rr = r & 15, cc = c & 31, ob = rr * 64 + cc * 2; return st * 1024 + (ob ^ (((ob >> 9) & 1) << 5)); }
__host__ __device__ __forceinline__ void stage_rc(int b, int& R, int& C) { const int st = b / 1024, sb = b % 1024, swz = sb ^ (((sb >> 9) & 1) << 5); R = (st >> 1) * 16 + swz / 64; C = (st & 1) * 32 + (swz % 64) / 2; }
__host__ __device__ __forceinline__ int perm32(int rho) { const int n = rho >> 4, i = rho & 15; return 8 * (i >> 2) + 4 * n + (i & 3); }

struct Unit { int pm, pn; };
struct Gemm { const bf16_t* A; const bf16_t* Bt; int M, N, K; };

struct StaticOrder {
    int nM, nN, nwg, G, c;
    __host__ __device__ void init(int M, int N, int G_, int c_) { nM = M / BM; nN = N / BM; nwg = nM * nN; G = G_; c = c_; }
    __host__ __device__ bool next(int i, Unit& u) const {
        const long L = (long)i * G + c; if (L >= nwg) return false;
        int wgid = (int)L; { const int q = nwg / NXCD, r = nwg % NXCD, xcd = wgid % NXCD, off = wgid / NXCD; wgid = (xcd < r ? xcd * (q + 1) : r * (q + 1) + (xcd - r) * q) + off; }
        const int nig = WGM * nN, gid = wgid / nig, fm = gid * WGM, gsz = (nM - fm) < WGM ? (nM - fm) : WGM;
        u.pm = fm + ((wgid % nig) % gsz); u.pn = (wgid % nig) / gsz; return true;
    }
    __device__ __forceinline__ void a_ready(const Unit&) const {}
    __device__ __forceinline__ void done(const Unit&) const {}
};

__device__ __forceinline__ unsigned cvt_pk_bf16(float lo, float hi) { unsigned r; asm volatile("v_cvt_pk_bf16_f32 %0, %1, %2" : "=v"(r) : "v"(lo), "v"(hi)); return r; }
typedef _Float16 f16x2_t __attribute__((ext_vector_type(2)));
typedef unsigned u32x2 __attribute__((ext_vector_type(2)));
__device__ __forceinline__ unsigned cvt_pk_f16(float lo, float hi) { unsigned r; asm volatile("v_cvt_pkrtz_f16_f32 %0, %1, %2" : "=v"(r) : "v"(lo), "v"(hi)); return r; }
__device__ __forceinline__ float gelu_tanh(float x) {
    const float y = 0.7978845608028654f * (x + 0.044715f * x * x * x);
    const float e = __builtin_amdgcn_exp2f(y * 2.8853900817779268f);
    const float t = 1.f - 2.f * __builtin_amdgcn_rcpf(1.f + e);
    return 0.5f * x * (1.f + t);
}
__device__ __forceinline__ float silu_f(float x) { return x * __builtin_amdgcn_rcpf(1.f + __builtin_amdgcn_exp2f(-x * 1.4426950408889634f)); }

template <int mode> struct EpiPlain16 {
    static constexpr bool PERM = true, AFTER_DRAIN = false;
    unsigned short* O; int ldc;
    __device__ __forceinline__ void operator()(const f32x4 (&acc)[2][2][4][2], const Unit& u, int wr, int wc, int fr, int fq) const {
        const int row0 = u.pm * BM + wr * 64 + fr, col0 = u.pn * BM + wc * 32 + 8 * fq;
#pragma unroll
        for (int ai = 0; ai < 2; ++ai)
#pragma unroll
            for (int m = 0; m < 4; ++m) {
                const int row = row0 + ai * HALF + m * 16; unsigned short* rowp = O + (size_t)row * ldc + col0;
                float dk = 0.f;
                if (mode == 2) { const int c = row & 2047; const float delta = __builtin_fabsf(MIN_DECAY_F + (float)c * ((MAX_DECAY_F - MIN_DECAY_F) / 2047.f)); dk = -delta * (1.4426950408889634f / 16383.f); }
#pragma unroll
                for (int bj = 0; bj < 2; ++bj) {
                    f32x4 v0 = acc[ai][bj][m][0], v1 = acc[ai][bj][m][1];
                    if (mode == 2) { const float t0 = (float)(col0 + bj * HALF);
#pragma unroll
                        for (int j = 0; j < 4; ++j) { v0[j] *= __builtin_amdgcn_exp2f(dk * (t0 + (float)j)); v1[j] *= __builtin_amdgcn_exp2f(dk * (t0 + (float)(4 + j))); } }
                    u32x4 w;
                    if (mode == 0) { w.x = cvt_pk_bf16(v0[0], v0[1]); w.y = cvt_pk_bf16(v0[2], v0[3]); w.z = cvt_pk_bf16(v1[0], v1[1]); w.w = cvt_pk_bf16(v1[2], v1[3]); }
                    else { w.x = cvt_pk_f16(v0[0], v0[1]); w.y = cvt_pk_f16(v0[2], v0[3]); w.z = cvt_pk_f16(v1[0], v1[1]); w.w = cvt_pk_f16(v1[2], v1[3]); }
                    *(u32x4*)(rowp + bj * HALF) = w;
                }
                asm volatile("" ::: "memory");
            }
    }
};
struct EpiIn0 {
    static constexpr bool PERM = false, AFTER_DRAIN = false;
    unsigned short* out0; size_t grp_stride; float scale0; int lat0;
    __device__ __forceinline__ void operator()(const f32x4 (&acc)[2][2][4][2], const Unit& u, int wr, int wc, int fr, int fq) const {
        const int grp = (u.pn * BM) >> 10, colt = (u.pn * BM) & 1023;
        unsigned short* base = out0 + (size_t)grp * grp_stride;
        const int kd = grp == 0 ? 0 : 2;
        const float sc = scale0;
        const int col0 = colt + wc * 32 + 4 * fq, row0 = u.pm * BM + wr * 64 + fr;
        if (kd == 0) {
            const bool lat = (u.pm * BM) >= lat0;
            float invrev[4];
#pragma unroll
            for (int j = 0; j < 4; ++j) invrev[j] = __builtin_amdgcn_exp2f(-(float)(4 * fq + j) * (13.287712379549449f / 16.f)) * 0.15915494309189535f;
#pragma unroll
            for (int ai = 0; ai < 2; ++ai)
#pragma unroll
                for (int m = 0; m < 4; ++m) {
                    const int row = row0 + ai * HALF + m * 16; const int t = (row - lat0) & 16383;
                    const float pos = (wc & 1) ? (float)(t & 63) : (float)(t >> 6);
                    float cs[4], sn[4];
#pragma unroll
                    for (int j = 0; j < 4; ++j) { const float r = __builtin_amdgcn_fractf(pos * invrev[j]); cs[j] = lat ? __builtin_amdgcn_cosf(r) : 1.f; sn[j] = lat ? __builtin_amdgcn_sinf(r) : 0.f; }
                    unsigned short* rowp = base + (size_t)row * 1024 + col0;
#pragma unroll
                    for (int bj = 0; bj < 2; ++bj) {
                        const f32x4 x1 = acc[ai][bj][m][0], x2 = acc[ai][bj][m][1]; float o1[4], o2[4];
#pragma unroll
                        for (int j = 0; j < 4; ++j) { o1[j] = (x1[j] * cs[j] - x2[j] * sn[j]) * sc; o2[j] = (x2[j] * cs[j] + x1[j] * sn[j]) * sc; }
                        u32x2 w1, w2; w1.x = cvt_pk_bf16(o1[0], o1[1]); w1.y = cvt_pk_bf16(o1[2], o1[3]); w2.x = cvt_pk_bf16(o2[0], o2[1]); w2.y = cvt_pk_bf16(o2[2], o2[3]);
                        *(u32x2*)(rowp + bj * HALF) = w1; *(u32x2*)(rowp + bj * HALF + 16) = w2;
                    }
                    asm volatile("" ::: "memory");
                }
        } else {
#pragma unroll
            for (int ai = 0; ai < 2; ++ai)
#pragma unroll
                for (int m = 0; m < 4; ++m) {
                    const int row = row0 + ai * HALF + m * 16; unsigned short* rowp = base + (size_t)row * 1024 + col0;
#pragma unroll
                    for (int bj = 0; bj < 2; ++bj)
#pragma unroll
                        for (int n = 0; n < 2; ++n) { const f32x4 v = acc[ai][bj][m][n]; u32x2 w; w.x = cvt_pk_bf16(gelu_tanh(v[0]), gelu_tanh(v[1])); w.y = cvt_pk_bf16(gelu_tanh(v[2]), gelu_tanh(v[3]));
                            *(u32x2*)(rowp + bj * HALF + n * 16) = w; }
                    asm volatile("" ::: "memory");
                }
        }
    }
};
struct EpiResid {
    static constexpr bool PERM = false, AFTER_DRAIN = false;
    const float* base; float* out; const float* gate; int gate_bstride;
    __device__ __forceinline__ void operator()(const f32x4 (&acc)[2][2][4][2], const Unit& u, int wr, int wc, int fr, int fq) const {
        const int col0 = u.pn * BM + wc * 32 + 4 * fq, row0 = u.pm * BM + wr * 64 + fr; const float* gp = gate + (size_t)((u.pm * BM) >> 14) * gate_bstride + col0;
        f32x4 gv[2][2];
#pragma unroll
        for (int bj = 0; bj < 2; ++bj)
#pragma unroll
            for (int n = 0; n < 2; ++n) gv[bj][n] = *(const f32x4*)(gp + bj * HALF + n * 16);
#pragma unroll
        for (int ai = 0; ai < 2; ++ai) {
            f32x4 bs[4][2][2];
#pragma unroll
            for (int m = 0; m < 4; ++m) { const size_t off = (size_t)(row0 + ai * HALF + m * 16) * 2048 + col0;
#pragma unroll
                for (int bj = 0; bj < 2; ++bj)
#pragma unroll
                    for (int n = 0; n < 2; ++n) bs[m][bj][n] = *(const f32x4*)(base + off + bj * HALF + n * 16); }
#pragma unroll
            for (int m = 0; m < 4; ++m) { const size_t off = (size_t)(row0 + ai * HALF + m * 16) * 2048 + col0;
#pragma unroll
                for (int bj = 0; bj < 2; ++bj)
#pragma unroll
                    for (int n = 0; n < 2; ++n) *(f32x4*)(out + off + bj * HALF + n * 16) = bs[m][bj][n] + gv[bj][n] * acc[ai][bj][m][n]; }
            asm volatile("" ::: "memory");
        }
    }
};
struct EpiSwiglu {
    static constexpr bool PERM = true, AFTER_DRAIN = false;
    unsigned short* O;
    __device__ __forceinline__ void operator()(const f32x4 (&acc)[2][2][4][2], const Unit& u, int wr, int wc, int fr, int fq) const {
        const int col0 = u.pn * HALF + wc * 32 + 8 * fq, row0 = u.pm * BM + wr * 64 + fr;
#pragma unroll
        for (int ai = 0; ai < 2; ++ai)
#pragma unroll
            for (int m = 0; m < 4; ++m) {
                float o[8];
#pragma unroll
                for (int n = 0; n < 2; ++n)
#pragma unroll
                    for (int j = 0; j < 4; ++j) o[4 * n + j] = silu_f(acc[ai][0][m][n][j]) * acc[ai][1][m][n][j];
                u32x4 w; w.x = cvt_pk_bf16(o[0], o[1]); w.y = cvt_pk_bf16(o[2], o[3]); w.z = cvt_pk_bf16(o[4], o[5]); w.w = cvt_pk_bf16(o[6], o[7]);
                *(u32x4*)(O + (size_t)(row0 + ai * HALF + m * 16) * DFF + col0) = w;
                asm volatile("" ::: "memory");
            }
    }
};
template <class Epi, class Sched, bool ALIGN_EPI = false, bool SP2 = false>
__device__ __forceinline__ void gemm_phase(PG8_LAS unsigned char* lds, const Gemm g, const Sched& S, const Epi& E) {
    const int tid = opaque_tid(), wid = __builtin_amdgcn_readfirstlane(tid >> 6), lane = tid & 63, wr = wid >> 2, wc = wid & 3, fr = lane & 15, fq = lane >> 4;
    const int K = g.K, nt = K / BK;
    unsigned voffA[2], voffB[2];
#pragma unroll
    for (int i = 0; i < 2; ++i) { int R, C; stage_rc(tid * 16 + i * 8192, R, C); const int Rb = Epi::PERM ? ((R & ~31) + perm32(R & 31)) : R;
        voffA[i] = (unsigned)(R * K + C) * 2u; voffB[i] = (unsigned)(Rb * K + C) * 2u; }
    const size_t kstep = (size_t)(BK * 2);
    const size_t hstep = (size_t)HALF * K * 2;
    const size_t tstep = 2 * hstep;
    const unsigned ldsw = (unsigned)wid * 1024u;
    const int aoff = lds_byte(wr * 64 + fr, fq * 8), boff = lds_byte(wc * 32 + fr, fq * 8);
#define PG8_SA(b, h) (((b) * 2 + (h)) * HTB)
#define PG8_SB(b, h) ((4 + (b) * 2 + (h)) * HTB)
#define PG8_STAGE(bufoff, gbase, voff) do { _Pragma("unroll") for (int _i = 0; _i < 2; ++_i) \
        __builtin_amdgcn_global_load_lds((const unsigned*)((const char*)(gbase) + (voff)[_i]), (PG8_LAS unsigned*)(lds + (bufoff) + ldsw + _i * 8192), 16, 0, 0); } while (0)
#define PG8_LDA(dst, b, h) do { _Pragma("unroll") for (int m = 0; m < 4; ++m) _Pragma("unroll") for (int k = 0; k < 2; ++k) dst[m][k] = *(const PG8_LAS bf16x8*)(lds + PG8_SA(b, h) + aoff + m * 2048 + k * 1024); } while (0)
#define PG8_LDB(dst, b, h) do { _Pragma("unroll") for (int n = 0; n < 2; ++n) _Pragma("unroll") for (int k = 0; k < 2; ++k) dst[n][k] = *(const PG8_LAS bf16x8*)(lds + PG8_SB(b, h) + boff + n * 2048 + k * 1024); } while (0)
#define PG8_MMA(ai, bj, At, Bt) do { __builtin_amdgcn_s_setprio(1); _Pragma("unroll") for (int m = 0; m < 4; ++m) _Pragma("unroll") for (int n = 0; n < 2; ++n) _Pragma("unroll") for (int k = 0; k < 2; ++k) \
        acc[ai][bj][m][n] = __builtin_amdgcn_mfma_f32_16x16x32_bf16(Bt[n][k], At[m][k], acc[ai][bj][m][n], 0, 0, 0); __builtin_amdgcn_s_setprio(0); } while (0)
#define PG8_WAIT_V(n) asm volatile("s_waitcnt vmcnt(" #n ")" ::: "memory")
#define PG8_WAIT_L(n) asm volatile("s_waitcnt lgkmcnt(" #n ")" ::: "memory")
#define PG8_BAR __builtin_amdgcn_s_barrier()
#define PG8_SCHED __builtin_amdgcn_sched_barrier(0)
    Unit cur, nxt; int ui = 0;
    if (!S.next(0, cur)) return;
    f32x4 acc[2][2][4][2];
#pragma unroll
    for (int a = 0; a < 2; ++a)
#pragma unroll
        for (int b = 0; b < 2; ++b)
#pragma unroll
            for (int m = 0; m < 4; ++m)
#pragma unroll
                for (int n = 0; n < 2; ++n) acc[a][b][m][n] = (f32x4){0.f, 0.f, 0.f, 0.f};
    bf16x8 At[4][2], B0[2][2], B1[2][2];
    const char* cA = (const char*)g.A + (size_t)cur.pm * tstep; const char* cB = (const char*)g.Bt + (size_t)cur.pn * tstep;
    S.a_ready(cur);
    if constexpr (SP2) {
        PG8_STAGE(PG8_SB(0, 0), cB, voffB); PG8_STAGE(PG8_SB(0, 1), cB + hstep, voffB); PG8_STAGE(PG8_SA(0, 0), cA, voffA); PG8_STAGE(PG8_SA(0, 1), cA + hstep, voffA);
        if (wr == 1) PG8_BAR;
        PG8_WAIT_V(2); PG8_BAR;
        PG8_STAGE(PG8_SB(1, 0), cB + kstep, voffB); PG8_STAGE(PG8_SA(1, 0), cA + kstep, voffA); PG8_STAGE(PG8_SB(1, 1), cB + hstep + kstep, voffB);
        PG8_WAIT_V(6); PG8_BAR;
    } else {
        PG8_STAGE(PG8_SB(0, 0), cB, voffB); PG8_STAGE(PG8_SA(0, 0), cA, voffA); PG8_STAGE(PG8_SB(0, 1), cB + hstep, voffB); PG8_STAGE(PG8_SA(0, 1), cA + hstep, voffA);
        if (wr == 1) PG8_BAR;
        PG8_WAIT_V(4); PG8_BAR;
        PG8_STAGE(PG8_SB(1, 0), cB + kstep, voffB); PG8_STAGE(PG8_SA(1, 0), cA + kstep, voffA); PG8_STAGE(PG8_SB(1, 1), cB + hstep + kstep, voffB);
        PG8_WAIT_V(6); PG8_BAR;
    }
    for (;;) {
        const bool has_next = S.next(ui + 1, nxt);
        const char* nA = has_next ? (const char*)g.A + (size_t)nxt.pm * tstep : cA; const char* nB = has_next ? (const char*)g.Bt + (size_t)nxt.pn * tstep : cB;
        for (int t = 0; t < nt; t += 2) {
            const bool last = (t == nt - 2);
            const char* a1 = cA + (size_t)(t + 1) * kstep;
            const char* a2 = last ? nA : cA + (size_t)(t + 2) * kstep; const char* b2 = last ? nB : cB + (size_t)(t + 2) * kstep;
            const char* a3 = a2 + kstep; const char* b3 = b2 + kstep;
            if (last && has_next) S.a_ready(nxt);
            if constexpr (SP2) {
            PG8_LDB(B0, 0, 0); PG8_LDB(B1, 0, 1); PG8_SCHED; PG8_LDA(At, 0, 0); PG8_STAGE(PG8_SA(1, 1), a1 + hstep, voffA);
            PG8_WAIT_V(8); PG8_WAIT_L(0); PG8_BAR; PG8_MMA(0, 0, At, B0); PG8_MMA(0, 1, At, B1); PG8_BAR; PG8_SCHED;
            PG8_LDA(At, 0, 1); PG8_STAGE(PG8_SB(0, 0), b2, voffB); PG8_STAGE(PG8_SB(0, 1), b2 + hstep, voffB); PG8_STAGE(PG8_SA(0, 0), a2, voffA);
            PG8_WAIT_V(8); PG8_WAIT_L(0); PG8_BAR; PG8_MMA(1, 0, At, B0); PG8_MMA(1, 1, At, B1); PG8_BAR; PG8_SCHED;
            PG8_LDB(B0, 1, 0); PG8_LDB(B1, 1, 1); PG8_SCHED; PG8_LDA(At, 1, 0); PG8_STAGE(PG8_SA(0, 1), a2 + hstep, voffA);
            PG8_WAIT_V(8); PG8_WAIT_L(0); PG8_BAR; PG8_MMA(0, 0, At, B0); PG8_MMA(0, 1, At, B1); PG8_BAR; PG8_SCHED;
            PG8_LDA(At, 1, 1); PG8_STAGE(PG8_SB(1, 0), b3, voffB); PG8_STAGE(PG8_SB(1, 1), b3 + hstep, voffB); PG8_STAGE(PG8_SA(1, 0), a3, voffA);
            PG8_WAIT_V(8); PG8_WAIT_L(0); PG8_BAR; PG8_MMA(1, 0, At, B0); PG8_MMA(1, 1, At, B1); PG8_BAR; PG8_SCHED;
            } else {
            PG8_LDB(B0, 0, 0); PG8_SCHED; PG8_LDA(At, 0, 0); PG8_STAGE(PG8_SA(1, 1), a1 + hstep, voffA);
            PG8_WAIT_L(8); PG8_BAR; PG8_WAIT_L(0); PG8_MMA(0, 0, At, B0); PG8_BAR; PG8_SCHED;
            PG8_LDB(B1, 0, 1); PG8_STAGE(PG8_SB(0, 0), b2, voffB);
            PG8_BAR; PG8_WAIT_L(0); PG8_MMA(0, 1, At, B1); PG8_BAR;
            PG8_LDA(At, 0, 1); PG8_STAGE(PG8_SA(0, 0), a2, voffA);
            PG8_BAR; PG8_WAIT_L(0); PG8_MMA(1, 0, At, B0); PG8_BAR; PG8_SCHED;
            PG8_STAGE(PG8_SB(0, 1), b2 + hstep, voffB);
            PG8_WAIT_V(6); PG8_BAR; PG8_MMA(1, 1, At, B1); PG8_BAR;
            PG8_LDB(B0, 1, 0); PG8_SCHED; PG8_LDA(At, 1, 0); PG8_STAGE(PG8_SA(0, 1), a2 + hstep, voffA);
            PG8_WAIT_L(8); PG8_BAR; PG8_WAIT_L(0); PG8_MMA(0, 0, At, B0); PG8_BAR; PG8_SCHED;
            PG8_LDB(B1, 1, 1); PG8_STAGE(PG8_SB(1, 0), b3, voffB);
            PG8_BAR; PG8_WAIT_L(0); PG8_MMA(0, 1, At, B1); PG8_BAR;
            PG8_LDA(At, 1, 1); PG8_STAGE(PG8_SA(1, 0), a3, voffA);
            PG8_BAR; PG8_WAIT_L(0); PG8_MMA(1, 0, At, B0); PG8_BAR; PG8_SCHED;
            PG8_STAGE(PG8_SB(1, 1), b3 + hstep, voffB);
            PG8_WAIT_V(6); PG8_BAR; PG8_MMA(1, 1, At, B1); PG8_BAR;
            }
        }
        if constexpr (ALIGN_EPI) { if (wr == 0) PG8_BAR; }
        if constexpr (!Epi::AFTER_DRAIN) { E(acc, cur, wr, wc, fr, fq); S.done(cur); }
        if (!has_next) break;
#pragma unroll
        for (int a = 0; a < 2; ++a)
#pragma unroll
            for (int b = 0; b < 2; ++b)
#pragma unroll
                for (int m = 0; m < 4; ++m)
#pragma unroll
                    for (int n = 0; n < 2; ++n) acc[a][b][m][n] = (f32x4){0.f, 0.f, 0.f, 0.f};
        cur = nxt; cA = nA; cB = nB; ++ui;
        if constexpr (ALIGN_EPI) { if (wr == 1) PG8_BAR; }
    }
    PG8_WAIT_V(0);
    if constexpr (!ALIGN_EPI) { if (wr == 0) PG8_BAR; }
    PG8_BAR;
    if constexpr (Epi::AFTER_DRAIN) { E.fused(acc, cur, wr, wc, fr, fq, lds, wid, lane); S.done(cur); }
#undef PG8_SA
#undef PG8_SB
#undef PG8_STAGE
#undef PG8_LDA
#undef PG8_LDB
#undef PG8_MMA
#undef PG8_WAIT_V
#undef PG8_WAIT_L
#undef PG8_BAR
#undef PG8_SCHED
}
}
#define LAS __attribute__((address_space(3)))
typedef unsigned short bf16;
typedef float f32x4 __attribute__((ext_vector_type(4)));
typedef float f32x2 __attribute__((ext_vector_type(2)));
typedef float f32x16 __attribute__((ext_vector_type(16)));
typedef short bf16x8 __attribute__((ext_vector_type(8)));
typedef unsigned u32x4 __attribute__((ext_vector_type(4)));
typedef unsigned u32x2 __attribute__((ext_vector_type(2)));
typedef _Float16 f16x2 __attribute__((ext_vector_type(2)));
constexpr int NWAVES = 8, NTHR = 512;
constexpr int LDS_BYTES = 147456;
constexpr size_t MiB = 1u << 20;
constexpr size_t WS_MODS = 0;
constexpr size_t WS_H3X = 1 * MiB;
constexpr size_t WS_W4X = 9 * MiB;
constexpr size_t WS_WIN = 16 * MiB;
constexpr size_t WS_WOUT0 = 36 * MiB;
constexpr size_t WS_WGU0 = 44 * MiB;
constexpr size_t WS_WD0 = 88 * MiB;
constexpr size_t WS_HYSCR = 16 * MiB;
constexpr size_t WS_OIN = 110 * MiB;
constexpr size_t WS_OOUT = 134 * MiB;
constexpr size_t WS_WGU1 = 142 * MiB;
constexpr size_t WS_WD1 = 186 * MiB;
constexpr size_t WS_X = 208 * MiB;
constexpr size_t WS_H = 464 * MiB;
constexpr size_t WS_OV = 594 * MiB;
constexpr size_t WS_K = WS_OV, WS_VT = WS_OV + 65 * MiB, WS_Q = WS_OV + 130 * MiB, WS_U = WS_OV + 194 * MiB, WS_G = WS_OV + 258 * MiB;
constexpr size_t WS_END = 978 * MiB;
static_assert(WS_U - WS_Q == WS_G - WS_U, "Q/U/G equally spaced");

struct Args { const float* in[33]; float* out; unsigned char* ws; int ph_lo, ph_hi; };
constexpr int TAB_OFF = 143360;
__device__ __forceinline__ unsigned long long tab_ld(const LAS unsigned long long* tab, int i) {
    const unsigned long long v = tab[i]; const unsigned lo = __builtin_amdgcn_readfirstlane((unsigned)v), hi = __builtin_amdgcn_readfirstlane((unsigned)(v >> 32));
    return ((unsigned long long)hi << 32) | lo; }
struct LArgs { const LAS unsigned long long* tab; float* out; unsigned char* ws;
    __device__ __forceinline__ const float* in(int i) const { return (const float*)(const __attribute__((address_space(1))) float*)tab_ld(tab, i); } };
enum { I_X = 0, I_C, I_CTX, I_CCTX, I_ADAW, I_ADAB, I_NORM1, I_NORM2, I_FG, I_FU, I_FD, I_EWIN, I_EWOUT, I_ELAM, I_ESUBLN, I_ESNG, I_ESNB, I_ESW, I_ESB,
       I_OWIN, I_OCW, I_OCB, I_FW1, I_FB1, I_FW2, I_FB2, I_FW3, I_FB3, I_FFREQ, I_FW4, I_FBIAS, I_OWOUT, I_FNORM };

template <int O> __device__ __forceinline__ float swz_xor(float v) { return __builtin_bit_cast(float, __builtin_amdgcn_ds_swizzle(__builtin_bit_cast(int, v), (O << 10) | 0x1f)); }
__device__ __forceinline__ float xor32_get(float v, int xaddr) { return __builtin_bit_cast(float, __builtin_amdgcn_ds_bpermute(xaddr, __builtin_bit_cast(int, v))); }
__device__ __forceinline__ float wave_sum(float v) {
    v += swz_xor<1>(v); v += swz_xor<2>(v); v += swz_xor<4>(v); v += swz_xor<8>(v); v += swz_xor<16>(v);
    return __builtin_bit_cast(float, __builtin_amdgcn_readlane(__builtin_bit_cast(int, v), 0)) + __builtin_bit_cast(float, __builtin_amdgcn_readlane(__builtin_bit_cast(int, v), 32));
}
__device__ __forceinline__ unsigned f2bf(float f) { unsigned u = __builtin_bit_cast(unsigned, f); return (u + 0x7fffu + ((u >> 16) & 1u)) >> 16; }
__device__ __forceinline__ unsigned pk2(float lo, float hi) { return f2bf(lo) | (f2bf(hi) << 16); }
__device__ __forceinline__ float bf2f(unsigned h) { return __builtin_bit_cast(float, h << 16); }
__device__ __forceinline__ f32x2 cmul(f32x2 a, f32x2 b) { const f32x2 ar = {-a.y, a.x}; return ar * b.y + a * b.x; }

__device__ __forceinline__ void transpose_item(const float* W, int K, int N, bf16* WT, int dst_row0, LAS float* scr, int k0, int n0, int lane) {
#pragma unroll 8
    for (int i = 0; i < 32; ++i) { const int kk = 2 * i + (lane >> 5); scr[kk * 33 + (lane & 31)] = W[(size_t)(k0 + kk) * N + n0 + (lane & 31)]; }
    asm volatile("s_waitcnt vmcnt(0) lgkmcnt(0)" ::: "memory");
    const int c = lane & 7;
#pragma unroll
    for (int j = 0; j < 4; ++j) { const int n = (lane >> 3) + 8 * j; const LAS float* s = scr + (8 * c) * 33 + n;
        u32x4 o; o.x = pk2(s[0 * 33], s[1 * 33]); o.y = pk2(s[2 * 33], s[3 * 33]); o.z = pk2(s[4 * 33], s[5 * 33]); o.w = pk2(s[6 * 33], s[7 * 33]);
        *(u32x4*)(WT + (size_t)(dst_row0 + n) * K + k0 + 8 * c) = o; }
    asm volatile("s_waitcnt lgkmcnt(0)" ::: "memory");
}
template <int MAP> __device__ __forceinline__ void transpose_matrix(const float* W, int K, int N, bf16* WT, LAS float* scr, int gw, int NGW, int lane) {
    const int nblk = N / 32, nitems = (K / 64) * nblk;
    for (int it = gw; it < nitems; it += NGW) {
        const int kb = it / nblk, nb = it % nblk, n0 = nb * 32; int d = n0;
        if (MAP == 1) d = n0 < 1024 ? n0 + 2048 : (n0 < 3072 ? n0 - 1024 : n0);
        if (MAP == 2) d = 256 * (n0 >> 7) + (n0 & 127);
        if (MAP == 3) d = 256 * (n0 >> 7) + 128 + (n0 & 127);
        transpose_item(W, K, N, WT, d, scr, kb * 64, n0, lane);
    }
}
__device__ __forceinline__ void p0_prologue(const LArgs& a, LAS unsigned char* lds) {
    const int tid = opaque_tid(), lane = tid & 63, wid = tid >> 6;
    const int gw = blockIdx.x * NWAVES + wid, NGW = gridDim.x * NWAVES;
    unsigned char* ws = a.ws;
    LAS float* scr = (LAS float*)(lds + wid * 16384);
    {
        float* mods = (float*)(ws + WS_MODS);
        for (int it = gw; it < 3072; it += NGW) {
            const int layer = it / 1536, r = it % 1536, cc = r >> 3, kc = r & 7, col = cc * 64 + lane;
            const float* w = a.in(I_ADAW) + (size_t)layer * 2048 * 12288 + (size_t)(kc * 256) * 12288 + col;
            const float* c0 = a.in(I_C) + kc * 256; const float* c1 = c0 + 2048; const float* c2 = a.in(I_CCTX) + kc * 256;
            float a0 = 0.f, a1 = 0.f, a2 = 0.f;
#pragma unroll 8
            for (int k = 0; k < 256; ++k) { const float wv = w[(size_t)k * 12288]; a0 += pg8::silu_f(c0[k]) * wv; a1 += pg8::silu_f(c1[k]) * wv; a2 += pg8::silu_f(c2[k]) * wv; }
            if (kc == 0) { const float bb = a.in(I_ADAB)[layer * 12288 + col]; a0 += bb; a1 += bb; a2 += bb; }
            float* m = mods + (size_t)layer * 3 * 12288 + col;
            atomicAdd(m, a0); atomicAdd(m + 12288, a1); atomicAdd(m + 2 * 12288, a2);
        }
    }
    transpose_matrix<1>(a.in(I_EWIN), 2048, EVEN_IN, (bf16*)(ws + WS_WIN), scr, gw, NGW, lane);
    transpose_matrix<0>(a.in(I_EWOUT), 2048, 2048, (bf16*)(ws + WS_WOUT0), scr, gw, NGW, lane);
    transpose_matrix<0>(a.in(I_OWIN), 2048, HY_IN, (bf16*)(ws + WS_OIN), scr, gw, NGW, lane);
    transpose_matrix<0>(a.in(I_OWOUT), 2048, 2048, (bf16*)(ws + WS_OOUT), scr, gw, NGW, lane);
    for (int l = 0; l < 2; ++l) {
        bf16* gu = (bf16*)(ws + (l ? WS_WGU1 : WS_WGU0)); bf16* dn = (bf16*)(ws + (l ? WS_WD1 : WS_WD0));
        transpose_matrix<2>(a.in(I_FG) + (size_t)l * 2048 * DFF, 2048, DFF, gu, scr, gw, NGW, lane);
        transpose_matrix<3>(a.in(I_FU) + (size_t)l * 2048 * DFF, 2048, DFF, gu, scr, gw, NGW, lane);
        transpose_matrix<0>(a.in(I_FD) + (size_t)l * 2048 * DFF, DFF, 2048, dn, scr, gw, NGW, lane);
    }
    {
        bf16* W4X = (bf16*)(ws + WS_W4X); const float* w4 = a.in(I_FW4);
        for (int e = blockIdx.x * NTHR + tid; e < 64 * 8192; e += gridDim.x * NTHR) {
            const int k = e >> 13, col = e & 8191; const float w = w4[e]; const unsigned hi = f2bf(w); const unsigned lo = f2bf(w - bf2f(hi));
            bf16* o = W4X + (size_t)col * 256 + k; o[0] = (bf16)hi; o[64] = (bf16)hi; o[128] = (bf16)lo; o[192] = (bf16)lo;
        }
    }
    {
        bf16* H3X = (bf16*)(ws + WS_H3X);
        const float* w1 = a.in(I_FW1); const float* w2 = a.in(I_FW2); const float* w3 = a.in(I_FW3);
        const float b1 = a.in(I_FB1)[lane], b2 = a.in(I_FB2)[lane], b3 = a.in(I_FB3)[lane];
        const float fr0 = a.in(I_FFREQ)[lane] * 0.15915494309189535f, fr1 = a.in(I_FFREQ)[64 + lane] * 0.15915494309189535f, fr2 = a.in(I_FFREQ)[128 + lane] * 0.15915494309189535f;
        float w1c[33], w2c[64], w3c[64];
#pragma unroll
        for (int f = 0; f < 33; ++f) w1c[f] = w1[f * 64 + lane];
#pragma unroll
        for (int k = 0; k < 64; ++k) { w2c[k] = w2[k * 64 + lane]; w3c[k] = w3[k * 64 + lane]; }
        for (int pos = gw; pos < SEQ; pos += NGW) {
            float feat = 0.f;
            { const int bidx = (lane >= 17) ? lane - 17 : lane - 1; const float fb = 1e-4f + (float)(bidx < 0 ? 0 : bidx) * ((15.f - 1e-4f) / 15.f);
              double rv = (double)fb * (double)pos * (1.0 / 16384.0); rv -= __builtin_floor(rv); const float rf = (float)rv;
              if (lane == 0) feat = (float)pos * (1.f / 16383.f); else if (lane <= 16) feat = __builtin_amdgcn_cosf(rf); else if (lane <= 32) feat = -__builtin_amdgcn_sinf(rf); }
            float acc = b1;
#pragma unroll
            for (int f = 0; f < 33; ++f) acc += __builtin_bit_cast(float, __builtin_amdgcn_readlane(__builtin_bit_cast(int, feat), f)) * w1c[f];
            float h = __builtin_amdgcn_sinf(__builtin_amdgcn_fractf(fr0 * acc));
            acc = b2;
#pragma unroll
            for (int k = 0; k < 64; ++k) acc += __builtin_bit_cast(float, __builtin_amdgcn_readlane(__builtin_bit_cast(int, h), k)) * w2c[k];
            h = __builtin_amdgcn_sinf(__builtin_amdgcn_fractf(fr1 * acc));
            acc = b3;
#pragma unroll
            for (int k = 0; k < 64; ++k) acc += __builtin_bit_cast(float, __builtin_amdgcn_readlane(__builtin_bit_cast(int, h), k)) * w3c[k];
            h = __builtin_amdgcn_sinf(__builtin_amdgcn_fractf(fr2 * acc));
            const unsigned hi = f2bf(h), lo = f2bf(h - bf2f(hi));
            bf16* o = H3X + (size_t)pos * 256 + lane; o[0] = (bf16)hi; o[64] = (bf16)lo; o[128] = (bf16)hi; o[192] = (bf16)lo;
        }
    }
}

template <int SRC> __device__ __forceinline__ void prenorm_rows(const LArgs& a, int nrows, const float* nw, const float* mods_layer, int shift_part, bf16* dst) {
    const int tid = opaque_tid(), lane = tid & 63, wid = tid >> 6, gw = blockIdx.x * NWAVES + wid, NGW = gridDim.x * NWAVES;
    for (int chunk = gw; chunk < nrows / 16; chunk += NGW) {
        const int row0 = chunk * 16; const float* src0; int cond;
        if (SRC == 0) { if (row0 < MCTX) { src0 = a.in(I_CTX) + (size_t)row0 * DM; cond = 2; } else { src0 = a.in(I_X) + (size_t)(row0 - MCTX) * DM; cond = (row0 - MCTX) >> 14; } }
        else { src0 = (const float*)(a.ws + WS_X) + (size_t)row0 * DM; cond = row0 >> 14; }
        const float* sh = mods_layer + (size_t)cond * 12288 + shift_part * 2048; const float* sc = sh + 2048;
        f32x4 cs[8], sv[8];
#pragma unroll
        for (int j = 0; j < 8; ++j) { const int col = 4 * lane + 256 * j; cs[j] = *(const f32x4*)(nw + col) * (*(const f32x4*)(sc + col) + 1.f); sv[j] = *(const f32x4*)(sh + col); }
#pragma unroll 2
        for (int r = 0; r < 16; ++r) {
            const float* src = src0 + (size_t)r * DM; f32x4 v[8]; float ss = 0.f;
#pragma unroll
            for (int j = 0; j < 8; ++j) { v[j] = *(const f32x4*)(src + 4 * lane + 256 * j); ss += (v[j].x * v[j].x + v[j].y * v[j].y) + (v[j].z * v[j].z + v[j].w * v[j].w); }
            const float rn = 1.f / sqrtf(wave_sum(ss) * (1.f / DM) + 1e-6f);
#pragma unroll
            for (int j = 0; j < 8; ++j) { const int col = 4 * lane + 256 * j; const f32x4 o = v[j] * rn * cs[j] + sv[j]; u32x2 pq; pq.x = pk2(o.x, o.y); pq.y = pk2(o.z, o.w); *(u32x2*)(dst + (size_t)(row0 + r) * DM + col) = pq; }
        }
    }
}
__device__ __forceinline__ void final_norm_rows(const LArgs& a) {
    const int tid = opaque_tid(), lane = tid & 63, wid = tid >> 6, gw = blockIdx.x * NWAVES + wid, NGW = gridDim.x * NWAVES;
    const float* nw = a.in(I_FNORM);
    f32x4 cs[8];
#pragma unroll
    for (int j = 0; j < 8; ++j) cs[j] = *(const f32x4*)(nw + 4 * lane + 256 * j);
    for (int chunk = gw; chunk < MLAT / 16; chunk += NGW) {
#pragma unroll 2
        for (int r = 0; r < 16; ++r) {
            const int row = chunk * 16 + r; const float* src = (const float*)(a.ws + WS_X) + (size_t)row * DM; f32x4 v[8]; float ss = 0.f;
#pragma unroll
            for (int j = 0; j < 8; ++j) { v[j] = *(const f32x4*)(src + 4 * lane + 256 * j); ss += (v[j].x * v[j].x + v[j].y * v[j].y) + (v[j].z * v[j].z + v[j].w * v[j].w); }
            const float rn = 1.f / sqrtf(wave_sum(ss) * (1.f / DM) + 1e-6f);
#pragma unroll
            for (int j = 0; j < 8; ++j) { const int col = 4 * lane + 256 * j; *(f32x4*)(a.out + (size_t)row * DM + col) = v[j] * rn * cs[j]; }
        }
    }
}

__device__ __forceinline__ void attn_phase(const LArgs& a, LAS unsigned char* lds) {
    const int tid = opaque_tid(), lane = tid & 63, wid = tid >> 6, pr = wid >> 1, mp = wid & 1, r32 = lane & 31, hi = lane >> 5;
    const bf16* Qg = (const bf16*)(a.ws + WS_Q); const bf16* Kg = (const bf16*)(a.ws + WS_K); const bf16* Vt = (const bf16*)(a.ws + WS_VT);
    bf16* act = (bf16*)(a.ws + WS_H);
    float lam;
    { const float* lp = a.in(I_ELAM); const float v = wave_sum(lp[lane] * lp[64 + lane]), w = wave_sum(lp[128 + lane] * lp[192 + lane]); lam = __expf(v) - __expf(w) + 0.2f; }
    constexpr int KROW = 272, VROW = 144, KBUF = 64 * KROW, VBUF = 128 * VROW, NT = 260;
    const int xaddr = (lane ^ 32) << 2;
    const int kappa = (r32 & 16) | ((r32 & 4) << 1) | ((r32 & 8) >> 1) | (r32 & 3);
    const int krow_t = tid >> 4, kch = tid & 15, vrow_t = tid >> 3, vch = tid & 7;
    const float* subln = a.in(I_ESUBLN);
    for (int u = blockIdx.x; u < 2048; u += gridDim.x) {
        const int bh = u >> 7, qb = u & 127, b = bh >> 3, h = bh & 7;
        const bf16* Qp = Qg + (size_t)(b * SEQ + qb * 128 + pr * 32 + r32) * 1024 + h * 128 + mp * 64 + hi * 8;
        bf16x8 qf[4];
#pragma unroll
        for (int ks = 0; ks < 4; ++ks) qf[ks] = *(const bf16x8*)(Qp + ks * 16);
        f32x16 o[4];
#pragma unroll
        for (int d = 0; d < 4; ++d)
#pragma unroll
            for (int r = 0; r < 16; ++r) o[d][r] = 0.f;
        float mrun = -1e30f, lrun = 0.f;
        const bf16* kgp = Kg + (size_t)krow_t * 1024 + h * 128 + kch * 8;
        const bf16* vgp = Vt + (size_t)(h * 128 + vrow_t) * MALL + vch * 8;
        u32x4 kreg[2], vreg[2];
#define ATT_LOAD(K0, K1, V0, V1, j) do { const int kb0_ = (j) < 4 ? b * NCTX + (j) * 64 : MCTX + b * SEQ + ((j) - 4) * 64; \
            K0 = *(const u32x4*)(kgp + (size_t)kb0_ * 1024); K1 = *(const u32x4*)(kgp + (size_t)(kb0_ + 32) * 1024); \
            V0 = *(const u32x4*)(vgp + kb0_); V1 = *(const u32x4*)(vgp + (size_t)64 * MALL + kb0_); } while (0)
#define ATT_STORE(K0, K1, V0, V1, kbuf, vbuf) do { LAS unsigned char* kb_ = lds + (kbuf) * KBUF; LAS unsigned char* vb_ = lds + 2 * KBUF + (vbuf) * VBUF; \
            *(LAS u32x4*)(kb_ + krow_t * KROW + kch * 16) = K0; *(LAS u32x4*)(kb_ + (krow_t + 32) * KROW + kch * 16) = K1; \
            *(LAS u32x4*)(vb_ + vrow_t * VROW + vch * 16) = V0; *(LAS u32x4*)(vb_ + (vrow_t + 64) * VROW + vch * 16) = V1; } while (0)
#define ATT_PV(vbuf) do { const LAS unsigned char* vb_ = lds + 2 * KBUF + (vbuf) * VBUF; \
            _Pragma("unroll") for (int kstep = 0; kstep < 4; ++kstep) { const bf16x8 pf = __builtin_bit_cast(bf16x8, pw[kstep]); \
                _Pragma("unroll") for (int d = 0; d < 4; ++d) { const bf16x8 vf = *(const LAS bf16x8*)(vb_ + (32 * d + r32) * VROW + kstep * 32 + hi * 16); \
                    o[d] = __builtin_amdgcn_mfma_f32_32x32x16_bf16(vf, pf, o[d], 0, 0, 0); } } } while (0)
#define ATT_BAR() asm volatile("s_waitcnt lgkmcnt(0)\n\ts_barrier" ::: "memory")
        const bool late = wid >= 4;
        u32x4 pw[4];
#pragma unroll
        for (int i = 0; i < 4; ++i) pw[i] = (u32x4){0u, 0u, 0u, 0u};
        u32x4 ka0, ka1, va0, va1, kb0, kb1, vb0, vb1;
        ATT_LOAD(ka0, ka1, va0, va1, 0); ATT_STORE(ka0, ka1, va0, va1, 0, 0); ATT_LOAD(ka0, ka1, va0, va1, 1); __syncthreads();
        int vprev = 2, vcur = 0, vnext = 1;
#define ATT_TILE(j, SK0, SK1, SV0, SV1, LK0, LK1, LV0, LV1) do { \
            const int cur = (j) & 1; \
            if ((j) + 2 < NT) ATT_LOAD(LK0, LK1, LV0, LV1, (j) + 2); \
            if (late && (j) > 0) ATT_PV(vprev); \
            const LAS unsigned char* kb_ = lds + cur * KBUF; \
            f32x16 s[2]; \
            _Pragma("unroll") for (int kb = 0; kb < 2; ++kb) { \
                _Pragma("unroll") for (int r = 0; r < 16; ++r) s[kb][r] = 0.f; \
                _Pragma("unroll") for (int ks = 0; ks < 4; ++ks) { const bf16x8 kf = *(const LAS bf16x8*)(kb_ + (32 * kb + kappa) * KROW + mp * 128 + ks * 32 + hi * 16); \
                    s[kb] = __builtin_amdgcn_mfma_f32_32x32x16_bf16(kf, qf[ks], s[kb], 0, 0, 0); } } \
            float mx = s[0][0]; \
            _Pragma("unroll") for (int r = 1; r < 16; ++r) mx = fmaxf(mx, s[0][r]); \
            _Pragma("unroll") for (int r = 0; r < 16; ++r) mx = fmaxf(mx, s[1][r]); \
            mx = fmaxf(mx, xor32_get(mx, xaddr)); \
            const float mnew = fmaxf(mrun, mx); \
            if (__any(mnew > mrun)) { \
                const float alpha = __builtin_amdgcn_exp2f(mrun - mnew); lrun *= alpha; \
                _Pragma("unroll") for (int d = 0; d < 4; ++d) _Pragma("unroll") for (int r = 0; r < 16; ++r) o[d][r] *= alpha; \
                mrun = mnew; } \
            float psum = 0.f; \
            _Pragma("unroll") for (int kb = 0; kb < 2; ++kb) _Pragma("unroll") for (int r = 0; r < 16; ++r) { const float pv = __builtin_amdgcn_exp2f(s[kb][r] - mrun); s[kb][r] = pv; psum += pv; } \
            lrun += psum; \
            _Pragma("unroll") for (int kb = 0; kb < 2; ++kb) _Pragma("unroll") for (int g = 0; g < 2; ++g) { \
                    u32x4 w4; w4.x = pg8::cvt_pk_bf16(s[kb][8 * g + 0], s[kb][8 * g + 1]); w4.y = pg8::cvt_pk_bf16(s[kb][8 * g + 2], s[kb][8 * g + 3]); \
                    w4.z = pg8::cvt_pk_bf16(s[kb][8 * g + 4], s[kb][8 * g + 5]); w4.w = pg8::cvt_pk_bf16(s[kb][8 * g + 6], s[kb][8 * g + 7]); \
                    pw[2 * kb + g] = w4; } \
            if (!late) ATT_PV(vcur); \
            if ((j) + 1 < NT) ATT_STORE(SK0, SK1, SV0, SV1, cur ^ 1, vnext); \
            ATT_BAR(); \
            { const int t_ = vprev; vprev = vcur; vcur = vnext; vnext = t_; } } while (0)
        for (int j = 0; j < NT; j += 2) {
            ATT_TILE(j, ka0, ka1, va0, va1, kb0, kb1, vb0, vb1);
            ATT_TILE(j + 1, kb0, kb1, vb0, vb1, ka0, ka1, va0, va1);
        }
#undef ATT_TILE
#undef ATT_BAR
        if (late) ATT_PV(vprev);
        __syncthreads();
#undef ATT_LOAD
#undef ATT_STORE
#undef ATT_PV
        const float ltot = lrun + xor32_get(lrun, xaddr); const float inv = 1.f / ltot;
        LAS float* xch = (LAS float*)lds + pr * 4096;
        if (mp == 1) { const float f = inv * lam;
#pragma unroll
            for (int d = 0; d < 4; ++d)
#pragma unroll
                for (int r = 0; r < 16; ++r) xch[(d * 16 + r) * 64 + lane] = o[d][r] * f; }
        __syncthreads();
        if (mp == 0) {
            float ss = 0.f;
#pragma unroll
            for (int d = 0; d < 4; ++d)
#pragma unroll
                for (int r = 0; r < 16; ++r) { const float dv = o[d][r] * inv - xch[(d * 16 + r) * 64 + lane]; o[d][r] = dv; ss += dv * dv; }
            ss += xor32_get(ss, xaddr);
            const float rn = (1.f / sqrtf(ss * (1.f / 128.f) + 1e-5f)) * 0.8f;
            bf16* orow = act + (size_t)(b * SEQ + qb * 128 + pr * 32 + r32) * DM + h * 128;
#pragma unroll
            for (int d = 0; d < 4; ++d)
#pragma unroll
                for (int j4 = 0; j4 < 4; ++j4) { const int dv0 = 32 * d + 8 * j4 + 4 * hi; const f32x4 g = *(const f32x4*)(subln + dv0);
                    u32x2 w; w.x = pk2(o[d][4 * j4 + 0] * rn * g.x, o[d][4 * j4 + 1] * rn * g.y); w.y = pk2(o[d][4 * j4 + 2] * rn * g.z, o[d][4 * j4 + 3] * rn * g.w);
                    *(u32x2*)(orow + dv0) = w; }
        }
        __syncthreads();
    }
}

__device__ __forceinline__ void sgu_phase(const LArgs& a, LAS unsigned char* lds) {
    const int tid = opaque_tid(), lane = tid & 63, wid = tid >> 6;
    LAS float* Ws = (LAS float*)lds; LAS float* VV = Ws + 128 * 128;
    const bf16* Ug = (const bf16*)(a.ws + WS_U); const bf16* Gg = (const bf16*)(a.ws + WS_G); bf16* act = (bf16*)(a.ws + WS_H);
    for (int u = blockIdx.x; u < 2048; u += gridDim.x) {
        const int g = u & 7, row0 = (u >> 3) * 128;
        const f32x4* wsrc = (const f32x4*)(a.in(I_ESW) + (size_t)g * 16384);
#pragma unroll
        for (int i = 0; i < 8; ++i) ((LAS f32x4*)Ws)[tid + NTHR * i] = wsrc[tid + NTHR * i];
        const float ng0 = a.in(I_ESNG)[g * 128 + 2 * lane], ng1 = a.in(I_ESNG)[g * 128 + 2 * lane + 1], nb0 = a.in(I_ESNB)[g * 128 + 2 * lane], nb1 = a.in(I_ESNB)[g * 128 + 2 * lane + 1];
#pragma unroll
        for (int rr = 0; rr < 16; ++rr) {
            const int r = wid * 16 + rr; const unsigned pk = *(const unsigned*)(Gg + (size_t)(row0 + r) * 1024 + g * 128 + 2 * lane);
            const float x0 = bf2f(pk & 0xffffu), x1 = bf2f(pk >> 16);
            const float mean = wave_sum(x0 + x1) * (1.f / 128.f); const float d0 = x0 - mean, d1 = x1 - mean;
            const float rstd = 1.f / sqrtf(wave_sum(d0 * d0 + d1 * d1) * (1.f / 128.f) + 1e-5f);
            *(LAS f32x2*)(VV + r * 128 + 2 * lane) = (f32x2){d0 * rstd * ng0 + nb0, d1 * rstd * ng1 + nb1};
        }
        __syncthreads();
        const int c0 = 4 * (tid & 31), p0 = 8 * (tid >> 5);
        f32x4 acc[8];
#pragma unroll
        for (int i = 0; i < 8; ++i) acc[i] = (f32x4){0.f, 0.f, 0.f, 0.f};
        for (int q = 0; q < 128; q += 4) {
            f32x4 v[4];
#pragma unroll
            for (int qq = 0; qq < 4; ++qq) v[qq] = *(const LAS f32x4*)(VV + (q + qq) * 128 + c0);
#pragma unroll
            for (int i = 0; i < 8; ++i) { const f32x4 w = *(const LAS f32x4*)(Ws + (p0 + i) * 128 + q); acc[i] += v[0] * w.x + v[1] * w.y + v[2] * w.z + v[3] * w.w; }
        }
#pragma unroll
        for (int i = 0; i < 8; ++i) {
            const int p = p0 + i; const float bs = a.in(I_ESB)[g * 128 + p];
            const u32x2 uu = *(const u32x2*)(Ug + (size_t)(row0 + p) * 1024 + g * 128 + c0);
            const f32x4 o = (f32x4){bf2f(uu.x & 0xffffu), bf2f(uu.x >> 16), bf2f(uu.y & 0xffffu), bf2f(uu.y >> 16)} * (acc[i] + bs);
            u32x2 w; w.x = pk2(o.x, o.y); w.y = pk2(o.z, o.w);
            *(u32x2*)(act + (size_t)(row0 + p) * DM + 1024 + g * 128 + c0) = w;
        }
        __syncthreads();
    }
}

__device__ __forceinline__ void bfly_fwd(f32x2& x0, f32x2& x1, f32x2& x2, f32x2& x3, const f32x2 w1) {
    const f32x2 w2 = cmul(w1, w1);
    const f32x2 y0 = x0 + x2, y1 = x1 + x3, y2 = cmul(x0 - x2, w1), t = cmul(x1 - x3, w1); const f32x2 y3 = {t.y, -t.x};
    x0 = y0 + y1; x1 = cmul(y0 - y1, w2); x2 = y2 + y3; x3 = cmul(y2 - y3, w2);
}
__device__ __forceinline__ void bfly_inv(f32x2& x0, f32x2& x1, f32x2& x2, f32x2& x3, const f32x2 w2) {
    const f32x2 w = cmul(w2, w2);
    const f32x2 t1 = cmul(x1, w), t3 = cmul(x3, w);
    const f32x2 y0 = x0 + t1, y1 = x0 - t1, y2 = x2 + t3, y3 = x2 - t3;
    const f32x2 u2 = cmul(y2, w2), u3 = cmul(y3, w2); const f32x2 u3i = {-u3.y, u3.x};
    x0 = y0 + u2; x1 = y1 + u3i; x2 = y0 - u2; x3 = y1 - u3i;
}
__device__ __forceinline__ void fft_fwd(LAS f32x2* X, int tid) {
    const f32x2 R1 = {0.92387953251128674f, -0.38268343236508977f}, R2 = {0.70710678118654752f, -0.70710678118654752f}, R3 = {0.38268343236508977f, -0.92387953251128674f};
    for (int lgb = 10; lgb >= 2; lgb -= 4) {
        const int h = 1 << lgb; const float inv16h = 1.f / (float)(16 * h);
#pragma unroll 2
        for (int G = tid; G < 1024; G += NTHR) {
            const int j = G & (h - 1), base = ((G >> lgb) << (lgb + 4)) + j;
            f32x2 x[4][4];
#pragma unroll
            for (int a = 0; a < 4; ++a)
#pragma unroll
                for (int bb = 0; bb < 4; ++bb) x[a][bb] = X[base + a * 4 * h + bb * h];
            const float rev = (float)j * inv16h; const f32x2 wb = {__builtin_amdgcn_cosf(rev), -__builtin_amdgcn_sinf(rev)};
            bfly_fwd(x[0][0], x[1][0], x[2][0], x[3][0], wb);
            bfly_fwd(x[0][1], x[1][1], x[2][1], x[3][1], cmul(wb, R1));
            bfly_fwd(x[0][2], x[1][2], x[2][2], x[3][2], cmul(wb, R2));
            bfly_fwd(x[0][3], x[1][3], x[2][3], x[3][3], cmul(wb, R3));
            const f32x2 wb2 = cmul(wb, wb), wl = cmul(wb2, wb2);
#pragma unroll
            for (int a = 0; a < 4; ++a) bfly_fwd(x[a][0], x[a][1], x[a][2], x[a][3], wl);
#pragma unroll
            for (int a = 0; a < 4; ++a)
#pragma unroll
                for (int bb = 0; bb < 4; ++bb) X[base + a * 4 * h + bb * h] = x[a][bb];
        }
        __syncthreads();
    }
#pragma unroll 4
    for (int q = tid; q < 4096; q += NTHR) {
        const int i0 = 4 * q; f32x2 x0 = X[i0], x1 = X[i0 + 1], x2 = X[i0 + 2], x3 = X[i0 + 3];
        bfly_fwd(x0, x1, x2, x3, (f32x2){1.f, 0.f});
        X[i0] = x0; X[i0 + 1] = x1; X[i0 + 2] = x2; X[i0 + 3] = x3;
    }
    __syncthreads();
}
__device__ __forceinline__ void fft_inv(LAS f32x2* X, int tid) {
    const f32x2 R1 = {0.92387953251128674f, 0.38268343236508977f}, R2 = {0.70710678118654752f, 0.70710678118654752f}, R3 = {0.38268343236508977f, 0.92387953251128674f};
    for (int lga = 0; lga <= 8; lga += 4) {
        const int h = 1 << lga; const float inv16h = 1.f / (float)(16 * h);
#pragma unroll 2
        for (int G = tid; G < 1024; G += NTHR) {
            const int j = G & (h - 1), base = ((G >> lga) << (lga + 4)) + j;
            f32x2 x[4][4];
#pragma unroll
            for (int a = 0; a < 4; ++a)
#pragma unroll
                for (int bb = 0; bb < 4; ++bb) x[a][bb] = X[base + a * 4 * h + bb * h];
            const float rev = (float)j * inv16h; const f32x2 wb = {__builtin_amdgcn_cosf(rev), __builtin_amdgcn_sinf(rev)};
            const f32x2 wb2 = cmul(wb, wb), wl = cmul(wb2, wb2);
#pragma unroll
            for (int a = 0; a < 4; ++a) bfly_inv(x[a][0], x[a][1], x[a][2], x[a][3], wl);
            bfly_inv(x[0][0], x[1][0], x[2][0], x[3][0], wb);
            bfly_inv(x[0][1], x[1][1], x[2][1], x[3][1], cmul(wb, R1));
            bfly_inv(x[0][2], x[1][2], x[2][2], x[3][2], cmul(wb, R2));
            bfly_inv(x[0][3], x[1][3], x[2][3], x[3][3], cmul(wb, R3));
#pragma unroll
            for (int a = 0; a < 4; ++a)
#pragma unroll
                for (int bb = 0; bb < 4; ++bb) X[base + a * 4 * h + bb * h] = x[a][bb];
        }
        __syncthreads();
    }
#pragma unroll 4
    for (int q = tid; q < 4096; q += NTHR) {
        f32x2 x0 = X[q], x1 = X[q + 4096], x2 = X[q + 8192], x3 = X[q + 12288];
        const float rev = (float)q * (1.f / 16384.f);
        bfly_inv(x0, x1, x2, x3, (f32x2){__builtin_amdgcn_cosf(rev), __builtin_amdgcn_sinf(rev)});
        X[q] = x0; X[q + 4096] = x1; X[q + 8192] = x2; X[q + 12288] = x3;
    }
    __syncthreads();
}
__device__ __forceinline__ void pointwise_filter(const LAS f32x2* X, f32x4* Hs, float scale, int tid) {
#pragma unroll 2
    for (int s = tid; s < 8192; s += NTHR) {
        if (s == 0) { const f32x2 A = X[0], Cm = X[1]; Hs[0] = (f32x4){(A.x + A.y) * scale, (A.x - A.y) * scale, Cm.x * scale, -Cm.y * scale}; }
        else {
            const int i1 = 2 * s, i2 = i1 ^ ((1 << (31 - __clz(i1))) - 1); const int p = (int)(__brev((unsigned)i1) >> 18);
            const f32x2 A = X[i1], B = X[i2];
            const f32x2 E = {0.5f * (A.x + B.x), 0.5f * (A.y - B.y)}; const f32x2 Dm = {A.x - B.x, A.y + B.y}; const f32x2 O = {0.5f * Dm.y, -0.5f * Dm.x};
            const float rev = (float)p * (1.f / 32768.f); const float c = __builtin_amdgcn_cosf(rev), sn = __builtin_amdgcn_sinf(rev);
            const f32x2 WO = cmul((f32x2){c, -sn}, O);
            Hs[s] = (f32x4){(E.x + WO.x) * scale, (E.y + WO.y) * scale, (E.x - WO.x) * scale, -(E.y - WO.y) * scale};
        }
    }
    __syncthreads();
}
__device__ __forceinline__ void pointwise_data(LAS f32x2* X, const f32x4* Hs, int tid) {
#pragma unroll 4
    for (int s = tid; s < 8192; s += NTHR) {
        const f32x4 hh = Hs[s];
        if (s == 0) {
            const f32x2 A = X[0]; const float Y0 = (A.x + A.y) * hh.x, YM = (A.x - A.y) * hh.y; X[0] = (f32x2){0.5f * (Y0 + YM), 0.5f * (Y0 - YM)};
            const f32x2 Cm = X[1]; const f32x2 Y = cmul((f32x2){Cm.x, -Cm.y}, (f32x2){hh.z, hh.w}); X[1] = (f32x2){Y.x, -Y.y};
        } else {
            const int i1 = 2 * s, i2 = i1 ^ ((1 << (31 - __clz(i1))) - 1); const int p = (int)(__brev((unsigned)i1) >> 18);
            const f32x2 A = X[i1], B = X[i2];
            const f32x2 E = {0.5f * (A.x + B.x), 0.5f * (A.y - B.y)}; const f32x2 Dm = {A.x - B.x, A.y + B.y}; const f32x2 O = {0.5f * Dm.y, -0.5f * Dm.x};
            const float rev = (float)p * (1.f / 32768.f); const float c = __builtin_amdgcn_cosf(rev), sn = __builtin_amdgcn_sinf(rev);
            const f32x2 WO = cmul((f32x2){c, -sn}, O);
            const f32x2 Xk = E + WO; const f32x2 Xk2 = {E.x - WO.x, -(E.y - WO.y)};
            const f32x2 Yk = cmul(Xk, (f32x2){hh.x, hh.y}), Yk2 = cmul(Xk2, (f32x2){hh.z, hh.w});
            const f32x2 Ye = {0.5f * (Yk.x + Yk2.x), 0.5f * (Yk.y - Yk2.y)}; const f32x2 Dd = {Yk.x - Yk2.x, Yk.y + Yk2.y};
            const f32x2 Yo = cmul((f32x2){0.5f * c, 0.5f * sn}, Dd);
            X[i1] = (f32x2){Ye.x - Yo.y, Ye.y + Yo.x}; X[i2] = (f32x2){Ye.x + Yo.y, Yo.x - Ye.y};
        }
    }
    __syncthreads();
}
__device__ __forceinline__ void h8_to_f(const u32x4 raw, float* e) {
#pragma unroll
    for (int i = 0; i < 4; ++i) { const unsigned w = raw[i];
        e[2 * i] = (float)__builtin_bit_cast(_Float16, (unsigned short)(w & 0xffffu)); e[2 * i + 1] = (float)__builtin_bit_cast(_Float16, (unsigned short)(w >> 16)); }
}
struct Z10 { u32x4 raw; _Float16 zm, zp; };
__device__ __forceinline__ Z10 sconv8_load(const _Float16* z, int t0) {
    Z10 r; r.raw = *(const u32x4*)(z + t0); r.zm = z[t0 > 0 ? t0 - 1 : 0]; r.zp = z[t0 + 8 < SEQ ? t0 + 8 : SEQ - 1]; return r;
}
__device__ __forceinline__ void sconv8_calc(const Z10& r, int t0, float w0, float w1, float w2, float bias, float* y) {
    float e[10]; e[0] = t0 > 0 ? (float)r.zm : 0.f; e[9] = (t0 + 8 < SEQ) ? (float)r.zp : 0.f; h8_to_f(r.raw, e + 1);
#pragma unroll
    for (int i = 0; i < 8; ++i) y[i] = bias + w0 * e[i] + w1 * e[i + 1] + w2 * e[i + 2];
}
constexpr size_t HY_WG_BYTES = 262144 + 65536;
__device__ __forceinline__ void hyena_phase(const LArgs& a, LAS unsigned char* lds) {
    const int tid0 = opaque_tid(), lane = tid0 & 63, wid = tid0 >> 6;
    LAS f32x2* X = (LAS f32x2*)lds; LAS float* red = (LAS float*)(lds + 131072);
    const _Float16* ZT = (const _Float16*)(a.ws + WS_OV); const _Float16* KT = (const _Float16*)a.out;
    bf16* YT = (bf16*)(a.ws + WS_H);
    f32x4* Hs = (f32x4*)(a.ws + WS_HYSCR + (size_t)blockIdx.x * HY_WG_BYTES); f32x4* Ys = Hs + 16384;
    const float* cw = a.in(I_OCW); const float* cb = a.in(I_OCB);
    for (int c = blockIdx.x; c < 2048; c += gridDim.x) {
        int tid = tid0; asm volatile("" : "+v"(tid));
        const float dkc = -__builtin_fabsf(MIN_DECAY_F + (float)c * ((MAX_DECAY_F - MIN_DECAY_F) / 2047.f)) * (1.4426950408889634f / 16383.f);
        for (int n = 0; n < 2; ++n) {
            const _Float16* fw = KT + (size_t)(n * 4096 + c) * SEQ; const _Float16* bw = KT + (size_t)(n * 4096 + 2048 + c) * SEQ;
            float l1 = 0.f;
            u32x4 rf[4], rb[4]; _Float16 rt[4];
#pragma unroll
            for (int j = 0; j < 4; ++j) { const int mm0 = 4 * (tid + NTHR * j); rf[j] = *(const u32x4*)(fw + 2 * mm0); rb[j] = *(const u32x4*)(bw + 16376 - 2 * mm0); rt[j] = bw[mm0 > 0 ? 16384 - 2 * mm0 : 16383]; }
#pragma unroll
            for (int j = 0; j < 4; ++j) {
                const int mm0 = 4 * (tid + NTHR * j);
                float e[8], cc[8]; h8_to_f(rf[j], e); h8_to_f(rb[j], cc);
                float top = mm0 > 0 ? (float)rt[j] : 0.f;
                {
                    const float tf = (float)(2 * mm0), tb = (float)(16376 - 2 * mm0);
#pragma unroll
                    for (int i = 0; i < 8; ++i) { e[i] *= __builtin_amdgcn_exp2f(dkc * (tf + (float)i)); cc[i] *= __builtin_amdgcn_exp2f(dkc * (tb + (float)i)); }
                    top *= __builtin_amdgcn_exp2f(dkc * (tb + 8.f));
                }
#pragma unroll
                for (int i = 0; i < 8; ++i) l1 += __builtin_fabsf(e[i]);
#pragma unroll
                for (int i = 1; i < 8; ++i) l1 += __builtin_fabsf(cc[i]);
                l1 += __builtin_fabsf(top);
                *(LAS f32x4*)(X + mm0) = (f32x4){e[0], e[1], e[2], e[3]}; *(LAS f32x4*)(X + mm0 + 2) = (f32x4){e[4], e[5], e[6], e[7]};
                *(LAS f32x4*)(X + 8192 + mm0) = (f32x4){top, cc[7], cc[6], cc[5]}; *(LAS f32x4*)(X + 8192 + mm0 + 2) = (f32x4){cc[4], cc[3], cc[2], cc[1]};
            }
            l1 = wave_sum(l1); if (lane == 0) red[wid] = l1;
            __syncthreads();
            float tot = 0.f;
#pragma unroll
            for (int w = 0; w < NWAVES; ++w) tot += red[w];
            fft_fwd(X, tid);
            pointwise_filter(X, Hs + n * 8192, 1.f / (16384.f * tot), tid);
        }
        const float w00 = cw[c], w01 = cw[HY_IN + c], w02 = cw[2 * HY_IN + c], b0 = cb[c];
        const float w10 = cw[2048 + c], w11 = cw[HY_IN + 2048 + c], w12 = cw[2 * HY_IN + 2048 + c], b1 = cb[2048 + c];
        const float w20 = cw[4096 + c], w21 = cw[HY_IN + 4096 + c], w22 = cw[2 * HY_IN + 4096 + c], b2 = cb[4096 + c];
        const float fb0 = a.in(I_FBIAS)[c], fb1 = a.in(I_FBIAS)[2048 + c];
        for (int b = 0; b < NB; ++b) {
            const _Float16* zv = ZT + (size_t)c * MLAT + b * SEQ; const _Float16* zx1 = ZT + (size_t)(2048 + c) * MLAT + b * SEQ; const _Float16* zx2 = ZT + (size_t)(4096 + c) * MLAT + b * SEQ;
            {
                Z10 zr[4];
#pragma unroll
                for (int j = 0; j < 4; ++j) zr[j] = sconv8_load(zv, 8 * (tid + NTHR * j));
#pragma unroll
                for (int j = 0; j < 4; ++j) { const int mm0 = 4 * (tid + NTHR * j); float y[8]; sconv8_calc(zr[j], 2 * mm0, w00, w01, w02, b0, y);
                    *(LAS f32x4*)(X + mm0) = (f32x4){y[0], y[1], y[2], y[3]}; *(LAS f32x4*)(X + mm0 + 2) = (f32x4){y[4], y[5], y[6], y[7]};
                    *(LAS f32x4*)(X + 8192 + mm0) = (f32x4){0.f, 0.f, 0.f, 0.f}; *(LAS f32x4*)(X + 8192 + mm0 + 2) = (f32x4){0.f, 0.f, 0.f, 0.f}; }
            }
            __syncthreads();
            fft_fwd(X, tid); pointwise_data(X, Hs, tid); fft_inv(X, tid);
            Z10 za[4], zb[4];
#pragma unroll
            for (int j = 0; j < 4; ++j) { za[j] = sconv8_load(zv, 8 * (tid + NTHR * j)); zb[j] = sconv8_load(zx1, 8 * (tid + NTHR * j)); }
#pragma unroll
            for (int j = 0; j < 4; ++j) { const int mm0 = 4 * (tid + NTHR * j); float y0[8], g[8]; sconv8_calc(za[j], 2 * mm0, w00, w01, w02, b0, y0); sconv8_calc(zb[j], 2 * mm0, w10, w11, w12, b1, g);
                const f32x4 r0 = *(const LAS f32x4*)(X + mm0), r1 = *(const LAS f32x4*)(X + mm0 + 2);
                const f32x4 o0 = (f32x4){g[0], g[1], g[2], g[3]} * (r0 + (f32x4){y0[0], y0[1], y0[2], y0[3]} * fb0), o1 = (f32x4){g[4], g[5], g[6], g[7]} * (r1 + (f32x4){y0[4], y0[5], y0[6], y0[7]} * fb0);
                *(LAS f32x4*)(X + mm0) = o0; *(LAS f32x4*)(X + mm0 + 2) = o1; Ys[mm0 / 2] = o0; Ys[mm0 / 2 + 1] = o1;
                *(LAS f32x4*)(X + 8192 + mm0) = (f32x4){0.f, 0.f, 0.f, 0.f}; *(LAS f32x4*)(X + 8192 + mm0 + 2) = (f32x4){0.f, 0.f, 0.f, 0.f}; }
            __syncthreads();
            fft_fwd(X, tid); pointwise_data(X, Hs + 8192, tid); fft_inv(X, tid);
#pragma unroll
            for (int j = 0; j < 4; ++j) za[j] = sconv8_load(zx2, 8 * (tid + NTHR * j));
            f32x4 qv[4][2];
#pragma unroll
            for (int j = 0; j < 4; ++j) { const int mm0 = 4 * (tid + NTHR * j); qv[j][0] = Ys[mm0 / 2]; qv[j][1] = Ys[mm0 / 2 + 1]; }
#pragma unroll
            for (int j = 0; j < 4; ++j) { const int mm0 = 4 * (tid + NTHR * j); float g[8]; sconv8_calc(za[j], 2 * mm0, w20, w21, w22, b2, g);
                const f32x4 r0 = *(const LAS f32x4*)(X + mm0), r1 = *(const LAS f32x4*)(X + mm0 + 2);
                const f32x4 o0 = (f32x4){g[0], g[1], g[2], g[3]} * (r0 + qv[j][0] * fb1), o1 = (f32x4){g[4], g[5], g[6], g[7]} * (r1 + qv[j][1] * fb1);
                u32x4 w; w.x = pk2(o0.x, o0.y); w.y = pk2(o0.z, o0.w); w.z = pk2(o1.x, o1.y); w.w = pk2(o1.z, o1.w);
                *(u32x4*)(YT + (size_t)c * MLAT + b * SEQ + 2 * mm0) = w; }
            __syncthreads();
        }
    }
}
__device__ __forceinline__ void transpose_phase(const LArgs& a, LAS unsigned char* lds) {
    const int tid = opaque_tid(), lane = tid & 63, wid = tid >> 6, gw = blockIdx.x * NWAVES + wid, NGW = gridDim.x * NWAVES;
    const bf16* YT = (const bf16*)(a.ws + WS_H); bf16* Y = (bf16*)(a.ws + WS_OV);
    LAS bf16* T = (LAS bf16*)(lds + wid * 16384);
    for (int it = gw; it < 32 * 512; it += NGW) {
        const int c0 = (it & 31) * 64, t0 = (it >> 5) * 64;
#pragma unroll
        for (int i = 0; i < 8; ++i) { const int ch = 8 * i + (lane >> 3), k = lane & 7; *(LAS u32x4*)(T + ch * 72 + 8 * k) = *(const u32x4*)(YT + (size_t)(c0 + ch) * MLAT + t0 + 8 * k); }
        asm volatile("s_waitcnt vmcnt(0) lgkmcnt(0)" ::: "memory");
#pragma unroll
        for (int i = 0; i < 8; ++i) { const int t = 8 * i + (lane >> 3), k = lane & 7; unsigned short e[8];
#pragma unroll
            for (int q = 0; q < 8; ++q) e[q] = T[(8 * k + q) * 72 + t];
            u32x4 w; w.x = e[0] | ((unsigned)e[1] << 16); w.y = e[2] | ((unsigned)e[3] << 16); w.z = e[4] | ((unsigned)e[5] << 16); w.w = e[6] | ((unsigned)e[7] << 16);
            *(u32x4*)(Y + (size_t)(t0 + t) * DM + c0 + 8 * k) = w; }
        asm volatile("s_waitcnt lgkmcnt(0)" ::: "memory");
    }
}

#define XB_TMO      128
#define XB_XCNT(j)  (256  + 64 * (j))
#define XB_XSUB(j)  (1280 + 64 * (j))
#define XB_XGEN(j)  (2304 + 64 * (j))
#define XB_TOP      3328
#define XB_TOPGEN   3392
#define XCD_BAR_WORDS 3456
#define XB_SPIN_CAP (1u << 18)

__device__ __forceinline__ unsigned xb_ld(unsigned* p)              { return __hip_atomic_load(p, __ATOMIC_RELAXED, __HIP_MEMORY_SCOPE_AGENT); }
__device__ __forceinline__ unsigned xb_add(unsigned* p, unsigned v) { return __hip_atomic_fetch_add(p, v, __ATOMIC_RELAXED, __HIP_MEMORY_SCOPE_AGENT); }
__device__ __forceinline__ unsigned xb_xcc_id() { return (unsigned)__builtin_amdgcn_s_getreg((3 << 11) | 20) & 0xFu; }
#define XB_SPIN(cond, bar) do { unsigned _sp = 0; while (cond) { __builtin_amdgcn_s_sleep(1); \
    if ((++_sp & 255u) == 0u) { if (xb_ld(&(bar)[XB_TMO])) break; if (_sp > XB_SPIN_CAP) { atomicAdd(&(bar)[XB_TMO], 1u); break; } } } } while (0)

struct XcdBarrier {
    unsigned* bar; unsigned x;
    volatile LAS unsigned* st;
};

__device__ __forceinline__ XcdBarrier xcd_barrier_post(unsigned* bar, volatile LAS unsigned* st) {
    XcdBarrier b; b.bar = bar; b.x = xb_xcc_id(); b.st = st;
    if (threadIdx.x == 0) (void)xb_add(&bar[XB_XCNT(b.x)], 1u);
    return b;
}
__device__ __forceinline__ void xcd_barrier_complete(unsigned* bar, unsigned x, unsigned& nloc, unsigned& nx) {
    const unsigned G = gridDim.x * gridDim.y * gridDim.z;
    unsigned sum, cnt, mine, sp = 0u;
    for (;;) {
        sum = 0u; cnt = 0u; mine = 0u;
#pragma unroll
        for (unsigned j = 0; j < 16; ++j) { const unsigned c = xb_ld(&bar[XB_XCNT(j)]); sum += c; cnt += (c > 0u) ? 1u : 0u; mine = (j == x) ? c : mine; }
        if (sum == G) break;
        __builtin_amdgcn_s_sleep(1);
        if ((++sp & 255u) == 0u) { if (xb_ld(&bar[XB_TMO])) break; if (sp > XB_SPIN_CAP) { atomicAdd(&bar[XB_TMO], 1u); break; } }
    }
    nloc = mine > 0u ? mine : 1u; nx = cnt > 0u ? cnt : 1u;
}

__device__ __forceinline__ void xcd_barrier(const XcdBarrier& b) {
    asm volatile("s_waitcnt vmcnt(0)" ::: "memory");
    __syncthreads();
    if (threadIdx.x == 0) {
        unsigned* bar = b.bar;
        __builtin_amdgcn_s_waitcnt(0);
        unsigned nloc = b.st[0], nx = b.st[1];
        if (nloc == 0u) { xcd_barrier_complete(bar, b.x, nloc, nx); b.st[0] = nloc; b.st[1] = nx; }
        const unsigned old = xb_add(&bar[XB_XSUB(b.x)], 1u);
        const unsigned gen = old / nloc;
        if (old + 1u == (gen + 1u) * nloc) {
            __builtin_amdgcn_fence(__ATOMIC_RELEASE, "agent");
            asm volatile("s_waitcnt vmcnt(0)" ::: "memory");
            const unsigned og = xb_add(&bar[XB_TOP], 1u);
            const unsigned tg = og / nx;
            if (og + 1u == (tg + 1u) * nx) xb_add(&bar[XB_TOPGEN], 1u);
            else XB_SPIN(xb_ld(&bar[XB_TOPGEN]) == tg, bar);
            __builtin_amdgcn_fence(__ATOMIC_ACQUIRE, "agent");
            xb_add(&bar[XB_XGEN(b.x)], 1u);
            asm volatile("s_waitcnt vmcnt(0)" ::: "memory");
        } else {
            XB_SPIN(xb_ld(&bar[XB_XGEN(b.x)]) == gen, bar);
            __builtin_amdgcn_fence(__ATOMIC_ACQUIRE, "agent");
            asm volatile("s_waitcnt vmcnt(0)" ::: "memory");
        }
    }
    __syncthreads();
}

constexpr size_t WS_BAR = 524288;
constexpr int XB_LDS_OFF = TAB_OFF + 512;
constexpr int N_PHASES = 20;
constexpr unsigned SYNC_AFTER = 0xFFFFFu & ~((1u << 2) | (1u << 3) | (1u << 5) | (1u << 19));
#ifndef PHSEL
#define PHSEL 0xfffff
#endif
#define PHON(k) ((PHSEL >> (k)) & 1)
__global__ void __launch_bounds__(NTHR, 2) mega_fwd(Args a_in) {
    extern __shared__ __attribute__((aligned(16))) unsigned char lds[];
    PG8_LAS unsigned char* ldsl = (PG8_LAS unsigned char*)lds;
    const int G = gridDim.x, cid = blockIdx.x;
    LAS unsigned long long* tab = (LAS unsigned long long*)(ldsl + TAB_OFF);
    if (threadIdx.x == 0) {
#pragma unroll
        for (int i = 0; i < 33; ++i) tab[i] = (unsigned long long)a_in.in[i];
        tab[33] = (unsigned long long)a_in.out; tab[34] = (unsigned long long)a_in.ws;
    }
    if (threadIdx.x == 0) { ((LAS unsigned*)(ldsl + XB_LDS_OFF))[0] = 0u; ((LAS unsigned*)(ldsl + XB_LDS_OFF))[1] = 0u; }
    __syncthreads();
    const int ph_lo = a_in.ph_lo, ph_hi = a_in.ph_hi;
    (void)xcd_barrier_post((unsigned*)(a_in.ws + WS_BAR), (volatile LAS unsigned*)(ldsl + XB_LDS_OFF));
#ifndef REPEAT_MASK
#define REPEAT_MASK 0
#endif
    for (int ph2 = 2 * ph_lo; ph2 < 2 * ph_hi; ++ph2) {
        const int ph = ph2 >> 1;
        if ((ph2 & 1) && !((REPEAT_MASK >> ph) & 1)) continue;
        const bool last_pass = (ph2 & 1) || !((REPEAT_MASK >> ph) & 1);
        unsigned tab_off = TAB_OFF; asm volatile("" : "+s"(tab_off) :: "memory");
        const LAS unsigned long long* tabl = (const LAS unsigned long long*)(ldsl + tab_off);
        const LArgs a{tabl, (float*)(__attribute__((address_space(1))) float*)tab_ld(tabl, 33), (unsigned char*)(__attribute__((address_space(1))) unsigned char*)tab_ld(tabl, 34)};
        unsigned char* ws = a.ws;
        const float* mods = (const float*)(ws + WS_MODS);
        const int layer = ph >= 11 ? 1 : 0;
        const float* modsL = mods + (size_t)layer * 3 * 12288;
        switch (ph) {
        case 0: if (PHON(0)) p0_prologue(a, ldsl); break;
        case 1: if (PHON(1)) prenorm_rows<0>(a, MALL, a.in(I_NORM1), modsL, 0, (bf16*)(ws + WS_H)); break;
        case 2: if (PHON(2)) {
            {
                pg8::Gemm g{(const bf16*)(ws + WS_H), (const bf16*)(ws + WS_WIN), MALL, 1024, 2048};
                pg8::EpiIn0 E; E.out0 = (bf16*)(ws + WS_K); E.grp_stride = 0; E.scale0 = 1.f; E.lat0 = MCTX;
                pg8::StaticOrder S; S.init(g.M, g.N, G, cid);
                pg8::gemm_phase<pg8::EpiIn0, pg8::StaticOrder, true, true>(ldsl, g, S, E);
            }
            {
                pg8::Gemm g{(const bf16*)(ws + WS_H) + (size_t)MCTX * DM, (const bf16*)(ws + WS_WIN) + (size_t)2048 * DM, MLAT, 3072, 2048};
                pg8::EpiIn0 E; E.out0 = (bf16*)(ws + WS_Q); E.grp_stride = (WS_U - WS_Q) / 2; E.scale0 = 0.125f * 1.4426950408889634f; E.lat0 = 0;
                pg8::StaticOrder S; S.init(g.M, g.N, G, cid);
                pg8::gemm_phase<pg8::EpiIn0, pg8::StaticOrder, true, true>(ldsl, g, S, E);
            }
        } break;
        case 3: if (PHON(3)) {
            pg8::Gemm g{(const bf16*)(ws + WS_WIN) + (size_t)1024 * DM, (const bf16*)(ws + WS_H), 1024, MALL, 2048}; pg8::EpiPlain16<0> E; E.O = (bf16*)(ws + WS_VT); E.ldc = MALL;
            pg8::StaticOrder S; S.init(g.M, g.N, G, (cid + G / 2) % G);
            pg8::gemm_phase<pg8::EpiPlain16<0>, pg8::StaticOrder, true, true>(ldsl, g, S, E);
        } break;
        case 4: if (PHON(4)) {
            pg8::Gemm g{(const bf16*)(ws + WS_W4X), (const bf16*)(ws + WS_H3X), 8192, SEQ, 256}; pg8::EpiPlain16<1> E; E.O = (bf16*)a.out; E.ldc = SEQ;
            pg8::StaticOrder S; S.init(g.M, g.N, G, cid);
            pg8::gemm_phase<pg8::EpiPlain16<1>, pg8::StaticOrder, true, true>(ldsl, g, S, E);
        } break;
        case 5: if (PHON(5)) attn_phase(a, ldsl); break;
        case 6: if (PHON(6)) sgu_phase(a, ldsl); break;
        case 7: case 10: case 15: case 18: if (PHON(7)) {
            pg8::Gemm g; pg8::EpiResid E; E.gate_bstride = 12288; E.out = (float*)(ws + WS_X);
            if (ph == 7) { g = pg8::Gemm{(const bf16*)(ws + WS_H), (const bf16*)(ws + WS_WOUT0), MLAT, 2048, 2048}; E.base = a.in(I_X); E.gate = modsL + 2 * 2048; }
            else if (ph == 15) { g = pg8::Gemm{(const bf16*)(ws + WS_OV), (const bf16*)(ws + WS_OOUT), MLAT, 2048, 2048}; E.base = (const float*)(ws + WS_X); E.gate = modsL + 2 * 2048; }
            else { g = pg8::Gemm{(const bf16*)(ws + WS_OV), (const bf16*)(ws + (layer ? WS_WD1 : WS_WD0)), MLAT, 2048, DFF}; E.base = (const float*)(ws + WS_X); E.gate = modsL + 5 * 2048; }
            pg8::StaticOrder S; S.init(g.M, g.N, G, cid);
            pg8::gemm_phase<pg8::EpiResid, pg8::StaticOrder, true, true>(ldsl, g, S, E);
        } break;
        case 8: case 16: if (PHON(8)) prenorm_rows<1>(a, MLAT, a.in(I_NORM2) + layer * DM, modsL, 3, (bf16*)(ws + WS_H)); break;
        case 9: case 17: if (PHON(9)) {
            pg8::Gemm g{(const bf16*)(ws + WS_H), (const bf16*)(ws + (layer ? WS_WGU1 : WS_WGU0)), MLAT, 2 * DFF, 2048}; pg8::EpiSwiglu E; E.O = (bf16*)(ws + WS_OV);
            pg8::StaticOrder S; S.init(g.M, g.N, G, cid);
            pg8::gemm_phase<pg8::EpiSwiglu, pg8::StaticOrder, true, true>(ldsl, g, S, E);
        } break;
        case 11: if (PHON(11)) prenorm_rows<1>(a, MLAT, a.in(I_NORM1) + DM, modsL, 0, (bf16*)(ws + WS_H)); break;
        case 12: if (PHON(12)) {
            pg8::Gemm g{(const bf16*)(ws + WS_OIN), (const bf16*)(ws + WS_H), HY_IN, MLAT, 2048}; pg8::EpiPlain16<1> E; E.O = (bf16*)(ws + WS_OV); E.ldc = MLAT;
            pg8::StaticOrder S; S.init(g.M, g.N, G, cid);
            pg8::gemm_phase<pg8::EpiPlain16<1>, pg8::StaticOrder, true, true>(ldsl, g, S, E);
        } break;
        case 13: if (PHON(13)) hyena_phase(a, ldsl); break;
        case 14: if (PHON(14)) transpose_phase(a, ldsl); break;
        case 19: if (PHON(19)) final_norm_rows(a); break;
        default: break;
        }
        if (ph + 1 < ph_hi && (((SYNC_AFTER >> ph) & 1u) || !last_pass)) { if (ph == 0) cg::this_grid().sync();
            else { XcdBarrier xb; xb.bar = (unsigned*)(a.ws + WS_BAR); xb.x = xb_xcc_id(); xb.st = (volatile LAS unsigned*)(ldsl + XB_LDS_OFF); xcd_barrier(xb); } }
        else if (ph + 1 < ph_hi) __syncthreads();
    }
}

extern "C" void kernel_launch(void* const* d_in, const int* in_sizes, int n_in, void* d_out, int out_size, void* d_ws, size_t ws_size, hipStream_t stream) {
    static int grid = 0;
    if (grid == 0) {
        if (n_in != 33 || out_size != MLAT * DM || ws_size < WS_END) { fprintf(stderr, "kernel_launch: unexpected shapes (n_in %d, out %d, ws %zu)\n", n_in, out_size, ws_size); grid = -1; return; }
        int dev = 0, cus = 0, per_cu = 0;
        hipGetDevice(&dev); hipDeviceGetAttribute(&cus, hipDeviceAttributeMultiprocessorCount, dev);
        hipFuncSetAttribute((const void*)mega_fwd, hipFuncAttributeMaxDynamicSharedMemorySize, LDS_BYTES);
        if (hipOccupancyMaxActiveBlocksPerMultiprocessor(&per_cu, (const void*)mega_fwd, NTHR, LDS_BYTES) != hipSuccess || per_cu < 1) per_cu = 1;
        (void)hipGetLastError();
        grid = cus * per_cu;
    }
    if (grid < 0) return;
    hipMemsetAsync(d_ws, 0, 1 * MiB, stream);
    Args a{};
    for (int i = 0; i < 33; ++i) a.in[i] = (const float*)d_in[i];
    a.out = (float*)d_out; a.ws = (unsigned char*)d_ws;
#if N_LAUNCH_MODE == 1
    a.ph_lo = 0; a.ph_hi = N_PHASES;
    void* args[] = {&a};
    hipError_t e = hipLaunchCooperativeKernel((const void*)mega_fwd, dim3(grid), dim3(NTHR), args, LDS_BYTES, stream);
    if (e != hipSuccess) fprintf(stderr, "cooperative launch failed: %s (grid %d)\n", hipGetErrorString(e), grid);
#else
    for (int ph = 0; ph < N_PHASES; ++ph) { a.ph_lo = ph; a.ph_hi = ph + 1; hipLaunchKernelGGL(mega_fwd, dim3(grid), dim3(NTHR), LDS_BYTES, stream, a); }
#endif
}
```

```cpp
#include <hip/hip_runtime.h>
#include <hip/hip_cooperative_groups.h>
#include <cstdio>
#include <cstdint>
namespace cg = cooperative_groups;
#ifndef N_LAUNCH_MODE
#define N_LAUNCH_MODE 1
#endif
constexpr int DM = 2048, SEQ = 16384, NB = 2, MLAT = NB * SEQ  , NCTX = 256, MCTX = NB * NCTX  , MALL = MLAT + MCTX  ;
constexpr int DFF = 5632, EVEN_IN = 5120, HY_IN = 6144;
constexpr float MIN_DECAY_F = -3.0701134573253945f, MAX_DECAY_F = -15.350567286626973f;
__device__ __forceinline__ int opaque_tid() { int t = threadIdx.x; asm volatile("" : "+v"(t)); return t; }
namespace pg8 {
#define PG8_LAS __attribute__((address_space(3)))
typedef unsigned short bf16_t;
typedef short bf16x8 __attribute__((ext_vector_type(8)));
typedef float f32x4 __attribute__((ext_vector_type(4)));
typedef unsigned u32x4 __attribute__((ext_vector_type(4)));
constexpr int BM = 256, BK = 64, HALF = 128, HTB = HALF * BK * 2  , STAGE_BYTES = 8 * HTB, NXCD = 8, WGM = 8;

__host__ __device__ __forceinline__ int lds_byte(int r, int c) { const int st = (r >> 4) * 2 + (c >> 5), rr = r & 15, cc = c & 31, ob = rr * 64 + cc * 2; return st * 1024 + (ob ^ (((ob >> 9) & 1) << 5)); }
__host__ __device__ __forceinline__ void stage_rc(int b, int& R, int& C) { const int st = b / 1024, sb = b % 1024, swz = sb ^ (((sb >> 9) & 1) << 5); R = (st >> 1) * 16 + swz / 64; C = (st & 1) * 32 + (swz % 64) / 2; }
__host__ __device__ __forceinline__ int perm32(int rho) { const int n = rho >> 4, i = rho & 15; return 8 * (i >> 2) + 4 * n + (i & 3); }

struct Unit { int pm, pn; };
struct Gemm { const bf16_t* A; const bf16_t* Bt; int M, N, K; };

struct StaticOrder {
    int nM, nN, nwg, G, c;
    __host__ __device__ void init(int M, int N, int G_, int c_) { nM = M / BM; nN = N / BM; nwg = nM * nN; G = G_; c = c_; }
    __host__ __device__ bool next(int i, Unit& u) const {
        const long L = (long)i * G + c; if (L >= nwg) return false;
        int wgid = (int)L; { const int q = nwg / NXCD, r = nwg % NXCD, xcd = wgid % NXCD, off = wgid / NXCD; wgid = (xcd < r ? xcd * (q + 1) : r * (q + 1) + (xcd - r) * q) + off; }
        const int nig = WGM * nN, gid = wgid / nig, fm = gid * WGM, gsz = (nM - fm) < WGM ? (nM - fm) : WGM;
        u.pm = fm + ((wgid % nig) % gsz); u.pn = (wgid % nig) / gsz; return true;
    }
    __device__ __forceinline__ void a_ready(const Unit&) const {}
    __device__ __forceinline__ void done(const Unit&) const {}
};

__device__ __forceinline__ unsigned cvt_pk_bf16(float lo, float hi) { unsigned r; asm volatile("v_cvt_pk_bf16_f32 %0, %1, %2" : "=v"(r) : "v"(lo), "v"(hi)); return r; }
typedef _Float16 f16x2_t __attribute__((ext_vector_type(2)));
typedef unsigned u32x2 __attribute__((ext_vector_type(2)));
__device__ __forceinline__ unsigned cvt_pk_f16(float lo, float hi) { unsigned r; asm volatile("v_cvt_pkrtz_f16_f32 %0, %1, %2" : "=v"(r) : "v"(lo), "v"(hi)); return r; }
__device__ __forceinline__ float gelu_tanh(float x) {
    const float y = 0.7978845608028654f * (x + 0.044715f * x * x * x);
    const float e = __builtin_amdgcn_exp2f(y * 2.8853900817779268f);
    const float t = 1.f - 2.f * __builtin_amdgcn_rcpf(1.f + e);
    return 0.5f * x * (1.f + t);
}
__device__ __forceinline__ float silu_f(float x) { return x * __builtin_amdgcn_rcpf(1.f + __builtin_amdgcn_exp2f(-x * 1.4426950408889634f)); }

template <int mode> struct EpiPlain16 {
    static constexpr bool PERM = true, AFTER_DRAIN = false;
    unsigned short* O; int ldc;
    __device__ __forceinline__ void operator()(const f32x4 (&acc)[2][2][4][2], const Unit& u, int wr, int wc, int fr, int fq) const {
        const int row0 = u.pm * BM + wr * 64 + fr, col0 = u.pn * BM + wc * 32 + 8 * fq;
#pragma unroll
        for (int ai = 0; ai < 2; ++ai)
#pragma unroll
            for (int m = 0; m < 4; ++m) {
                const int row = row0 + ai * HALF + m * 16; unsigned short* rowp = O + (size_t)row * ldc + col0;
                float dk = 0.f;
                if (mode == 2) { const int c = row & 2047; const float delta = __builtin_fabsf(MIN_DECAY_F + (float)c * ((MAX_DECAY_F - MIN_DECAY_F) / 2047.f)); dk = -delta * (1.4426950408889634f / 16383.f); }
#pragma unroll
                for (int bj = 0; bj < 2; ++bj) {
                    f32x4 v0 = acc[ai][bj][m][0], v1 = acc[ai][bj][m][1];
                    if (mode == 2) { const float t0 = (float)(col0 + bj * HALF);
#pragma unroll
                        for (int j = 0; j < 4; ++j) { v0[j] *= __builtin_amdgcn_exp2f(dk * (t0 + (float)j)); v1[j] *= __builtin_amdgcn_exp2f(dk * (t0 + (float)(4 + j))); } }
                    u32x4 w;
                    if (mode == 0) { w.x = cvt_pk_bf16(v0[0], v0[1]); w.y = cvt_pk_bf16(v0[2], v0[3]); w.z = cvt_pk_bf16(v1[0], v1[1]); w.w = cvt_pk_bf16(v1[2], v1[3]); }
                    else { w.x = cvt_pk_f16(v0[0], v0[1]); w.y = cvt_pk_f16(v0[2], v0[3]); w.z = cvt_pk_f16(v1[0], v1[1]); w.w = cvt_pk_f16(v1[2], v1[3]); }
                    *(u32x4*)(rowp + bj * HALF) = w;
                }
                asm volatile("" ::: "memory");
            }
    }
};
struct EpiIn0 {
    static constexpr bool PERM = false, AFTER_DRAIN = false;
    unsigned short* out0; size_t grp_stride; float scale0; int lat0;
    __device__ __forceinline__ void operator()(const f32x4 (&acc)[2][2][4][2], const Unit& u, int wr, int wc, int fr, int fq) const {
        const int grp = (u.pn * BM) >> 10, colt = (u.pn * BM) & 1023;
        unsigned short* base = out0 + (size_t)grp * grp_stride;
        const int kd = grp == 0 ? 0 : 2;
        const float sc = scale0;
        const int col0 = colt + wc * 32 + 4 * fq, row0 = u.pm * BM + wr * 64 + fr;
        if (kd == 0) {
            const bool lat = (u.pm * BM) >= lat0;
            float invrev[4];
#pragma unroll
            for (int j = 0; j < 4; ++j) invrev[j] = __builtin_amdgcn_exp2f(-(float)(4 * fq + j) * (13.287712379549449f / 16.f)) * 0.15915494309189535f;
#pragma unroll
            for (int ai = 0; ai < 2; ++ai)
#pragma unroll
                for (int m = 0; m < 4; ++m) {
                    const int row = row0 + ai * HALF + m * 16; const int t = (row - lat0) & 16383;
                    const float pos = (wc & 1) ? (float)(t & 63) : (float)(t >> 6);
                    float cs[4], sn[4];
#pragma unroll
                    for (int j = 0; j < 4; ++j) { const float r = __builtin_amdgcn_fractf(pos * invrev[j]); cs[j] = lat ? __builtin_amdgcn_cosf(r) : 1.f; sn[j] = lat ? __builtin_amdgcn_sinf(r) : 0.f; }
                    unsigned short* rowp = base + (size_t)row * 1024 + col0;
#pragma unroll
                    for (int bj = 0; bj < 2; ++bj) {
                        const f32x4 x1 = acc[ai][bj][m][0], x2 = acc[ai][bj][m][1]; float o1[4], o2[4];
#pragma unroll
                        for (int j = 0; j < 4; ++j) { o1[j] = (x1[j] * cs[j] - x2[j] * sn[j]) * sc; o2[j] = (x2[j] * cs[j] + x1[j] * sn[j]) * sc; }
                        u32x2 w1, w2; w1.x = cvt_pk_bf16(o1[0], o1[1]); w1.y = cvt_pk_bf16(o1[2], o1[3]); w2.x = cvt_pk_bf16(o2[0], o2[1]); w2.y = cvt_pk_bf16(o2[2], o2[3]);
                        *(u32x2*)(rowp + bj * HALF) = w1; *(u32x2*)(rowp + bj * HALF + 16) = w2;
                    }
                    asm volatile("" ::: "memory");
                }
        } else {
#pragma unroll
            for (int ai = 0; ai < 2; ++ai)
#pragma unroll
                for (int m = 0; m < 4; ++m) {
                    const int row = row0 + ai * HALF + m * 16; unsigned short* rowp = base + (size_t)row * 1024 + col0;
#pragma unroll
                    for (int bj = 0; bj < 2; ++bj)
#pragma unroll
                        for (int n = 0; n < 2; ++n) { const f32x4 v = acc[ai][bj][m][n]; u32x2 w; w.x = cvt_pk_bf16(gelu_tanh(v[0]), gelu_tanh(v[1])); w.y = cvt_pk_bf16(gelu_tanh(v[2]), gelu_tanh(v[3]));
                            *(u32x2*)(rowp + bj * HALF + n * 16) = w; }
                    asm volatile("" ::: "memory");
                }
        }
    }
};
struct EpiResid {
    static constexpr bool PERM = false, AFTER_DRAIN = false;
    const float* base; float* out; const float* gate; int gate_bstride;
    __device__ __forceinline__ void operator()(const f32x4 (&acc)[2][2][4][2], const Unit& u, int wr, int wc, int fr, int fq) const {
        const int col0 = u.pn * BM + wc * 32 + 4 * fq, row0 = u.pm * BM + wr * 64 + fr; const float* gp = gate + (size_t)((u.pm * BM) >> 14) * gate_bstride + col0;
        f32x4 gv[2][2];
#pragma unroll
        for (int bj = 0; bj < 2; ++bj)
#pragma unroll
            for (int n = 0; n < 2; ++n) gv[bj][n] = *(const f32x4*)(gp + bj * HALF + n * 16);
#pragma unroll
        for (int ai = 0; ai < 2; ++ai) {
            f32x4 bs[4][2][2];
#pragma unroll
            for (int m = 0; m < 4; ++m) { const size_t off = (size_t)(row0 + ai * HALF + m * 16) * 2048 + col0;
#pragma unroll
                for (int bj = 0; bj < 2; ++bj)
#pragma unroll
                    for (int n = 0; n < 2; ++n) bs[m][bj][n] = *(const f32x4*)(base + off + bj * HALF + n * 16); }
#pragma unroll
            for (int m = 0; m < 4; ++m) { const size_t off = (size_t)(row0 + ai * HALF + m * 16) * 2048 + col0;
#pragma unroll
                for (int bj = 0; bj < 2; ++bj)
#pragma unroll
                    for (int n = 0; n < 2; ++n) *(f32x4*)(out + off + bj * HALF + n * 16) = bs[m][bj][n] + gv[bj][n] * acc[ai][bj][m][n]; }
            asm volatile("" ::: "memory");
        }
    }
};
struct EpiSwiglu {
    static constexpr bool PERM = true, AFTER_DRAIN = false;
    unsigned short* O;
    __device__ __forceinline__ void operator()(const f32x4 (&acc)[2][2][4][2], const Unit& u, int wr, int wc, int fr, int fq) const {
        const int col0 = u.pn * HALF + wc * 32 + 8 * fq, row0 = u.pm * BM + wr * 64 + fr;
#pragma unroll
        for (int ai = 0; ai < 2; ++ai)
#pragma unroll
            for (int m = 0; m < 4; ++m) {
                float o[8];
#pragma unroll
                for (int n = 0; n < 2; ++n)
#pragma unroll
                    for (int j = 0; j < 4; ++j) o[4 * n + j] = silu_f(acc[ai][0][m][n][j]) * acc[ai][1][m][n][j];
                u32x4 w; w.x = cvt_pk_bf16(o[0], o[1]); w.y = cvt_pk_bf16(o[2], o[3]); w.z = cvt_pk_bf16(o[4], o[5]); w.w = cvt_pk_bf16(o[6], o[7]);
                *(u32x4*)(O + (size_t)(row0 + ai * HALF + m * 16) * DFF + col0) = w;
                asm volatile("" ::: "memory");
            }
    }
};
template <class Epi, class Sched, bool ALIGN_EPI = false, bool SP2 = false>
__device__ __forceinline__ void gemm_phase(PG8_LAS unsigned char* lds, const Gemm g, const Sched& S, const Epi& E) {
    const int tid = opaque_tid(), wid = __builtin_amdgcn_readfirstlane(tid >> 6), lane = tid & 63, wr = wid >> 2, wc = wid & 3, fr = lane & 15, fq = lane >> 4;
    const int K = g.K, nt = K / BK;
    unsigned voffA[2], voffB[2];
#pragma unroll
    for (int i = 0; i < 2; ++i) { int R, C; stage_rc(tid * 16 + i * 8192, R, C); const int Rb = Epi::PERM ? ((R & ~31) + perm32(R & 31)) : R;
        voffA[i] = (unsigned)(R * K + C) * 2u; voffB[i] = (unsigned)(Rb * K + C) * 2u; }
    const size_t kstep = (size_t)(BK * 2);
    const size_t hstep = (size_t)HALF * K * 2;
    const size_t tstep = 2 * hstep;
    const unsigned ldsw = (unsigned)wid * 1024u;
    const int aoff = lds_byte(wr * 64 + fr, fq * 8), boff = lds_byte(wc * 32 + fr, fq * 8);
#define PG8_SA(b, h) (((b) * 2 + (h)) * HTB)
#define PG8_SB(b, h) ((4 + (b) * 2 + (h)) * HTB)
#define PG8_STAGE(bufoff, gbase, voff) do { _Pragma("unroll") for (int _i = 0; _i < 2; ++_i) \
        __builtin_amdgcn_global_load_lds((const unsigned*)((const char*)(gbase) + (voff)[_i]), (PG8_LAS unsigned*)(lds + (bufoff) + ldsw + _i * 8192), 16, 0, 0); } while (0)
#define PG8_LDA(dst, b, h) do { _Pragma("unroll") for (int m = 0; m < 4; ++m) _Pragma("unroll") for (int k = 0; k < 2; ++k) dst[m][k] = *(const PG8_LAS bf16x8*)(lds + PG8_SA(b, h) + aoff + m * 2048 + k * 1024); } while (0)
#define PG8_LDB(dst, b, h) do { _Pragma("unroll") for (int n = 0; n < 2; ++n) _Pragma("unroll") for (int k = 0; k < 2; ++k) dst[n][k] = *(const PG8_LAS bf16x8*)(lds + PG8_SB(b, h) + boff + n * 2048 + k * 1024); } while (0)
#define PG8_MMA(ai, bj, At, Bt) do { __builtin_amdgcn_s_setprio(1); _Pragma("unroll") for (int m = 0; m < 4; ++m) _Pragma("unroll") for (int n = 0; n < 2; ++n) _Pragma("unroll") for (int k = 0; k < 2; ++k) \
        acc[ai][bj][m][n] = __builtin_amdgcn_mfma_f32_16x16x32_bf16(Bt[n][k], At[m][k], acc[ai][bj][m][n], 0, 0, 0); __builtin_amdgcn_s_setprio(0); } while (0)
#define PG8_WAIT_V(n) asm volatile("s_waitcnt vmcnt(" #n ")" ::: "memory")
#define PG8_WAIT_L(n) asm volatile("s_waitcnt lgkmcnt(" #n ")" ::: "memory")
#define PG8_BAR __builtin_amdgcn_s_barrier()
#define PG8_SCHED __builtin_amdgcn_sched_barrier(0)
    Unit cur, nxt; int ui = 0;
    if (!S.next(0, cur)) return;
    f32x4 acc[2][2][4][2];
#pragma unroll
    for (int a = 0; a < 2; ++a)
#pragma unroll
        for (int b = 0; b < 2; ++b)
#pragma unroll
            for (int m = 0; m < 4; ++m)
#pragma unroll
                for (int n = 0; n < 2; ++n) acc[a][b][m][n] = (f32x4){0.f, 0.f, 0.f, 0.f};
    bf16x8 At[4][2], B0[2][2], B1[2][2];
    const char* cA = (const char*)g.A + (size_t)cur.pm * tstep; const char* cB = (const char*)g.Bt + (size_t)cur.pn * tstep;
    S.a_ready(cur);
    if constexpr (SP2) {
        PG8_STAGE(PG8_SB(0, 0), cB, voffB); PG8_STAGE(PG8_SB(0, 1), cB + hstep, voffB); PG8_STAGE(PG8_SA(0, 0), cA, voffA); PG8_STAGE(PG8_SA(0, 1), cA + hstep, voffA);
        if (wr == 1) PG8_BAR;
        PG8_WAIT_V(2); PG8_BAR;
        PG8_STAGE(PG8_SB(1, 0), cB + kstep, voffB); PG8_STAGE(PG8_SA(1, 0), cA + kstep, voffA); PG8_STAGE(PG8_SB(1, 1), cB + hstep + kstep, voffB);
        PG8_WAIT_V(6); PG8_BAR;
    } else {
        PG8_STAGE(PG8_SB(0, 0), cB, voffB); PG8_STAGE(PG8_SA(0, 0), cA, voffA); PG8_STAGE(PG8_SB(0, 1), cB + hstep, voffB); PG8_STAGE(PG8_SA(0, 1), cA + hstep, voffA);
        if (wr == 1) PG8_BAR;
        PG8_WAIT_V(4); PG8_BAR;
        PG8_STAGE(PG8_SB(1, 0), cB + kstep, voffB); PG8_STAGE(PG8_SA(1, 0), cA + kstep, voffA); PG8_STAGE(PG8_SB(1, 1), cB + hstep + kstep, voffB);
        PG8_WAIT_V(6); PG8_BAR;
    }
    for (;;) {
        const bool has_next = S.next(ui + 1, nxt);
        const char* nA = has_next ? (const char*)g.A + (size_t)nxt.pm * tstep : cA; const char* nB = has_next ? (const char*)g.Bt + (size_t)nxt.pn * tstep : cB;
        for (int t = 0; t < nt; t += 2) {
            const bool last = (t == nt - 2);
            const char* a1 = cA + (size_t)(t + 1) * kstep;
            const char* a2 = last ? nA : cA + (size_t)(t + 2) * kstep; const char* b2 = last ? nB : cB + (size_t)(t + 2) * kstep;
            const char* a3 = a2 + kstep; const char* b3 = b2 + kstep;
            if (last && has_next) S.a_ready(nxt);
            if constexpr (SP2) {
            PG8_LDB(B0, 0, 0); PG8_LDB(B1, 0, 1); PG8_SCHED; PG8_LDA(At, 0, 0); PG8_STAGE(PG8_SA(1, 1), a1 + hstep, voffA);
            PG8_WAIT_V(8); PG8_WAIT_L(0); PG8_BAR; PG8_MMA(0, 0, At, B0); PG8_MMA(0, 1, At, B1); PG8_BAR; PG8_SCHED;
            PG8_LDA(At, 0, 1); PG8_STAGE(PG8_SB(0, 0), b2, voffB); PG8_STAGE(PG8_SB(0, 1), b2 + hstep, voffB); PG8_STAGE(PG8_SA(0, 0), a2, voffA);
            PG8_WAIT_V(8); PG8_WAIT_L(0); PG8_BAR; PG8_MMA(1, 0, At, B0); PG8_MMA(1, 1, At, B1); PG8_BAR; PG8_SCHED;
            PG8_LDB(B0, 1, 0); PG8_LDB(B1, 1, 1); PG8_SCHED; PG8_LDA(At, 1, 0); PG8_STAGE(PG8_SA(0, 1), a2 + hstep, voffA);
            PG8_WAIT_V(8); PG8_WAIT_L(0); PG8_BAR; PG8_MMA(0, 0, At, B0); PG8_MMA(0, 1, At, B1); PG8_BAR; PG8_SCHED;
            PG8_LDA(At, 1, 1); PG8_STAGE(PG8_SB(1, 0), b3, voffB); PG8_STAGE(PG8_SB(1, 1), b3 + hstep, voffB); PG8_STAGE(PG8_SA(1, 0), a3, voffA);
            PG8_WAIT_V(8); PG8_WAIT_L(0); PG8_BAR; PG8_MMA(1, 0, At, B0); PG8_MMA(1, 1, At, B1); PG8_BAR; PG8_SCHED;
            } else {
            PG8_LDB(B0, 0, 0); PG8_SCHED; PG8_LDA(At, 0, 0); PG8_STAGE(PG8_SA(1, 1), a1 + hstep, voffA);
            PG8_WAIT_L(8); PG8_BAR; PG8_WAIT_L(0); PG8_MMA(0, 0, At, B0); PG8_BAR; PG8_SCHED;
            PG8_LDB(B1, 0, 1); PG8_STAGE(PG8_SB(0, 0), b2, voffB);
            PG8_BAR; PG8_WAIT_L(0); PG8_MMA(0, 1, At, B1); PG8_BAR;
            PG8_LDA(At, 0, 1); PG8_STAGE(PG8_SA(0, 0), a2, voffA);
            PG8_BAR; PG8_WAIT_L(0); PG8_MMA(1, 0, At, B0); PG8_BAR; PG8_SCHED;
            PG8_STAGE(PG8_SB(0, 1), b2 + hstep, voffB);
            PG8_WAIT_V(6); PG8_BAR; PG8_MMA(1, 1, At, B1); PG8_BAR;
            PG8_LDB(B0, 1, 0); PG8_SCHED; PG8_LDA(At, 1, 0); PG8_STAGE(PG8_SA(0, 1), a2 + hstep, voffA);
            PG8_WAIT_L(8); PG8_BAR; PG8_WAIT_L(0); PG8_MMA(0, 0, At, B0); PG8_BAR; PG8_SCHED;
            PG8_LDB(B1, 1, 1); PG8_STAGE(PG8_SB(1, 0), b3, voffB);
            PG8_BAR; PG8_WAIT_L(0); PG8_MMA(0, 1, At, B1); PG8_BAR;
            PG8_LDA(At, 1, 1); PG8_STAGE(PG8_SA(1, 0), a3, voffA);
            PG8_BAR; PG8_WAIT_L(0); PG8_MMA(1, 0, At, B0); PG8_BAR; PG8_SCHED;
            PG8_STAGE(PG8_SB(1, 1), b3 + hstep, voffB);
            PG8_WAIT_V(6); PG8_BAR; PG8_MMA(1, 1, At, B1); PG8_BAR;
            }
        }
        if constexpr (ALIGN_EPI) { if (wr == 0) PG8_BAR; }
        if constexpr (!Epi::AFTER_DRAIN) { E(acc, cur, wr, wc, fr, fq); S.done(cur); }
        if (!has_next) break;
#pragma unroll
        for (int a = 0; a < 2; ++a)
#pragma unroll
            for (int b = 0; b < 2; ++b)
#pragma unroll
                for (int m = 0; m < 4; ++m)
#pragma unroll
                    for (int n = 0; n < 2; ++n) acc[a][b][m][n] = (f32x4){0.f, 0.f, 0.f, 0.f};
        cur = nxt; cA = nA; cB = nB; ++ui;
        if constexpr (ALIGN_EPI) { if (wr == 1) PG8_BAR; }
    }
    PG8_WAIT_V(0);
    if constexpr (!ALIGN_EPI) { if (wr == 0) PG8_BAR; }
    PG8_BAR;
    if constexpr (Epi::AFTER_DRAIN) { E.fused(acc, cur, wr, wc, fr, fq, lds, wid, lane); S.done(cur); }
#undef PG8_SA
#undef PG8_SB
#undef PG8_STAGE
#undef PG8_LDA
#undef PG8_LDB
#undef PG8_MMA
#undef PG8_WAIT_V
#undef PG8_WAIT_L
#undef PG8_BAR
#undef PG8_SCHED
}
}
#define LAS __attribute__((address_space(3)))
typedef unsigned short bf16;
typedef float f32x4 __attribute__((ext_vector_type(4)));
typedef float f32x2 __attribute__((ext_vector_type(2)));
typedef float f32x16 __attribute__((ext_vector_type(16)));
typedef short bf16x8 __attribute__((ext_vector_type(8)));
typedef unsigned u32x4 __attribute__((ext_vector_type(4)));
typedef unsigned u32x2 __attribute__((ext_vector_type(2)));
typedef _Float16 f16x2 __attribute__((ext_vector_type(2)));
constexpr int NWAVES = 8, NTHR = 512;
constexpr int LDS_BYTES = 147456;
constexpr size_t MiB = 1u << 20;
constexpr size_t WS_MODS = 0;
constexpr size_t WS_H3X = 1 * MiB;
constexpr size_t WS_W4X = 9 * MiB;
constexpr size_t WS_WIN = 16 * MiB;
constexpr size_t WS_WOUT0 = 36 * MiB;
constexpr size_t WS_WGU0 = 44 * MiB;
constexpr size_t WS_WD0 = 88 * MiB;
constexpr size_t WS_HYSCR = 16 * MiB;
constexpr size_t WS_OIN = 110 * MiB;
constexpr size_t WS_OOUT = 134 * MiB;
constexpr size_t WS_WGU1 = 142 * MiB;
constexpr size_t WS_WD1 = 186 * MiB;
constexpr size_t WS_X = 208 * MiB;
constexpr size_t WS_H = 464 * MiB;
constexpr size_t WS_OV = 594 * MiB;
constexpr size_t WS_K = WS_OV, WS_VT = WS_OV + 65 * MiB, WS_Q = WS_OV + 130 * MiB, WS_U = WS_OV + 194 * MiB, WS_G = WS_OV + 258 * MiB;
constexpr size_t WS_END = 978 * MiB;
static_assert(WS_U - WS_Q == WS_G - WS_U, "Q/U/G equally spaced");

struct Args { const float* in[33]; float* out; unsigned char* ws; int ph_lo, ph_hi; };
constexpr int TAB_OFF = 143360;
__device__ __forceinline__ unsigned long long tab_ld(const LAS unsigned long long* tab, int i) {
    const unsigned long long v = tab[i]; const unsigned lo = __builtin_amdgcn_readfirstlane((unsigned)v), hi = __builtin_amdgcn_readfirstlane((unsigned)(v >> 32));
    return ((unsigned long long)hi << 32) | lo; }
struct LArgs { const LAS unsigned long long* tab; float* out; unsigned char* ws;
    __device__ __forceinline__ const float* in(int i) const { return (const float*)(const __attribute__((address_space(1))) float*)tab_ld(tab, i); } };
enum { I_X = 0, I_C, I_CTX, I_CCTX, I_ADAW, I_ADAB, I_NORM1, I_NORM2, I_FG, I_FU, I_FD, I_EWIN, I_EWOUT, I_ELAM, I_ESUBLN, I_ESNG, I_ESNB, I_ESW, I_ESB,
       I_OWIN, I_OCW, I_OCB, I_FW1, I_FB1, I_FW2, I_FB2, I_FW3, I_FB3, I_FFREQ, I_FW4, I_FBIAS, I_OWOUT, I_FNORM };

template <int O> __device__ __forceinline__ float swz_xor(float v) { return __builtin_bit_cast(float, __builtin_amdgcn_ds_swizzle(__builtin_bit_cast(int, v), (O << 10) | 0x1f)); }
__device__ __forceinline__ float xor32_get(float v, int xaddr) { return __builtin_bit_cast(float, __builtin_amdgcn_ds_bpermute(xaddr, __builtin_bit_cast(int, v))); }
__device__ __forceinline__ float wave_sum(float v) {
    v += swz_xor<1>(v); v += swz_xor<2>(v); v += swz_xor<4>(v); v += swz_xor<8>(v); v += swz_xor<16>(v);
    return __builtin_bit_cast(float, __builtin_amdgcn_readlane(__builtin_bit_cast(int, v), 0)) + __builtin_bit_cast(float, __builtin_amdgcn_readlane(__builtin_bit_cast(int, v), 32));
}
__device__ __forceinline__ unsigned f2bf(float f) { unsigned u = __builtin_bit_cast(unsigned, f); return (u + 0x7fffu + ((u >> 16) & 1u)) >> 16; }
__device__ __forceinline__ unsigned pk2(float lo, float hi) { return f2bf(lo) | (f2bf(hi) << 16); }
__device__ __forceinline__ float bf2f(unsigned h) { return __builtin_bit_cast(float, h << 16); }
__device__ __forceinline__ f32x2 cmul(f32x2 a, f32x2 b) { const f32x2 ar = {-a.y, a.x}; return ar * b.y + a * b.x; }

__device__ __forceinline__ void transpose_item(const float* W, int K, int N, bf16* WT, int dst_row0, LAS float* scr, int k0, int n0, int lane) {
#pragma unroll 8
    for (int i = 0; i < 32; ++i) { const int kk = 2 * i + (lane >> 5); scr[kk * 33 + (lane & 31)] = W[(size_t)(k0 + kk) * N + n0 + (lane & 31)]; }
    asm volatile("s_waitcnt vmcnt(0) lgkmcnt(0)" ::: "memory");
    const int c = lane & 7;
#pragma unroll
    for (int j = 0; j < 4; ++j) { const int n = (lane >> 3) + 8 * j; const LAS float* s = scr + (8 * c) * 33 + n;
        u32x4 o; o.x = pk2(s[0 * 33], s[1 * 33]); o.y = pk2(s[2 * 33], s[3 * 33]); o.z = pk2(s[4 * 33], s[5 * 33]); o.w = pk2(s[6 * 33], s[7 * 33]);
        *(u32x4*)(WT + (size_t)(dst_row0 + n) * K + k0 + 8 * c) = o; }
    asm volatile("s_waitcnt lgkmcnt(0)" ::: "memory");
}
template <int MAP> __device__ __forceinline__ void transpose_matrix(const float* W, int K, int N, bf16* WT, LAS float* scr, int gw, int NGW, int lane) {
    const int nblk = N / 32, nitems = (K / 64) * nblk;
    for (int it = gw; it < nitems; it += NGW) {
        const int kb = it / nblk, nb = it % nblk, n0 = nb * 32; int d = n0;
        if (MAP == 1) d = n0 < 1024 ? n0 + 2048 : (n0 < 3072 ? n0 - 1024 : n0);
        if (MAP == 2) d = 256 * (n0 >> 7) + (n0 & 127);
        if (MAP == 3) d = 256 * (n0 >> 7) + 128 + (n0 & 127);
        transpose_item(W, K, N, WT, d, scr, kb * 64, n0, lane);
    }
}
__device__ __forceinline__ void p0_prologue(const LArgs& a, LAS unsigned char* lds) {
    const int tid = opaque_tid(), lane = tid & 63, wid = tid >> 6;
    const int gw = blockIdx.x * NWAVES + wid, NGW = gridDim.x * NWAVES;
    unsigned char* ws = a.ws;
    LAS float* scr = (LAS float*)(lds + wid * 16384);
    {
        float* mods = (float*)(ws + WS_MODS);
        for (int it = gw; it < 3072; it += NGW) {
            const int layer = it / 1536, r = it % 1536, cc = r >> 3, kc = r & 7, col = cc * 64 + lane;
            const float* w = a.in(I_ADAW) + (size_t)layer * 2048 * 12288 + (size_t)(kc * 256) * 12288 + col;
            const float* c0 = a.in(I_C) + kc * 256; const float* c1 = c0 + 2048; const float* c2 = a.in(I_CCTX) + kc * 256;
            float a0 = 0.f, a1 = 0.f, a2 = 0.f;
#pragma unroll 8
            for (int k = 0; k < 256; ++k) { const float wv = w[(size_t)k * 12288]; a0 += pg8::silu_f(c0[k]) * wv; a1 += pg8::silu_f(c1[k]) * wv; a2 += pg8::silu_f(c2[k]) * wv; }
            if (kc == 0) { const float bb = a.in(I_ADAB)[layer * 12288 + col]; a0 += bb; a1 += bb; a2 += bb; }
            float* m = mods + (size_t)layer * 3 * 12288 + col;
            atomicAdd(m, a0); atomicAdd(m + 12288, a1); atomicAdd(m + 2 * 12288, a2);
        }
    }
    transpose_matrix<1>(a.in(I_EWIN), 2048, EVEN_IN, (bf16*)(ws + WS_WIN), scr, gw, NGW, lane);
    transpose_matrix<0>(a.in(I_EWOUT), 2048, 2048, (bf16*)(ws + WS_WOUT0), scr, gw, NGW, lane);
    transpose_matrix<0>(a.in(I_OWIN), 2048, HY_IN, (bf16*)(ws + WS_OIN), scr, gw, NGW, lane);
    transpose_matrix<0>(a.in(I_OWOUT), 2048, 2048, (bf16*)(ws + WS_OOUT), scr, gw, NGW, lane);
    for (int l = 0; l < 2; ++l) {
        bf16* gu = (bf16*)(ws + (l ? WS_WGU1 : WS_WGU0)); bf16* dn = (bf16*)(ws + (l ? WS_WD1 : WS_WD0));
        transpose_matrix<2>(a.in(I_FG) + (size_t)l * 2048 * DFF, 2048, DFF, gu, scr, gw, NGW, lane);
        transpose_matrix<3>(a.in(I_FU) + (size_t)l * 2048 * DFF, 2048, DFF, gu, scr, gw, NGW, lane);
        transpose_matrix<0>(a.in(I_FD) + (size_t)l * 2048 * DFF, DFF, 2048, dn, scr, gw, NGW, lane);
    }
    {
        bf16* W4X = (bf16*)(ws + WS_W4X); const float* w4 = a.in(I_FW4);
        for (int e = blockIdx.x * NTHR + tid; e < 64 * 8192; e += gridDim.x * NTHR) {
            const int k = e >> 13, col = e & 8191; const float w = w4[e]; const unsigned hi = f2bf(w); const unsigned lo = f2bf(w - bf2f(hi));
            bf16* o = W4X + (size_t)col * 256 + k; o[0] = (bf16)hi; o[64] = (bf16)hi; o[128] = (bf16)lo; o[192] = (bf16)lo;
        }
    }
    {
        bf16* H3X = (bf16*)(ws + WS_H3X);
        const float* w1 = a.in(I_FW1); const float* w2 = a.in(I_FW2); const float* w3 = a.in(I_FW3);
        const float b1 = a.in(I_FB1)[lane], b2 = a.in(I_FB2)[lane], b3 = a.in(I_FB3)[lane];
        const float fr0 = a.in(I_FFREQ)[lane] * 0.15915494309189535f, fr1 = a.in(I_FFREQ)[64 + lane] * 0.15915494309189535f, fr2 = a.in(I_FFREQ)[128 + lane] * 0.15915494309189535f;
        float w1c[33], w2c[64], w3c[64];
#pragma unroll
        for (int f = 0; f < 33; ++f) w1c[f] = w1[f * 64 + lane];
#pragma unroll
        for (int k = 0; k < 64; ++k) { w2c[k] = w2[k * 64 + lane]; w3c[k] = w3[k * 64 + lane]; }
        for (int pos = gw; pos < SEQ; pos += NGW) {
            float feat = 0.f;
            { const int bidx = (lane >= 17) ? lane - 17 : lane - 1; const float fb = 1e-4f + (float)(bidx < 0 ? 0 : bidx) * ((15.f - 1e-4f) / 15.f);
              double rv = (double)fb * (double)pos * (1.0 / 16384.0); rv -= __builtin_floor(rv); const float rf = (float)rv;
              if (lane == 0) feat = (float)pos * (1.f / 16383.f); else if (lane <= 16) feat = __builtin_amdgcn_cosf(rf); else if (lane <= 32) feat = -__builtin_amdgcn_sinf(rf); }
            float acc = b1;
#pragma unroll
            for (int f = 0; f < 33; ++f) acc += __builtin_bit_cast(float, __builtin_amdgcn_readlane(__builtin_bit_cast(int, feat), f)) * w1c[f];
            float h = __builtin_amdgcn_sinf(__builtin_amdgcn_fractf(fr0 * acc));
            acc = b2;
#pragma unroll
            for (int k = 0; k < 64; ++k) acc += __builtin_bit_cast(float, __builtin_amdgcn_readlane(__builtin_bit_cast(int, h), k)) * w2c[k];
            h = __builtin_amdgcn_sinf(__builtin_amdgcn_fractf(fr1 * acc));
            acc = b3;
#pragma unroll
            for (int k = 0; k < 64; ++k) acc += __builtin_bit_cast(float, __builtin_amdgcn_readlane(__builtin_bit_cast(int, h), k)) * w3c[k];
            h = __builtin_amdgcn_sinf(__builtin_amdgcn_fractf(fr2 * acc));
            const unsigned hi = f2bf(h), lo = f2bf(h - bf2f(hi));
            bf16* o = H3X + (size_t)pos * 256 + lane; o[0] = (bf16)hi; o[64] = (bf16)lo; o[128] = (bf16)hi; o[192] = (bf16)lo;
        }
    }
}

template <int SRC> __device__ __forceinline__ void prenorm_rows(const LArgs& a, int nrows, const float* nw, const float* mods_layer, int shift_part, bf16* dst) {
    const int tid = opaque_tid(), lane = tid & 63, wid = tid >> 6, gw = blockIdx.x * NWAVES + wid, NGW = gridDim.x * NWAVES;
    for (int chunk = gw; chunk < nrows / 16; chunk += NGW) {
        const int row0 = chunk * 16; const float* src0; int cond;
        if (SRC == 0) { if (row0 < MCTX) { src0 = a.in(I_CTX) + (size_t)row0 * DM; cond = 2; } else { src0 = a.in(I_X) + (size_t)(row0 - MCTX) * DM; cond = (row0 - MCTX) >> 14; } }
        else { src0 = (const float*)(a.ws + WS_X) + (size_t)row0 * DM; cond = row0 >> 14; }
        const float* sh = mods_layer + (size_t)cond * 12288 + shift_part * 2048; const float* sc = sh + 2048;
        f32x4 cs[8], sv[8];
#pragma unroll
        for (int j = 0; j < 8; ++j) { const int col = 4 * lane + 256 * j; cs[j] = *(const f32x4*)(nw + col) * (*(const f32x4*)(sc + col) + 1.f); sv[j] = *(const f32x4*)(sh + col); }
#pragma unroll 2
        for (int r = 0; r < 16; ++r) {
            const float* src = src0 + (size_t)r * DM; f32x4 v[8]; float ss = 0.f;
#pragma unroll
            for (int j = 0; j < 8; ++j) { v[j] = *(const f32x4*)(src + 4 * lane + 256 * j); ss += (v[j].x * v[j].x + v[j].y * v[j].y) + (v[j].z * v[j].z + v[j].w * v[j].w); }
            const float rn = 1.f / sqrtf(wave_sum(ss) * (1.f / DM) + 1e-6f);
#pragma unroll
            for (int j = 0; j < 8; ++j) { const int col = 4 * lane + 256 * j; const f32x4 o = v[j] * rn * cs[j] + sv[j]; u32x2 pq; pq.x = pk2(o.x, o.y); pq.y = pk2(o.z, o.w); *(u32x2*)(dst + (size_t)(row0 + r) * DM + col) = pq; }
        }
    }
}
__device__ __forceinline__ void final_norm_rows(const LArgs& a) {
    const int tid = opaque_tid(), lane = tid & 63, wid = tid >> 6, gw = blockIdx.x * NWAVES + wid, NGW = gridDim.x * NWAVES;
    const float* nw = a.in(I_FNORM);
    f32x4 cs[8];
#pragma unroll
    for (int j = 0; j < 8; ++j) cs[j] = *(const f32x4*)(nw + 4 * lane + 256 * j);
    for (int chunk = gw; chunk < MLAT / 16; chunk += NGW) {
#pragma unroll 2
        for (int r = 0; r < 16; ++r) {
            const int row = chunk * 16 + r; const float* src = (const float*)(a.ws + WS_X) + (size_t)row * DM; f32x4 v[8]; float ss = 0.f;
#pragma unroll
            for (int j = 0; j < 8; ++j) { v[j] = *(const f32x4*)(src + 4 * lane + 256 * j); ss += (v[j].x * v[j].x + v[j].y * v[j].y) + (v[j].z * v[j].z + v[j].w * v[j].w); }
            const float rn = 1.f / sqrtf(wave_sum(ss) * (1.f / DM) + 1e-6f);
#pragma unroll
            for (int j = 0; j < 8; ++j) { const int col = 4 * lane + 256 * j; *(f32x4*)(a.out + (size_t)row * DM + col) = v[j] * rn * cs[j]; }
        }
    }
}

__device__ __forceinline__ void attn_phase(const LArgs& a, LAS unsigned char* lds) {
    const int tid = opaque_tid(), lane = tid & 63, wid = tid >> 6, pr = wid >> 1, mp = wid & 1, r32 = lane & 31, hi = lane >> 5;
    const bf16* Qg = (const bf16*)(a.ws + WS_Q); const bf16* Kg = (const bf16*)(a.ws + WS_K); const bf16* Vt = (const bf16*)(a.ws + WS_VT);
    bf16* act = (bf16*)(a.ws + WS_H);
    float lam;
    { const float* lp = a.in(I_ELAM); const float v = wave_sum(lp[lane] * lp[64 + lane]), w = wave_sum(lp[128 + lane] * lp[192 + lane]); lam = __expf(v) - __expf(w) + 0.2f; }
    constexpr int KROW = 272, VROW = 144, KBUF = 64 * KROW, VBUF = 128 * VROW, NT = 260;
    const int xaddr = (lane ^ 32) << 2;
    const int kappa = (r32 & 16) | ((r32 & 4) << 1) | ((r32 & 8) >> 1) | (r32 & 3);
    const int krow_t = tid >> 4, kch = tid & 15, vrow_t = tid >> 3, vch = tid & 7;
    const float* subln = a.in(I_ESUBLN);
    for (int u = blockIdx.x; u < 2048; u += gridDim.x) {
        const int bh = u >> 7, qb = u & 127, b = bh >> 3, h = bh & 7;
        const bf16* Qp = Qg + (size_t)(b * SEQ + qb * 128 + pr * 32 + r32) * 1024 + h * 128 + mp * 64 + hi * 8;
        bf16x8 qf[4];
#pragma unroll
        for (int ks = 0; ks < 4; ++ks) qf[ks] = *(const bf16x8*)(Qp + ks * 16);
        f32x16 o[4];
#pragma unroll
        for (int d = 0; d < 4; ++d)
#pragma unroll
            for (int r = 0; r < 16; ++r) o[d][r] = 0.f;
        float mrun = -1e30f, lrun = 0.f;
        const bf16* kgp = Kg + (size_t)krow_t * 1024 + h * 128 + kch * 8;
        const bf16* vgp = Vt + (size_t)(h * 128 + vrow_t) * MALL + vch * 8;
        u32x4 kreg[2], vreg[2];
#define ATT_LOAD(j) do { const int kb0_ = (j) < 4 ? b * NCTX + (j) * 64 : MCTX + b * SEQ + ((j) - 4) * 64; \
            kreg[0] = *(const u32x4*)(kgp + (size_t)kb0_ * 1024); kreg[1] = *(const u32x4*)(kgp + (size_t)(kb0_ + 32) * 1024); \
            vreg[0] = *(const u32x4*)(vgp + kb0_); vreg[1] = *(const u32x4*)(vgp + (size_t)64 * MALL + kb0_); } while (0)
#define ATT_STORE(kbuf, vbuf) do { LAS unsigned char* kb_ = lds + (kbuf) * KBUF; LAS unsigned char* vb_ = lds + 2 * KBUF + (vbuf) * VBUF; \
            *(LAS u32x4*)(kb_ + krow_t * KROW + kch * 16) = kreg[0]; *(LAS u32x4*)(kb_ + (krow_t + 32) * KROW + kch * 16) = kreg[1]; \
            *(LAS u32x4*)(vb_ + vrow_t * VROW + vch * 16) = vreg[0]; *(LAS u32x4*)(vb_ + (vrow_t + 64) * VROW + vch * 16) = vreg[1]; } while (0)
#define ATT_VRD(DST, vb_, kstep) do { _Pragma("unroll") for (int d = 0; d < 4; ++d) DST[d] = *(const LAS bf16x8*)((vb_) + (32 * d + r32) * VROW + (kstep) * 32 + hi * 16); } while (0)
#define ATT_VMM(SRC, kstep) do { const bf16x8 pf = __builtin_bit_cast(bf16x8, pw[kstep]); _Pragma("unroll") for (int d = 0; d < 4; ++d) o[d] = __builtin_amdgcn_mfma_f32_32x32x16_bf16(SRC[d], pf, o[d], 0, 0, 0); } while (0)
#define ATT_PV_PRE(vbuf) do { const LAS unsigned char* vb_ = lds + 2 * KBUF + (vbuf) * VBUF; ATT_VRD(vfa, vb_, 0); __builtin_amdgcn_sched_barrier(0); } while (0)
#define ATT_PV(vbuf, PRE) do { const LAS unsigned char* vb_ = lds + 2 * KBUF + (vbuf) * VBUF; \
            if (!(PRE)) ATT_VRD(vfa, vb_, 0); \
            ATT_VRD(vfb, vb_, 1); __builtin_amdgcn_sched_barrier(0); ATT_VMM(vfa, 0); __builtin_amdgcn_sched_barrier(0); \
            ATT_VRD(vfa, vb_, 2); __builtin_amdgcn_sched_barrier(0); ATT_VMM(vfb, 1); __builtin_amdgcn_sched_barrier(0); \
            ATT_VRD(vfb, vb_, 3); __builtin_amdgcn_sched_barrier(0); ATT_VMM(vfa, 2); __builtin_amdgcn_sched_barrier(0); \
            ATT_VMM(vfb, 3); } while (0)
        const bool late = wid >= 4;
        u32x4 pw[4]; bf16x8 vfa[4], vfb[4];
#pragma unroll
        for (int i = 0; i < 4; ++i) pw[i] = (u32x4){0u, 0u, 0u, 0u};
        ATT_LOAD(0); ATT_STORE(0, 0); __syncthreads();
        int vprev = 2, vcur = 0, vnext = 1;
        for (int j = 0; j < NT; ++j) {
            const int cur = j & 1;
            if (j + 1 < NT) ATT_LOAD(j + 1);
            if (late && j > 0) ATT_PV(vprev, 0);
            const LAS unsigned char* kb_ = lds + cur * KBUF;
            f32x16 s[2];
#pragma unroll
            for (int kb = 0; kb < 2; ++kb) {
#pragma unroll
                for (int r = 0; r < 16; ++r) s[kb][r] = 0.f;
#pragma unroll
                for (int ks = 0; ks < 4; ++ks) { const bf16x8 kf = *(const LAS bf16x8*)(kb_ + (32 * kb + kappa) * KROW + mp * 128 + ks * 32 + hi * 16);
                    s[kb] = __builtin_amdgcn_mfma_f32_32x32x16_bf16(kf, qf[ks], s[kb], 0, 0, 0); }
            }
            if (!late) ATT_PV_PRE(vcur);
            float mx = s[0][0];
#pragma unroll
            for (int r = 1; r < 16; ++r) mx = fmaxf(mx, s[0][r]);
#pragma unroll
            for (int r = 0; r < 16; ++r) mx = fmaxf(mx, s[1][r]);
            mx = fmaxf(mx, xor32_get(mx, xaddr));
            const float mnew = fmaxf(mrun, mx);
            if (__any(mnew > mrun)) {
                const float alpha = __builtin_amdgcn_exp2f(mrun - mnew); lrun *= alpha;
#pragma unroll
                for (int d = 0; d < 4; ++d)
#pragma unroll
                    for (int r = 0; r < 16; ++r) o[d][r] *= alpha;
                mrun = mnew;
            }
            float psum = 0.f;
#pragma unroll
            for (int kb = 0; kb < 2; ++kb)
#pragma unroll
                for (int r = 0; r < 16; ++r) { const float pv = __builtin_amdgcn_exp2f(s[kb][r] - mrun); s[kb][r] = pv; psum += pv; }
            lrun += psum;
#pragma unroll
            for (int kb = 0; kb < 2; ++kb)
#pragma unroll
                for (int g = 0; g < 2; ++g) {
                    u32x4 w4; w4.x = pg8::cvt_pk_bf16(s[kb][8 * g + 0], s[kb][8 * g + 1]); w4.y = pg8::cvt_pk_bf16(s[kb][8 * g + 2], s[kb][8 * g + 3]);
                    w4.z = pg8::cvt_pk_bf16(s[kb][8 * g + 4], s[kb][8 * g + 5]); w4.w = pg8::cvt_pk_bf16(s[kb][8 * g + 6], s[kb][8 * g + 7]);
                    pw[2 * kb + g] = w4;
                }
            if (!late) ATT_PV(vcur, 1);
            if (j + 1 < NT) ATT_STORE(cur ^ 1, vnext);
            __syncthreads();
            { const int t_ = vprev; vprev = vcur; vcur = vnext; vnext = t_; }
        }
        if (late) ATT_PV(vprev, 0);
        __syncthreads();
#undef ATT_LOAD
#undef ATT_STORE
#undef ATT_PV
#undef ATT_PV_PRE
#undef ATT_VRD
#undef ATT_VMM
        const float ltot = lrun + xor32_get(lrun, xaddr); const float inv = 1.f / ltot;
        LAS float* xch = (LAS float*)lds + pr * 4096;
        if (mp == 1) { const float f = inv * lam;
#pragma unroll
            for (int d = 0; d < 4; ++d)
#pragma unroll
                for (int r = 0; r < 16; ++r) xch[(d * 16 + r) * 64 + lane] = o[d][r] * f; }
        __syncthreads();
        if (mp == 0) {
            float ss = 0.f;
#pragma unroll
            for (int d = 0; d < 4; ++d)
#pragma unroll
                for (int r = 0; r < 16; ++r) { const float dv = o[d][r] * inv - xch[(d * 16 + r) * 64 + lane]; o[d][r] = dv; ss += dv * dv; }
            ss += xor32_get(ss, xaddr);
            const float rn = (1.f / sqrtf(ss * (1.f / 128.f) + 1e-5f)) * 0.8f;
            bf16* orow = act + (size_t)(b * SEQ + qb * 128 + pr * 32 + r32) * DM + h * 128;
#pragma unroll
            for (int d = 0; d < 4; ++d)
#pragma unroll
                for (int j4 = 0; j4 < 4; ++j4) { const int dv0 = 32 * d + 8 * j4 + 4 * hi; const f32x4 g = *(const f32x4*)(subln + dv0);
                    u32x2 w; w.x = pk2(o[d][4 * j4 + 0] * rn * g.x, o[d][4 * j4 + 1] * rn * g.y); w.y = pk2(o[d][4 * j4 + 2] * rn * g.z, o[d][4 * j4 + 3] * rn * g.w);
                    *(u32x2*)(orow + dv0) = w; }
        }
        __syncthreads();
    }
}

__device__ __forceinline__ void sgu_phase(const LArgs& a, LAS unsigned char* lds) {
    const int tid = opaque_tid(), lane = tid & 63, wid = tid >> 6;
    LAS float* Ws = (LAS float*)lds; LAS float* VV = Ws + 128 * 128;
    const bf16* Ug = (const bf16*)(a.ws + WS_U); const bf16* Gg = (const bf16*)(a.ws + WS_G); bf16* act = (bf16*)(a.ws + WS_H);
    for (int u = blockIdx.x; u < 2048; u += gridDim.x) {
        const int g = u & 7, row0 = (u >> 3) * 128;
        const f32x4* wsrc = (const f32x4*)(a.in(I_ESW) + (size_t)g * 16384);
#pragma unroll
        for (int i = 0; i < 8; ++i) ((LAS f32x4*)Ws)[tid + NTHR * i] = wsrc[tid + NTHR * i];
        const float ng0 = a.in(I_ESNG)[g * 128 + 2 * lane], ng1 = a.in(I_ESNG)[g * 128 + 2 * lane + 1], nb0 = a.in(I_ESNB)[g * 128 + 2 * lane], nb1 = a.in(I_ESNB)[g * 128 + 2 * lane + 1];
#pragma unroll
        for (int rr = 0; rr < 16; ++rr) {
            const int r = wid * 16 + rr; const unsigned pk = *(const unsigned*)(Gg + (size_t)(row0 + r) * 1024 + g * 128 + 2 * lane);
            const float x0 = bf2f(pk & 0xffffu), x1 = bf2f(pk >> 16);
            const float mean = wave_sum(x0 + x1) * (1.f / 128.f); const float d0 = x0 - mean, d1 = x1 - mean;
            const float rstd = 1.f / sqrtf(wave_sum(d0 * d0 + d1 * d1) * (1.f / 128.f) + 1e-5f);
            *(LAS f32x2*)(VV + r * 128 + 2 * lane) = (f32x2){d0 * rstd * ng0 + nb0, d1 * rstd * ng1 + nb1};
        }
        __syncthreads();
        const int c0 = 4 * (tid & 31), p0 = 8 * (tid >> 5);
        f32x4 acc[8];
#pragma unroll
        for (int i = 0; i < 8; ++i) acc[i] = (f32x4){0.f, 0.f, 0.f, 0.f};
        for (int q = 0; q < 128; q += 4) {
            f32x4 v[4];
#pragma unroll
            for (int qq = 0; qq < 4; ++qq) v[qq] = *(const LAS f32x4*)(VV + (q + qq) * 128 + c0);
#pragma unroll
            for (int i = 0; i < 8; ++i) { const f32x4 w = *(const LAS f32x4*)(Ws + (p0 + i) * 128 + q); acc[i] += v[0] * w.x + v[1] * w.y + v[2] * w.z + v[3] * w.w; }
        }
#pragma unroll
        for (int i = 0; i < 8; ++i) {
            const int p = p0 + i; const float bs = a.in(I_ESB)[g * 128 + p];
            const u32x2 uu = *(const u32x2*)(Ug + (size_t)(row0 + p) * 1024 + g * 128 + c0);
            const f32x4 o = (f32x4){bf2f(uu.x & 0xffffu), bf2f(uu.x >> 16), bf2f(uu.y & 0xffffu), bf2f(uu.y >> 16)} * (acc[i] + bs);
            u32x2 w; w.x = pk2(o.x, o.y); w.y = pk2(o.z, o.w);
            *(u32x2*)(act + (size_t)(row0 + p) * DM + 1024 + g * 128 + c0) = w;
        }
        __syncthreads();
    }
}

__device__ __forceinline__ void bfly_fwd(f32x2& x0, f32x2& x1, f32x2& x2, f32x2& x3, const f32x2 w1) {
    const f32x2 w2 = cmul(w1, w1);
    const f32x2 y0 = x0 + x2, y1 = x1 + x3, y2 = cmul(x0 - x2, w1), t = cmul(x1 - x3, w1); const f32x2 y3 = {t.y, -t.x};
    x0 = y0 + y1; x1 = cmul(y0 - y1, w2); x2 = y2 + y3; x3 = cmul(y2 - y3, w2);
}
__device__ __forceinline__ void bfly_inv(f32x2& x0, f32x2& x1, f32x2& x2, f32x2& x3, const f32x2 w2) {
    const f32x2 w = cmul(w2, w2);
    const f32x2 t1 = cmul(x1, w), t3 = cmul(x3, w);
    const f32x2 y0 = x0 + t1, y1 = x0 - t1, y2 = x2 + t3, y3 = x2 - t3;
    const f32x2 u2 = cmul(y2, w2), u3 = cmul(y3, w2); const f32x2 u3i = {-u3.y, u3.x};
    x0 = y0 + u2; x1 = y1 + u3i; x2 = y0 - u2; x3 = y1 - u3i;
}
__device__ __forceinline__ void fft_fwd(LAS f32x2* X, int tid) {
    const f32x2 R1 = {0.92387953251128674f, -0.38268343236508977f}, R2 = {0.70710678118654752f, -0.70710678118654752f}, R3 = {0.38268343236508977f, -0.92387953251128674f};
    for (int lgb = 10; lgb >= 2; lgb -= 4) {
        const int h = 1 << lgb; const float inv16h = 1.f / (float)(16 * h);
#pragma unroll 2
        for (int G = tid; G < 1024; G += NTHR) {
            const int j = G & (h - 1), base = ((G >> lgb) << (lgb + 4)) + j;
            f32x2 x[4][4];
#pragma unroll
            for (int a = 0; a < 4; ++a)
#pragma unroll
                for (int bb = 0; bb < 4; ++bb) x[a][bb] = X[base + a * 4 * h + bb * h];
            const float rev = (float)j * inv16h; const f32x2 wb = {__builtin_amdgcn_cosf(rev), -__builtin_amdgcn_sinf(rev)};
            bfly_fwd(x[0][0], x[1][0], x[2][0], x[3][0], wb);
            bfly_fwd(x[0][1], x[1][1], x[2][1], x[3][1], cmul(wb, R1));
            bfly_fwd(x[0][2], x[1][2], x[2][2], x[3][2], cmul(wb, R2));
            bfly_fwd(x[0][3], x[1][3], x[2][3], x[3][3], cmul(wb, R3));
            const f32x2 wb2 = cmul(wb, wb), wl = cmul(wb2, wb2);
#pragma unroll
            for (int a = 0; a < 4; ++a) bfly_fwd(x[a][0], x[a][1], x[a][2], x[a][3], wl);
#pragma unroll
            for (int a = 0; a < 4; ++a)
#pragma unroll
                for (int bb = 0; bb < 4; ++bb) X[base + a * 4 * h + bb * h] = x[a][bb];
        }
        __syncthreads();
    }
#pragma unroll 4
    for (int q = tid; q < 4096; q += NTHR) {
        const int i0 = 4 * q; f32x2 x0 = X[i0], x1 = X[i0 + 1], x2 = X[i0 + 2], x3 = X[i0 + 3];
        bfly_fwd(x0, x1, x2, x3, (f32x2){1.f, 0.f});
        X[i0] = x0; X[i0 + 1] = x1; X[i0 + 2] = x2; X[i0 + 3] = x3;
    }
    __syncthreads();
}
__device__ __forceinline__ void fft_inv(LAS f32x2* X, int tid) {
    const f32x2 R1 = {0.92387953251128674f, 0.38268343236508977f}, R2 = {0.70710678118654752f, 0.70710678118654752f}, R3 = {0.38268343236508977f, 0.92387953251128674f};
    for (int lga = 0; lga <= 8; lga += 4) {
        const int h = 1 << lga; const float inv16h = 1.f / (float)(16 * h);
#pragma unroll 2
        for (int G = tid; G < 1024; G += NTHR) {
            const int j = G & (h - 1), base = ((G >> lga) << (lga + 4)) + j;
            f32x2 x[4][4];
#pragma unroll
            for (int a = 0; a < 4; ++a)
#pragma unroll
                for (int bb = 0; bb < 4; ++bb) x[a][bb] = X[base + a * 4 * h + bb * h];
            const float rev = (float)j * inv16h; const f32x2 wb = {__builtin_amdgcn_cosf(rev), __builtin_amdgcn_sinf(rev)};
            const f32x2 wb2 = cmul(wb, wb), wl = cmul(wb2, wb2);
#pragma unroll
            for (int a = 0; a < 4; ++a) bfly_inv(x[a][0], x[a][1], x[a][2], x[a][3], wl);
            bfly_inv(x[0][0], x[1][0], x[2][0], x[3][0], wb);
            bfly_inv(x[0][1], x[1][1], x[2][1], x[3][1], cmul(wb, R1));
            bfly_inv(x[0][2], x[1][2], x[2][2], x[3][2], cmul(wb, R2));
            bfly_inv(x[0][3], x[1][3], x[2][3], x[3][3], cmul(wb, R3));
#pragma unroll
            for (int a = 0; a < 4; ++a)
#pragma unroll
                for (int bb = 0; bb < 4; ++bb) X[base + a * 4 * h + bb * h] = x[a][bb];
        }
        __syncthreads();
    }
#pragma unroll 4
    for (int q = tid; q < 4096; q += NTHR) {
        f32x2 x0 = X[q], x1 = X[q + 4096], x2 = X[q + 8192], x3 = X[q + 12288];
        const float rev = (float)q * (1.f / 16384.f);
        bfly_inv(x0, x1, x2, x3, (f32x2){__builtin_amdgcn_cosf(rev), __builtin_amdgcn_sinf(rev)});
        X[q] = x0; X[q + 4096] = x1; X[q + 8192] = x2; X[q + 12288] = x3;
    }
    __syncthreads();
}
__device__ __forceinline__ void pointwise_filter(const LAS f32x2* X, f32x4* Hs, float scale, int tid) {
#pragma unroll 2
    for (int s = tid; s < 8192; s += NTHR) {
        if (s == 0) { const f32x2 A = X[0], Cm = X[1]; Hs[0] = (f32x4){(A.x + A.y) * scale, (A.x - A.y) * scale, Cm.x * scale, -Cm.y * scale}; }
        else {
            const int i1 = 2 * s, i2 = i1 ^ ((1 << (31 - __clz(i1))) - 1); const int p = (int)(__brev((unsigned)i1) >> 18);
            const f32x2 A = X[i1], B = X[i2];
            const f32x2 E = {0.5f * (A.x + B.x), 0.5f * (A.y - B.y)}; const f32x2 Dm = {A.x - B.x, A.y + B.y}; const f32x2 O = {0.5f * Dm.y, -0.5f * Dm.x};
            const float rev = (float)p * (1.f / 32768.f); const float c = __builtin_amdgcn_cosf(rev), sn = __builtin_amdgcn_sinf(rev);
            const f32x2 WO = cmul((f32x2){c, -sn}, O);
            Hs[s] = (f32x4){(E.x + WO.x) * scale, (E.y + WO.y) * scale, (E.x - WO.x) * scale, -(E.y - WO.y) * scale};
        }
    }
    __syncthreads();
}
__device__ __forceinline__ void pointwise_data(LAS f32x2* X, const f32x4* Hs, int tid) {
#pragma unroll 4
    for (int s = tid; s < 8192; s += NTHR) {
        const f32x4 hh = Hs[s];
        if (s == 0) {
            const f32x2 A = X[0]; const float Y0 = (A.x + A.y) * hh.x, YM = (A.x - A.y) * hh.y; X[0] = (f32x2){0.5f * (Y0 + YM), 0.5f * (Y0 - YM)};
            const f32x2 Cm = X[1]; const f32x2 Y = cmul((f32x2){Cm.x, -Cm.y}, (f32x2){hh.z, hh.w}); X[1] = (f32x2){Y.x, -Y.y};
        } else {
            const int i1 = 2 * s, i2 = i1 ^ ((1 << (31 - __clz(i1))) - 1); const int p = (int)(__brev((unsigned)i1) >> 18);
            const f32x2 A = X[i1], B = X[i2];
            const f32x2 E = {0.5f * (A.x + B.x), 0.5f * (A.y - B.y)}; const f32x2 Dm = {A.x - B.x, A.y + B.y}; const f32x2 O = {0.5f * Dm.y, -0.5f * Dm.x};
            const float rev = (float)p * (1.f / 32768.f); const float c = __builtin_amdgcn_cosf(rev), sn = __builtin_amdgcn_sinf(rev);
            const f32x2 WO = cmul((f32x2){c, -sn}, O);
            const f32x2 Xk = E + WO; const f32x2 Xk2 = {E.x - WO.x, -(E.y - WO.y)};
            const f32x2 Yk = cmul(Xk, (f32x2){hh.x, hh.y}), Yk2 = cmul(Xk2, (f32x2){hh.z, hh.w});
            const f32x2 Ye = {0.5f * (Yk.x + Yk2.x), 0.5f * (Yk.y - Yk2.y)}; const f32x2 Dd = {Yk.x - Yk2.x, Yk.y + Yk2.y};
            const f32x2 Yo = cmul((f32x2){0.5f * c, 0.5f * sn}, Dd);
            X[i1] = (f32x2){Ye.x - Yo.y, Ye.y + Yo.x}; X[i2] = (f32x2){Ye.x + Yo.y, Yo.x - Ye.y};
        }
    }
    __syncthreads();
}
__device__ __forceinline__ void h8_to_f(const u32x4 raw, float* e) {
#pragma unroll
    for (int i = 0; i < 4; ++i) { const unsigned w = raw[i];
        e[2 * i] = (float)__builtin_bit_cast(_Float16, (unsigned short)(w & 0xffffu)); e[2 * i + 1] = (float)__builtin_bit_cast(_Float16, (unsigned short)(w >> 16)); }
}
struct Z10 { u32x4 raw; _Float16 zm, zp; };
__device__ __forceinline__ Z10 sconv8_load(const _Float16* z, int t0) {
    Z10 r; r.raw = *(const u32x4*)(z + t0); r.zm = z[t0 > 0 ? t0 - 1 : 0]; r.zp = z[t0 + 8 < SEQ ? t0 + 8 : SEQ - 1]; return r;
}
__device__ __forceinline__ void sconv8_calc(const Z10& r, int t0, float w0, float w1, float w2, float bias, float* y) {
    float e[10]; e[0] = t0 > 0 ? (float)r.zm : 0.f; e[9] = (t0 + 8 < SEQ) ? (float)r.zp : 0.f; h8_to_f(r.raw, e + 1);
#pragma unroll
    for (int i = 0; i < 8; ++i) y[i] = bias + w0 * e[i] + w1 * e[i + 1] + w2 * e[i + 2];
}
constexpr size_t HY_WG_BYTES = 262144 + 65536;
__device__ __forceinline__ void hyena_phase(const LArgs& a, LAS unsigned char* lds) {
    const int tid0 = opaque_tid(), lane = tid0 & 63, wid = tid0 >> 6;
    LAS f32x2* X = (LAS f32x2*)lds; LAS float* red = (LAS float*)(lds + 131072);
    const _Float16* ZT = (const _Float16*)(a.ws + WS_OV); const _Float16* KT = (const _Float16*)a.out;
    bf16* YT = (bf16*)(a.ws + WS_H);
    f32x4* Hs = (f32x4*)(a.ws + WS_HYSCR + (size_t)blockIdx.x * HY_WG_BYTES); f32x4* Ys = Hs + 16384;
    const float* cw = a.in(I_OCW); const float* cb = a.in(I_OCB);
    for (int c = blockIdx.x; c < 2048; c += gridDim.x) {
        int tid = tid0; asm volatile("" : "+v"(tid));
        const float dkc = -__builtin_fabsf(MIN_DECAY_F + (float)c * ((MAX_DECAY_F - MIN_DECAY_F) / 2047.f)) * (1.4426950408889634f / 16383.f);
        for (int n = 0; n < 2; ++n) {
            const _Float16* fw = KT + (size_t)(n * 4096 + c) * SEQ; const _Float16* bw = KT + (size_t)(n * 4096 + 2048 + c) * SEQ;
            float l1 = 0.f;
            u32x4 rf[4], rb[4]; _Float16 rt[4];
#pragma unroll
            for (int j = 0; j < 4; ++j) { const int mm0 = 4 * (tid + NTHR * j); rf[j] = *(const u32x4*)(fw + 2 * mm0); rb[j] = *(const u32x4*)(bw + 16376 - 2 * mm0); rt[j] = bw[mm0 > 0 ? 16384 - 2 * mm0 : 16383]; }
#pragma unroll
            for (int j = 0; j < 4; ++j) {
                const int mm0 = 4 * (tid + NTHR * j);
                float e[8], cc[8]; h8_to_f(rf[j], e); h8_to_f(rb[j], cc);
                float top = mm0 > 0 ? (float)rt[j] : 0.f;
                {
                    const float tf = (float)(2 * mm0), tb = (float)(16376 - 2 * mm0);
#pragma unroll
                    for (int i = 0; i < 8; ++i) { e[i] *= __builtin_amdgcn_exp2f(dkc * (tf + (float)i)); cc[i] *= __builtin_amdgcn_exp2f(dkc * (tb + (float)i)); }
                    top *= __builtin_amdgcn_exp2f(dkc * (tb + 8.f));
                }
#pragma unroll
                for (int i = 0; i < 8; ++i) l1 += __builtin_fabsf(e[i]);
#pragma unroll
                for (int i = 1; i < 8; ++i) l1 += __builtin_fabsf(cc[i]);
                l1 += __builtin_fabsf(top);
                *(LAS f32x4*)(X + mm0) = (f32x4){e[0], e[1], e[2], e[3]}; *(LAS f32x4*)(X + mm0 + 2) = (f32x4){e[4], e[5], e[6], e[7]};
                *(LAS f32x4*)(X + 8192 + mm0) = (f32x4){top, cc[7], cc[6], cc[5]}; *(LAS f32x4*)(X + 8192 + mm0 + 2) = (f32x4){cc[4], cc[3], cc[2], cc[1]};
            }
            l1 = wave_sum(l1); if (lane == 0) red[wid] = l1;
            __syncthreads();
            float tot = 0.f;
#pragma unroll
            for (int w = 0; w < NWAVES; ++w) tot += red[w];
            fft_fwd(X, tid);
            pointwise_filter(X, Hs + n * 8192, 1.f / (16384.f * tot), tid);
        }
        const float w00 = cw[c], w01 = cw[HY_IN + c], w02 = cw[2 * HY_IN + c], b0 = cb[c];
        const float w10 = cw[2048 + c], w11 = cw[HY_IN + 2048 + c], w12 = cw[2 * HY_IN + 2048 + c], b1 = cb[2048 + c];
        const float w20 = cw[4096 + c], w21 = cw[HY_IN + 4096 + c], w22 = cw[2 * HY_IN + 4096 + c], b2 = cb[4096 + c];
        const float fb0 = a.in(I_FBIAS)[c], fb1 = a.in(I_FBIAS)[2048 + c];
        for (int b = 0; b < NB; ++b) {
            const _Float16* zv = ZT + (size_t)c * MLAT + b * SEQ; const _Float16* zx1 = ZT + (size_t)(2048 + c) * MLAT + b * SEQ; const _Float16* zx2 = ZT + (size_t)(4096 + c) * MLAT + b * SEQ;
            {
                Z10 zr[4];
#pragma unroll
                for (int j = 0; j < 4; ++j) zr[j] = sconv8_load(zv, 8 * (tid + NTHR * j));
#pragma unroll
                for (int j = 0; j < 4; ++j) { const int mm0 = 4 * (tid + NTHR * j); float y[8]; sconv8_calc(zr[j], 2 * mm0, w00, w01, w02, b0, y);
                    *(LAS f32x4*)(X + mm0) = (f32x4){y[0], y[1], y[2], y[3]}; *(LAS f32x4*)(X + mm0 + 2) = (f32x4){y[4], y[5], y[6], y[7]};
                    *(LAS f32x4*)(X + 8192 + mm0) = (f32x4){0.f, 0.f, 0.f, 0.f}; *(LAS f32x4*)(X + 8192 + mm0 + 2) = (f32x4){0.f, 0.f, 0.f, 0.f}; }
            }
            __syncthreads();
            fft_fwd(X, tid); pointwise_data(X, Hs, tid); fft_inv(X, tid);
            Z10 za[4], zb[4];
#pragma unroll
            for (int j = 0; j < 4; ++j) { za[j] = sconv8_load(zv, 8 * (tid + NTHR * j)); zb[j] = sconv8_load(zx1, 8 * (tid + NTHR * j)); }
#pragma unroll
            for (int j = 0; j < 4; ++j) { const int mm0 = 4 * (tid + NTHR * j); float y0[8], g[8]; sconv8_calc(za[j], 2 * mm0, w00, w01, w02, b0, y0); sconv8_calc(zb[j], 2 * mm0, w10, w11, w12, b1, g);
                const f32x4 r0 = *(const LAS f32x4*)(X + mm0), r1 = *(const LAS f32x4*)(X + mm0 + 2);
                const f32x4 o0 = (f32x4){g[0], g[1], g[2], g[3]} * (r0 + (f32x4){y0[0], y0[1], y0[2], y0[3]} * fb0), o1 = (f32x4){g[4], g[5], g[6], g[7]} * (r1 + (f32x4){y0[4], y0[5], y0[6], y0[7]} * fb0);
                *(LAS f32x4*)(X + mm0) = o0; *(LAS f32x4*)(X + mm0 + 2) = o1; Ys[mm0 / 2] = o0; Ys[mm0 / 2 + 1] = o1;
                *(LAS f32x4*)(X + 8192 + mm0) = (f32x4){0.f, 0.f, 0.f, 0.f}; *(LAS f32x4*)(X + 8192 + mm0 + 2) = (f32x4){0.f, 0.f, 0.f, 0.f}; }
            __syncthreads();
            fft_fwd(X, tid); pointwise_data(X, Hs + 8192, tid); fft_inv(X, tid);
#pragma unroll
            for (int j = 0; j < 4; ++j) za[j] = sconv8_load(zx2, 8 * (tid + NTHR * j));
            f32x4 qv[4][2];
#pragma unroll
            for (int j = 0; j < 4; ++j) { const int mm0 = 4 * (tid + NTHR * j); qv[j][0] = Ys[mm0 / 2]; qv[j][1] = Ys[mm0 / 2 + 1]; }
#pragma unroll
            for (int j = 0; j < 4; ++j) { const int mm0 = 4 * (tid + NTHR * j); float g[8]; sconv8_calc(za[j], 2 * mm0, w20, w21, w22, b2, g);
                const f32x4 r0 = *(const LAS f32x4*)(X + mm0), r1 = *(const LAS f32x4*)(X + mm0 + 2);
                const f32x4 o0 = (f32x4){g[0], g[1], g[2], g[3]} * (r0 + qv[j][0] * fb1), o1 = (f32x4){g[4], g[5], g[6], g[7]} * (r1 + qv[j][1] * fb1);
                u32x4 w; w.x = pk2(o0.x, o0.y); w.y = pk2(o0.z, o0.w); w.z = pk2(o1.x, o1.y); w.w = pk2(o1.z, o1.w);
                *(u32x4*)(YT + (size_t)c * MLAT + b * SEQ + 2 * mm0) = w; }
            __syncthreads();
        }
    }
}
__device__ __forceinline__ void transpose_phase(const LArgs& a, LAS unsigned char* lds) {
    const int tid = opaque_tid(), lane = tid & 63, wid = tid >> 6, gw = blockIdx.x * NWAVES + wid, NGW = gridDim.x * NWAVES;
    const bf16* YT = (const bf16*)(a.ws + WS_H); bf16* Y = (bf16*)(a.ws + WS_OV);
    LAS bf16* T = (LAS bf16*)(lds + wid * 16384);
    for (int it = gw; it < 32 * 512; it += NGW) {
        const int c0 = (it & 31) * 64, t0 = (it >> 5) * 64;
#pragma unroll
        for (int i = 0; i < 8; ++i) { const int ch = 8 * i + (lane >> 3), k = lane & 7; *(LAS u32x4*)(T + ch * 72 + 8 * k) = *(const u32x4*)(YT + (size_t)(c0 + ch) * MLAT + t0 + 8 * k); }
        asm volatile("s_waitcnt vmcnt(0) lgkmcnt(0)" ::: "memory");
#pragma unroll
        for (int i = 0; i < 8; ++i) { const int t = 8 * i + (lane >> 3), k = lane & 7; unsigned short e[8];
#pragma unroll
            for (int q = 0; q < 8; ++q) e[q] = T[(8 * k + q) * 72 + t];
            u32x4 w; w.x = e[0] | ((unsigned)e[1] << 16); w.y = e[2] | ((unsigned)e[3] << 16); w.z = e[4] | ((unsigned)e[5] << 16); w.w = e[6] | ((unsigned)e[7] << 16);
            *(u32x4*)(Y + (size_t)(t0 + t) * DM + c0 + 8 * k) = w; }
        asm volatile("s_waitcnt lgkmcnt(0)" ::: "memory");
    }
}

#define XB_TMO      128
#define XB_XCNT(j)  (256  + 64 * (j))
#define XB_XSUB(j)  (1280 + 64 * (j))
#define XB_XGEN(j)  (2304 + 64 * (j))
#define XB_TOP      3328
#define XB_TOPGEN   3392
#define XCD_BAR_WORDS 3456
#define XB_SPIN_CAP (1u << 18)

__device__ __forceinline__ unsigned xb_ld(unsigned* p)              { return __hip_atomic_load(p, __ATOMIC_RELAXED, __HIP_MEMORY_SCOPE_AGENT); }
__device__ __forceinline__ unsigned xb_add(unsigned* p, unsigned v) { return __hip_atomic_fetch_add(p, v, __ATOMIC_RELAXED, __HIP_MEMORY_SCOPE_AGENT); }
__device__ __forceinline__ unsigned xb_xcc_id() { return (unsigned)__builtin_amdgcn_s_getreg((3 << 11) | 20) & 0xFu; }
#define XB_SPIN(cond, bar) do { unsigned _sp = 0; while (cond) { __builtin_amdgcn_s_sleep(1); \
    if ((++_sp & 255u) == 0u) { if (xb_ld(&(bar)[XB_TMO])) break; if (_sp > XB_SPIN_CAP) { atomicAdd(&(bar)[XB_TMO], 1u); break; } } } } while (0)

struct XcdBarrier {
    unsigned* bar; unsigned x;
    volatile LAS unsigned* st;
};

__device__ __forceinline__ XcdBarrier xcd_barrier_post(unsigned* bar, volatile LAS unsigned* st) {
    XcdBarrier b; b.bar = bar; b.x = xb_xcc_id(); b.st = st;
    if (threadIdx.x == 0) (void)xb_add(&bar[XB_XCNT(b.x)], 1u);
    return b;
}
__device__ __forceinline__ void xcd_barrier_complete(unsigned* bar, unsigned x, unsigned& nloc, unsigned& nx) {
    const unsigned G = gridDim.x * gridDim.y * gridDim.z;
    unsigned sum, cnt, mine, sp = 0u;
    for (;;) {
        sum = 0u; cnt = 0u; mine = 0u;
#pragma unroll
        for (unsigned j = 0; j < 16; ++j) { const unsigned c = xb_ld(&bar[XB_XCNT(j)]); sum += c; cnt += (c > 0u) ? 1u : 0u; mine = (j == x) ? c : mine; }
        if (sum == G) break;
        __builtin_amdgcn_s_sleep(1);
        if ((++sp & 255u) == 0u) { if (xb_ld(&bar[XB_TMO])) break; if (sp > XB_SPIN_CAP) { atomicAdd(&bar[XB_TMO], 1u); break; } }
    }
    nloc = mine > 0u ? mine : 1u; nx = cnt > 0u ? cnt : 1u;
}

__device__ __forceinline__ void xcd_barrier(const XcdBarrier& b) {
    asm volatile("s_waitcnt vmcnt(0)" ::: "memory");
    __syncthreads();
    if (threadIdx.x == 0) {
        unsigned* bar = b.bar;
        __builtin_amdgcn_s_waitcnt(0);
        unsigned nloc = b.st[0], nx = b.st[1];
        if (nloc == 0u) { xcd_barrier_complete(bar, b.x, nloc, nx); b.st[0] = nloc; b.st[1] = nx; }
        const unsigned old = xb_add(&bar[XB_XSUB(b.x)], 1u);
        const unsigned gen = old / nloc;
        if (old + 1u == (gen + 1u) * nloc) {
            __builtin_amdgcn_fence(__ATOMIC_RELEASE, "agent");
            asm volatile("s_waitcnt vmcnt(0)" ::: "memory");
            const unsigned og = xb_add(&bar[XB_TOP], 1u);
            const unsigned tg = og / nx;
            if (og + 1u == (tg + 1u) * nx) xb_add(&bar[XB_TOPGEN], 1u);
            else XB_SPIN(xb_ld(&bar[XB_TOPGEN]) == tg, bar);
            __builtin_amdgcn_fence(__ATOMIC_ACQUIRE, "agent");
            xb_add(&bar[XB_XGEN(b.x)], 1u);
            asm volatile("s_waitcnt vmcnt(0)" ::: "memory");
        } else {
            XB_SPIN(xb_ld(&bar[XB_XGEN(b.x)]) == gen, bar);
            __builtin_amdgcn_fence(__ATOMIC_ACQUIRE, "agent");
            asm volatile("s_waitcnt vmcnt(0)" ::: "memory");
        }
    }
    __syncthreads();
}

constexpr size_t WS_BAR = 524288;
constexpr int XB_LDS_OFF = TAB_OFF + 512;
constexpr int N_PHASES = 20;
constexpr unsigned SYNC_AFTER = 0xFFFFFu & ~((1u << 2) | (1u << 3) | (1u << 5) | (1u << 19));
#ifndef PHSEL
#define PHSEL 0xfffff
#endif
#define PHON(k) ((PHSEL >> (k)) & 1)
__global__ void __launch_bounds__(NTHR, 2) mega_fwd(Args a_in) {
    extern __shared__ __attribute__((aligned(16))) unsigned char lds[];
    PG8_LAS unsigned char* ldsl = (PG8_LAS unsigned char*)lds;
    const int G = gridDim.x, cid = blockIdx.x;
    LAS unsigned long long* tab = (LAS unsigned long long*)(ldsl + TAB_OFF);
    if (threadIdx.x == 0) {
#pragma unroll
        for (int i = 0; i < 33; ++i) tab[i] = (unsigned long long)a_in.in[i];
        tab[33] = (unsigned long long)a_in.out; tab[34] = (unsigned long long)a_in.ws;
    }
    if (threadIdx.x == 0) { ((LAS unsigned*)(ldsl + XB_LDS_OFF))[0] = 0u; ((LAS unsigned*)(ldsl + XB_LDS_OFF))[1] = 0u; }
    __syncthreads();
    const int ph_lo = a_in.ph_lo, ph_hi = a_in.ph_hi;
    (void)xcd_barrier_post((unsigned*)(a_in.ws + WS_BAR), (volatile LAS unsigned*)(ldsl + XB_LDS_OFF));
#ifndef REPEAT_MASK
#define REPEAT_MASK 0
#endif
    for (int ph2 = 2 * ph_lo; ph2 < 2 * ph_hi; ++ph2) {
        const int ph = ph2 >> 1;
        if ((ph2 & 1) && !((REPEAT_MASK >> ph) & 1)) continue;
        const bool last_pass = (ph2 & 1) || !((REPEAT_MASK >> ph) & 1);
        unsigned tab_off = TAB_OFF; asm volatile("" : "+s"(tab_off) :: "memory");
        const LAS unsigned long long* tabl = (const LAS unsigned long long*)(ldsl + tab_off);
        const LArgs a{tabl, (float*)(__attribute__((address_space(1))) float*)tab_ld(tabl, 33), (unsigned char*)(__attribute__((address_space(1))) unsigned char*)tab_ld(tabl, 34)};
        unsigned char* ws = a.ws;
        const float* mods = (const float*)(ws + WS_MODS);
        const int layer = ph >= 11 ? 1 : 0;
        const float* modsL = mods + (size_t)layer * 3 * 12288;
        switch (ph) {
        case 0: if (PHON(0)) p0_prologue(a, ldsl); break;
        case 1: if (PHON(1)) prenorm_rows<0>(a, MALL, a.in(I_NORM1), modsL, 0, (bf16*)(ws + WS_H)); break;
        case 2: if (PHON(2)) {
            {
                pg8::Gemm g{(const bf16*)(ws + WS_H), (const bf16*)(ws + WS_WIN), MALL, 1024, 2048};
                pg8::EpiIn0 E; E.out0 = (bf16*)(ws + WS_K); E.grp_stride = 0; E.scale0 = 1.f; E.lat0 = MCTX;
                pg8::StaticOrder S; S.init(g.M, g.N, G, cid);
                pg8::gemm_phase<pg8::EpiIn0, pg8::StaticOrder, true, true>(ldsl, g, S, E);
            }
            {
                pg8::Gemm g{(const bf16*)(ws + WS_H) + (size_t)MCTX * DM, (const bf16*)(ws + WS_WIN) + (size_t)2048 * DM, MLAT, 3072, 2048};
                pg8::EpiIn0 E; E.out0 = (bf16*)(ws + WS_Q); E.grp_stride = (WS_U - WS_Q) / 2; E.scale0 = 0.125f * 1.4426950408889634f; E.lat0 = 0;
                pg8::StaticOrder S; S.init(g.M, g.N, G, cid);
                pg8::gemm_phase<pg8::EpiIn0, pg8::StaticOrder, true, true>(ldsl, g, S, E);
            }
        } break;
        case 3: if (PHON(3)) {
            pg8::Gemm g{(const bf16*)(ws + WS_WIN) + (size_t)1024 * DM, (const bf16*)(ws + WS_H), 1024, MALL, 2048}; pg8::EpiPlain16<0> E; E.O = (bf16*)(ws + WS_VT); E.ldc = MALL;
            pg8::StaticOrder S; S.init(g.M, g.N, G, (cid + G / 2) % G);
            pg8::gemm_phase<pg8::EpiPlain16<0>, pg8::StaticOrder, true, true>(ldsl, g, S, E);
        } break;
        case 4: if (PHON(4)) {
            pg8::Gemm g{(const bf16*)(ws + WS_W4X), (const bf16*)(ws + WS_H3X), 8192, SEQ, 256}; pg8::EpiPlain16<1> E; E.O = (bf16*)a.out; E.ldc = SEQ;
            pg8::StaticOrder S; S.init(g.M, g.N, G, cid);
            pg8::gemm_phase<pg8::EpiPlain16<1>, pg8::StaticOrder, true, true>(ldsl, g, S, E);
        } break;
        case 5: if (PHON(5)) attn_phase(a, ldsl); break;
        case 6: if (PHON(6)) sgu_phase(a, ldsl); break;
        case 7: case 10: case 15: case 18: if (PHON(7)) {
            pg8::Gemm g; pg8::EpiResid E; E.gate_bstride = 12288; E.out = (float*)(ws + WS_X);
            if (ph == 7) { g = pg8::Gemm{(const bf16*)(ws + WS_H), (const bf16*)(ws + WS_WOUT0), MLAT, 2048, 2048}; E.base = a.in(I_X); E.gate = modsL + 2 * 2048; }
            else if (ph == 15) { g = pg8::Gemm{(const bf16*)(ws + WS_OV), (const bf16*)(ws + WS_OOUT), MLAT, 2048, 2048}; E.base = (const float*)(ws + WS_X); E.gate = modsL + 2 * 2048; }
            else { g = pg8::Gemm{(const bf16*)(ws + WS_OV), (const bf16*)(ws + (layer ? WS_WD1 : WS_WD0)), MLAT, 2048, DFF}; E.base = (const float*)(ws + WS_X); E.gate = modsL + 5 * 2048; }
            pg8::StaticOrder S; S.init(g.M, g.N, G, cid);
            pg8::gemm_phase<pg8::EpiResid, pg8::StaticOrder, true, true>(ldsl, g, S, E);
        } break;
        case 8: case 16: if (PHON(8)) prenorm_rows<1>(a, MLAT, a.in(I_NORM2) + layer * DM, modsL, 3, (bf16*)(ws + WS_H)); break;
        case 9: case 17: if (PHON(9)) {
            pg8::Gemm g{(const bf16*)(ws + WS_H), (const bf16*)(ws + (layer ? WS_WGU1 : WS_WGU0)), MLAT, 2 * DFF, 2048}; pg8::EpiSwiglu E; E.O = (bf16*)(ws + WS_OV);
            pg8::StaticOrder S; S.init(g.M, g.N, G, cid);
            pg8::gemm_phase<pg8::EpiSwiglu, pg8::StaticOrder, true, true>(ldsl, g, S, E);
        } break;
        case 11: if (PHON(11)) prenorm_rows<1>(a, MLAT, a.in(I_NORM1) + DM, modsL, 0, (bf16*)(ws + WS_H)); break;
        case 12: if (PHON(12)) {
            pg8::Gemm g{(const bf16*)(ws + WS_OIN), (const bf16*)(ws + WS_H), HY_IN, MLAT, 2048}; pg8::EpiPlain16<1> E; E.O = (bf16*)(ws + WS_OV); E.ldc = MLAT;
            pg8::StaticOrder S; S.init(g.M, g.N, G, cid);
            pg8::gemm_phase<pg8::EpiPlain16<1>, pg8::StaticOrder, true, true>(ldsl, g, S, E);
        } break;
        case 13: if (PHON(13)) hyena_phase(a, ldsl); break;
        case 14: if (PHON(14)) transpose_phase(a, ldsl); break;
        case 19: if (PHON(19)) final_norm_rows(a); break;
        default: break;
        }
        if (ph + 1 < ph_hi && (((SYNC_AFTER >> ph) & 1u) || !last_pass)) { if (ph == 0) cg::this_grid().sync();
            else { XcdBarrier xb; xb.bar = (unsigned*)(a.ws + WS_BAR); xb.x = xb_xcc_id(); xb.st = (volatile LAS unsigned*)(ldsl + XB_LDS_OFF); xcd_barrier(xb); } }
        else if (ph + 1 < ph_hi) __syncthreads();
    }
}

extern "C" void kernel_launch(void* const* d_in, const int* in_sizes, int n_in, void* d_out, int out_size, void* d_ws, size_t ws_size, hipStream_t stream) {
    static int grid = 0;
    if (grid == 0) {
        if (n_in != 33 || out_size != MLAT * DM || ws_size < WS_END) { fprintf(stderr, "kernel_launch: unexpected shapes (n_in %d, out %d, ws %zu)\n", n_in, out_size, ws_size); grid = -1; return; }
        int dev = 0, cus = 0, per_cu = 0;
        hipGetDevice(&dev); hipDeviceGetAttribute(&cus, hipDeviceAttributeMultiprocessorCount, dev);
        hipFuncSetAttribute((const void*)mega_fwd, hipFuncAttributeMaxDynamicSharedMemorySize, LDS_BYTES);
        if (hipOccupancyMaxActiveBlocksPerMultiprocessor(&per_cu, (const void*)mega_fwd, NTHR, LDS_BYTES) != hipSuccess || per_cu < 1) per_cu = 1;
        (void)hipGetLastError();
        grid = cus * per_cu;
    }
    if (grid < 0) return;
    hipMemsetAsync(d_ws, 0, 1 * MiB, stream);
    Args a{};
    for (int i = 0; i < 33; ++i) a.in[i] = (const float*)d_in[i];
    a.out = (float*)d_out; a.ws = (unsigned char*)d_ws;
#if N_LAUNCH_MODE == 1
    a.ph_lo = 0; a.ph_hi = N_PHASES;
    void* args[] = {&a};
    hipError_t e = hipLaunchCooperativeKernel((const void*)mega_fwd, dim3(grid), dim3(NTHR), args, LDS_BYTES, stream);
    if (e != hipSuccess) fprintf(stderr, "cooperative launch failed: %s (grid %d)\n", hipGetErrorString(e), grid);
#else
    for (int ph = 0; ph < N_PHASES; ++ph) { a.ph_lo = ph; a.ph_hi = ph + 1; hipLaunchKernelGGL(mega_fwd, dim3(grid), dim3(NTHR), LDS_BYTES, stream, a); }
#endif
}
```

```cpp
#include <hip/hip_runtime.h>
#include <hip/hip_cooperative_groups.h>
#include <cstdio>
#include <cstdint>
namespace cg = cooperative_groups;
#ifndef N_LAUNCH_MODE
#define N_LAUNCH_MODE 1
#endif
constexpr int DM = 2048, SEQ = 16384, NB = 2, MLAT = NB * SEQ  , NCTX = 256, MCTX = NB * NCTX  , MALL = MLAT + MCTX  ;
constexpr int DFF = 5632, EVEN_IN = 5120, HY_IN = 6144;
constexpr float MIN_DECAY_F = -3.0701134573253945f, MAX_DECAY_F = -15.350567286626973f;
__device__ __forceinline__ int opaque_tid() { int t = threadIdx.x; asm volatile("" : "+v"(t)); return t; }
namespace pg8 {
#define PG8_LAS __attribute__((address_space(3)))
typedef unsigned short bf16_t;
typedef short bf16x8 __attribute__((ext_vector_type(8)));
typedef float f32x4 __attribute__((ext_vector_type(4)));
typedef unsigned u32x4 __attribute__((ext_vector_type(4)));
constexpr int BM = 256, BK = 64, HALF = 128, HTB = HALF * BK * 2  , STAGE_BYTES = 8 * HTB, NXCD = 8, WGM = 8;

__host__ __device__ __forceinline__ int lds_byte(int r, int c) { const int st = (r >> 4) * 2 + (c >> 5), rr = r & 15, cc = c & 31, ob = rr * 64 + cc * 2; return st * 1024 + (ob ^ (((ob >> 9) & 1) << 5)); }
__host__ __device__ __forceinline__ void stage_rc(int b, int& R, int& C) { const int st = b / 1024, sb = b % 1024, swz = sb ^ (((sb >> 9) & 1) << 5); R = (st >> 1) * 16 + swz / 64; C = (st & 1) * 32 + (swz % 64) / 2; }
__host__ __device__ __forceinline__ int perm32(int rho) { const int n = rho >> 4, i = rho & 15; return 8 * (i >> 2) + 4 * n + (i & 3); }

struct Unit { int pm, pn; };
struct Gemm { const bf16_t* A; const bf16_t* Bt; int M, N, K; };

struct StaticOrder {
    int nM, nN, nwg, G, c;
    __host__ __device__ void init(int M, int N, int G_, int c_) { nM = M / BM; nN = N / BM; nwg = nM * nN; G = G_; c = c_; }
    __host__ __device__ bool next(int i, Unit& u) const {
        const long L = (long)i * G + c; if (L >= nwg) return false;
        int wgid = (int)L; { const int q = nwg / NXCD, r = nwg % NXCD, xcd = wgid % NXCD, off = wgid / NXCD; wgid = (xcd < r ? xcd * (q + 1) : r * (q + 1) + (xcd - r) * q) + off; }
        const int nig = WGM * nN, gid = wgid / nig, fm = gid * WGM, gsz = (nM - fm) < WGM ? (nM - fm) : WGM;
        u.pm = fm + ((wgid % nig) % gsz); u.pn = (wgid % nig) / gsz; return true;
    }
    __device__ __forceinline__ void a_ready(const Unit&) const {}
    __device__ __forceinline__ void done(const Unit&) const {}
};

__device__ __forceinline__ unsigned cvt_pk_bf16(float lo, float hi) { unsigned r; asm volatile("v_cvt_pk_bf16_f32 %0, %1, %2" : "=v"(r) : "v"(lo), "v"(hi)); return r; }
typedef _Float16 f16x2_t __attribute__((ext_vector_type(2)));
typedef unsigned u32x2 __attribute__((ext_vector_type(2)));
__device__ __forceinline__ unsigned cvt_pk_f16(float lo, float hi) { unsigned r; asm volatile("v_cvt_pkrtz_f16_f32 %0, %1, %2" : "=v"(r) : "v"(lo), "v"(hi)); return r; }
__device__ __forceinline__ float gelu_tanh(float x) {
    const float y = 0.7978845608028654f * (x + 0.044715f * x * x * x);
    const float e = __builtin_amdgcn_exp2f(y * 2.8853900817779268f);
    const float t = 1.f - 2.f * __builtin_amdgcn_rcpf(1.f + e);
    return 0.5f * x * (1.f + t);
}
__device__ __forceinline__ float silu_f(float x) { return x * __builtin_amdgcn_rcpf(1.f + __builtin_amdgcn_exp2f(-x * 1.4426950408889634f)); }

template <int mode> struct EpiPlain16 {
    static constexpr bool PERM = true, AFTER_DRAIN = false;
    unsigned short* O; int ldc;
    __device__ __forceinline__ void operator()(const f32x4 (&acc)[2][2][4][2], const Unit& u, int wr, int wc, int fr, int fq) const {
        const int row0 = u.pm * BM + wr * 64 + fr, col0 = u.pn * BM + wc * 32 + 8 * fq;
#pragma unroll
        for (int ai = 0; ai < 2; ++ai)
#pragma unroll
            for (int m = 0; m < 4; ++m) {
                const int row = row0 + ai * HALF + m * 16; unsigned short* rowp = O + (size_t)row * ldc + col0;
                float dk = 0.f;
                if (mode == 2) { const int c = row & 2047; const float delta = __builtin_fabsf(MIN_DECAY_F + (float)c * ((MAX_DECAY_F - MIN_DECAY_F) / 2047.f)); dk = -delta * (1.4426950408889634f / 16383.f); }
#pragma unroll
                for (int bj = 0; bj < 2; ++bj) {
                    f32x4 v0 = acc[ai][bj][m][0], v1 = acc[ai][bj][m][1];
                    if (mode == 2) { const float t0 = (float)(col0 + bj * HALF);
#pragma unroll
                        for (int j = 0; j < 4; ++j) { v0[j] *= __builtin_amdgcn_exp2f(dk * (t0 + (float)j)); v1[j] *= __builtin_amdgcn_exp2f(dk * (t0 + (float)(4 + j))); } }
                    u32x4 w;
                    if (mode == 0) { w.x = cvt_pk_bf16(v0[0], v0[1]); w.y = cvt_pk_bf16(v0[2], v0[3]); w.z = cvt_pk_bf16(v1[0], v1[1]); w.w = cvt_pk_bf16(v1[2], v1[3]); }
                    else { w.x = cvt_pk_f16(v0[0], v0[1]); w.y = cvt_pk_f16(v0[2], v0[3]); w.z = cvt_pk_f16(v1[0], v1[1]); w.w = cvt_pk_f16(v1[2], v1[3]); }
                    *(u32x4*)(rowp + bj * HALF) = w;
                }
                asm volatile("" ::: "memory");
            }
    }
};
struct EpiIn0 {
    static constexpr bool PERM = false, AFTER_DRAIN = false;
    unsigned short* out0; size_t grp_stride; float scale0; int lat0;
    __device__ __forceinline__ void operator()(const f32x4 (&acc)[2][2][4][2], const Unit& u, int wr, int wc, int fr, int fq) const {
        const int grp = (u.pn * BM) >> 10, colt = (u.pn * BM) & 1023;
        unsigned short* base = out0 + (size_t)grp * grp_stride;
        const int kd = grp == 0 ? 0 : 2;
        const float sc = scale0;
        const int col0 = colt + wc * 32 + 4 * fq, row0 = u.pm * BM + wr * 64 + fr;
        if (kd == 0) {
            const bool lat = (u.pm * BM) >= lat0;
            float invrev[4];
#pragma unroll
            for (int j = 0; j < 4; ++j) invrev[j] = __builtin_amdgcn_exp2f(-(float)(4 * fq + j) * (13.287712379549449f / 16.f)) * 0.15915494309189535f;
#pragma unroll
            for (int ai = 0; ai < 2; ++ai)
#pragma unroll
                for (int m = 0; m < 4; ++m) {
                    const int row = row0 + ai * HALF + m * 16; const int t = (row - lat0) & 16383;
                    const float pos = (wc & 1) ? (float)(t & 63) : (float)(t >> 6);
                    float cs[4], sn[4];
#pragma unroll
                    for (int j = 0; j < 4; ++j) { const float r = __builtin_amdgcn_fractf(pos * invrev[j]); cs[j] = lat ? __builtin_amdgcn_cosf(r) : 1.f; sn[j] = lat ? __builtin_amdgcn_sinf(r) : 0.f; }
                    unsigned short* rowp = base + (size_t)row * 1024 + col0;
#pragma unroll
                    for (int bj = 0; bj < 2; ++bj) {
                        const f32x4 x1 = acc[ai][bj][m][0], x2 = acc[ai][bj][m][1]; float o1[4], o2[4];
#pragma unroll
                        for (int j = 0; j < 4; ++j) { o1[j] = (x1[j] * cs[j] - x2[j] * sn[j]) * sc; o2[j] = (x2[j] * cs[j] + x1[j] * sn[j]) * sc; }
                        u32x2 w1, w2; w1.x = cvt_pk_bf16(o1[0], o1[1]); w1.y = cvt_pk_bf16(o1[2], o1[3]); w2.x = cvt_pk_bf16(o2[0], o2[1]); w2.y = cvt_pk_bf16(o2[2], o2[3]);
                        *(u32x2*)(rowp + bj * HALF) = w1; *(u32x2*)(rowp + bj * HALF + 16) = w2;
                    }
                    asm volatile("" ::: "memory");
                }
        } else {
#pragma unroll
            for (int ai = 0; ai < 2; ++ai)
#pragma unroll
                for (int m = 0; m < 4; ++m) {
                    const int row = row0 + ai * HALF + m * 16; unsigned short* rowp = base + (size_t)row * 1024 + col0;
#pragma unroll
                    for (int bj = 0; bj < 2; ++bj)
#pragma unroll
                        for (int n = 0; n < 2; ++n) { const f32x4 v = acc[ai][bj][m][n]; u32x2 w; w.x = cvt_pk_bf16(gelu_tanh(v[0]), gelu_tanh(v[1])); w.y = cvt_pk_bf16(gelu_tanh(v[2]), gelu_tanh(v[3]));
                            *(u32x2*)(rowp + bj * HALF + n * 16) = w; }
                    asm volatile("" ::: "memory");
                }
        }
    }
};
struct EpiResid {
    static constexpr bool PERM = false, AFTER_DRAIN = false;
    const float* base; float* out; const float* gate; int gate_bstride;
    __device__ __forceinline__ void operator()(const f32x4 (&acc)[2][2][4][2], const Unit& u, int wr, int wc, int fr, int fq) const {
        const int col0 = u.pn * BM + wc * 32 + 4 * fq, row0 = u.pm * BM + wr * 64 + fr; const float* gp = gate + (size_t)((u.pm * BM) >> 14) * gate_bstride + col0;
        f32x4 gv[2][2];
#pragma unroll
        for (int bj = 0; bj < 2; ++bj)
#pragma unroll
            for (int n = 0; n < 2; ++n) gv[bj][n] = *(const f32x4*)(gp + bj * HALF + n * 16);
#pragma unroll
        for (int ai = 0; ai < 2; ++ai) {
            f32x4 bs[4][2][2];
#pragma unroll
            for (int m = 0; m < 4; ++m) { const size_t off = (size_t)(row0 + ai * HALF + m * 16) * 2048 + col0;
#pragma unroll
                for (int bj = 0; bj < 2; ++bj)
#pragma unroll
                    for (int n = 0; n < 2; ++n) bs[m][bj][n] = *(const f32x4*)(base + off + bj * HALF + n * 16); }
#pragma unroll
            for (int m = 0; m < 4; ++m) { const size_t off = (size_t)(row0 + ai * HALF + m * 16) * 2048 + col0;
#pragma unroll
                for (int bj = 0; bj < 2; ++bj)
#pragma unroll
                    for (int n = 0; n < 2; ++n) *(f32x4*)(out + off + bj * HALF + n * 16) = bs[m][bj][n] + gv[bj][n] * acc[ai][bj][m][n]; }
            asm volatile("" ::: "memory");
        }
    }
};
struct EpiSwiglu {
    static constexpr bool PERM = true, AFTER_DRAIN = false;
    unsigned short* O;
    __device__ __forceinline__ void operator()(const f32x4 (&acc)[2][2][4][2], const Unit& u, int wr, int wc, int fr, int fq) const {
        const int col0 = u.pn * HALF + wc * 32 + 8 * fq, row0 = u.pm * BM + wr * 64 + fr;
#pragma unroll
        for (int ai = 0; ai < 2; ++ai)
#pragma unroll
            for (int m = 0; m < 4; ++m) {
                float o[8];
#pragma unroll
                for (int n = 0; n < 2; ++n)
#pragma unroll
                    for (int j = 0; j < 4; ++j) o[4 * n + j] = silu_f(acc[ai][0][m][n][j]) * acc[ai][1][m][n][j];
                u32x4 w; w.x = cvt_pk_bf16(o[0], o[1]); w.y = cvt_pk_bf16(o[2], o[3]); w.z = cvt_pk_bf16(o[4], o[5]); w.w = cvt_pk_bf16(o[6], o[7]);
                *(u32x4*)(O + (size_t)(row0 + ai * HALF + m * 16) * DFF + col0) = w;
                asm volatile("" ::: "memory");
            }
    }
};
template <class Epi, class Sched, bool ALIGN_EPI = false, bool SP2 = false>
__device__ __forceinline__ void gemm_phase(PG8_LAS unsigned char* lds, const Gemm g, const Sched& S, const Epi& E) {
    const int tid = opaque_tid(), wid = __builtin_amdgcn_readfirstlane(tid >> 6), lane = tid & 63, wr = wid >> 2, wc = wid & 3, fr = lane & 15, fq = lane >> 4;
    const int K = g.K, nt = K / BK;
    unsigned voffA[2], voffB[2];
#pragma unroll
    for (int i = 0; i < 2; ++i) { int R, C; stage_rc(tid * 16 + i * 8192, R, C); const int Rb = Epi::PERM ? ((R & ~31) + perm32(R & 31)) : R;
        voffA[i] = (unsigned)(R * K + C) * 2u; voffB[i] = (unsigned)(Rb * K + C) * 2u; }
    const size_t kstep = (size_t)(BK * 2);
    const size_t hstep = (size_t)HALF * K * 2;
    const size_t tstep = 2 * hstep;
    const unsigned ldsw = (unsigned)wid * 1024u;
    const int aoff = lds_byte(wr * 64 + fr, fq * 8), boff = lds_byte(wc * 32 + fr, fq * 8);
#define PG8_SA(b, h) (((b) * 2 + (h)) * HTB)
#define PG8_SB(b, h) ((4 + (b) * 2 + (h)) * HTB)
#define PG8_STAGE(bufoff, gbase, voff) do { _Pragma("unroll") for (int _i = 0; _i < 2; ++_i) \
        __builtin_amdgcn_global_load_lds((const unsigned*)((const char*)(gbase) + (voff)[_i]), (PG8_LAS unsigned*)(lds + (bufoff) + ldsw + _i * 8192), 16, 0, 0); } while (0)
#define PG8_LDA(dst, b, h) do { _Pragma("unroll") for (int m = 0; m < 4; ++m) _Pragma("unroll") for (int k = 0; k < 2; ++k) dst[m][k] = *(const PG8_LAS bf16x8*)(lds + PG8_SA(b, h) + aoff + m * 2048 + k * 1024); } while (0)
#define PG8_LDB(dst, b, h) do { _Pragma("unroll") for (int n = 0; n < 2; ++n) _Pragma("unroll") for (int k = 0; k < 2; ++k) dst[n][k] = *(const PG8_LAS bf16x8*)(lds + PG8_SB(b, h) + boff + n * 2048 + k * 1024); } while (0)
#define PG8_MMA(ai, bj, At, Bt) do { __builtin_amdgcn_s_setprio(1); _Pragma("unroll") for (int m = 0; m < 4; ++m) _Pragma("unroll") for (int n = 0; n < 2; ++n) _Pragma("unroll") for (int k = 0; k < 2; ++k) \
        acc[ai][bj][m][n] = __builtin_amdgcn_mfma_f32_16x16x32_bf16(Bt[n][k], At[m][k], acc[ai][bj][m][n], 0, 0, 0); __builtin_amdgcn_s_setprio(0); } while (0)
#define PG8_WAIT_V(n) asm volatile("s_waitcnt vmcnt(" #n ")" ::: "memory")
#define PG8_WAIT_L(n) asm volatile("s_waitcnt lgkmcnt(" #n ")" ::: "memory")
#define PG8_BAR __builtin_amdgcn_s_barrier()
#define PG8_SCHED __builtin_amdgcn_sched_barrier(0)
    Unit cur, nxt; int ui = 0;
    if (!S.next(0, cur)) return;
    f32x4 acc[2][2][4][2];
#pragma unroll
    for (int a = 0; a < 2; ++a)
#pragma unroll
        for (int b = 0; b < 2; ++b)
#pragma unroll
            for (int m = 0; m < 4; ++m)
#pragma unroll
                for (int n = 0; n < 2; ++n) acc[a][b][m][n] = (f32x4){0.f, 0.f, 0.f, 0.f};
    bf16x8 At[4][2], B0[2][2], B1[2][2];
    const char* cA = (const char*)g.A + (size_t)cur.pm * tstep; const char* cB = (const char*)g.Bt + (size_t)cur.pn * tstep;
    S.a_ready(cur);
    if constexpr (SP2) {
        PG8_STAGE(PG8_SB(0, 0), cB, voffB); PG8_STAGE(PG8_SB(0, 1), cB + hstep, voffB); PG8_STAGE(PG8_SA(0, 0), cA, voffA); PG8_STAGE(PG8_SA(0, 1), cA + hstep, voffA);
        if (wr == 1) PG8_BAR;
        PG8_WAIT_V(2); PG8_BAR;
        PG8_STAGE(PG8_SB(1, 0), cB + kstep, voffB); PG8_STAGE(PG8_SA(1, 0), cA + kstep, voffA); PG8_STAGE(PG8_SB(1, 1), cB + hstep + kstep, voffB);
        PG8_WAIT_V(6); PG8_BAR;
    } else {
        PG8_STAGE(PG8_SB(0, 0), cB, voffB); PG8_STAGE(PG8_SA(0, 0), cA, voffA); PG8_STAGE(PG8_SB(0, 1), cB + hstep, voffB); PG8_STAGE(PG8_SA(0, 1), cA + hstep, voffA);
        if (wr == 1) PG8_BAR;
        PG8_WAIT_V(4); PG8_BAR;
        PG8_STAGE(PG8_SB(1, 0), cB + kstep, voffB); PG8_STAGE(PG8_SA(1, 0), cA + kstep, voffA); PG8_STAGE(PG8_SB(1, 1), cB + hstep + kstep, voffB);
        PG8_WAIT_V(6); PG8_BAR;
    }
    for (;;) {
        const bool has_next = S.next(ui + 1, nxt);
        const char* nA = has_next ? (const char*)g.A + (size_t)nxt.pm * tstep : cA; const char* nB = has_next ? (const char*)g.Bt + (size_t)nxt.pn * tstep : cB;
        for (int t = 0; t < nt; t += 2) {
            const bool last = (t == nt - 2);
            const char* a1 = cA + (size_t)(t + 1) * kstep;
            const char* a2 = last ? nA : cA + (size_t)(t + 2) * kstep; const char* b2 = last ? nB : cB + (size_t)(t + 2) * kstep;
            const char* a3 = a2 + kstep; const char* b3 = b2 + kstep;
            if (last && has_next) S.a_ready(nxt);
            if constexpr (SP2) {
            PG8_LDB(B0, 0, 0); PG8_LDB(B1, 0, 1); PG8_SCHED; PG8_LDA(At, 0, 0); PG8_STAGE(PG8_SA(1, 1), a1 + hstep, voffA);
            PG8_WAIT_V(8); PG8_WAIT_L(0); PG8_BAR; PG8_MMA(0, 0, At, B0); PG8_MMA(0, 1, At, B1); PG8_BAR; PG8_SCHED;
            PG8_LDA(At, 0, 1); PG8_STAGE(PG8_SB(0, 0), b2, voffB); PG8_STAGE(PG8_SB(0, 1), b2 + hstep, voffB); PG8_STAGE(PG8_SA(0, 0), a2, voffA);
            PG8_WAIT_V(8); PG8_WAIT_L(0); PG8_BAR; PG8_MMA(1, 0, At, B0); PG8_MMA(1, 1, At, B1); PG8_BAR; PG8_SCHED;
            PG8_LDB(B0, 1, 0); PG8_LDB(B1, 1, 1); PG8_SCHED; PG8_LDA(At, 1, 0); PG8_STAGE(PG8_SA(0, 1), a2 + hstep, voffA);
            PG8_WAIT_V(8); PG8_WAIT_L(0); PG8_BAR; PG8_MMA(0, 0, At, B0); PG8_MMA(0, 1, At, B1); PG8_BAR; PG8_SCHED;
            PG8_LDA(At, 1, 1); PG8_STAGE(PG8_SB(1, 0), b3, voffB); PG8_STAGE(PG8_SB(1, 1), b3 + hstep, voffB); PG8_STAGE(PG8_SA(1, 0), a3, voffA);
            PG8_WAIT_V(8); PG8_WAIT_L(0); PG8_BAR; PG8_MMA(1, 0, At, B0); PG8_MMA(1, 1, At, B1); PG8_BAR; PG8_SCHED;
            } else {
            PG8_LDB(B0, 0, 0); PG8_SCHED; PG8_LDA(At, 0, 0); PG8_STAGE(PG8_SA(1, 1), a1 + hstep, voffA);
            PG8_WAIT_L(8); PG8_BAR; PG8_WAIT_L(0); PG8_MMA(0, 0, At, B0); PG8_BAR; PG8_SCHED;
            PG8_LDB(B1, 0, 1); PG8_STAGE(PG8_SB(0, 0), b2, voffB);
            PG8_BAR; PG8_WAIT_L(0); PG8_MMA(0, 1, At, B1); PG8_BAR;
            PG8_LDA(At, 0, 1); PG8_STAGE(PG8_SA(0, 0), a2, voffA);
            PG8_BAR; PG8_WAIT_L(0); PG8_MMA(1, 0, At, B0); PG8_BAR; PG8_SCHED;
            PG8_STAGE(PG8_SB(0, 1), b2 + hstep, voffB);
            PG8_WAIT_V(6); PG8_BAR; PG8_MMA(1, 1, At, B1); PG8_BAR;
            PG8_LDB(B0, 1, 0); PG8_SCHED; PG8_LDA(At, 1, 0); PG8_STAGE(PG8_SA(0, 1), a2 + hstep, voffA);
            PG8_WAIT_L(8); PG8_BAR; PG8_WAIT_L(0); PG8_MMA(0, 0, At, B0); PG8_BAR; PG8_SCHED;
            PG8_LDB(B1, 1, 1); PG8_STAGE(PG8_SB(1, 0), b3, voffB);
            PG8_BAR; PG8_WAIT_L(0); PG8_MMA(0, 1, At, B1); PG8_BAR;
            PG8_LDA(At, 1, 1); PG8_STAGE(PG8_SA(1, 0), a3, voffA);
            PG8_BAR; PG8_WAIT_L(0); PG8_MMA(1, 0, At, B0); PG8_BAR; PG8_SCHED;
            PG8_STAGE(PG8_SB(1, 1), b3 + hstep, voffB);
            PG8_WAIT_V(6); PG8_BAR; PG8_MMA(1, 1, At, B1); PG8_BAR;
            }
        }
        if constexpr (ALIGN_EPI) { if (wr == 0) PG8_BAR; }
        if constexpr (!Epi::AFTER_DRAIN) { E(acc, cur, wr, wc, fr, fq); S.done(cur); }
        if (!has_next) break;
#pragma unroll
        for (int a = 0; a < 2; ++a)
#pragma unroll
            for (int b = 0; b < 2; ++b)
#pragma unroll
                for (int m = 0; m < 4; ++m)
#pragma unroll
                    for (int n = 0; n < 2; ++n) acc[a][b][m][n] = (f32x4){0.f, 0.f, 0.f, 0.f};
        cur = nxt; cA = nA; cB = nB; ++ui;
        if constexpr (ALIGN_EPI) { if (wr == 1) PG8_BAR; }
    }
    PG8_WAIT_V(0);
    if constexpr (!ALIGN_EPI) { if (wr == 0) PG8_BAR; }
    PG8_BAR;
    if constexpr (Epi::AFTER_DRAIN) { E.fused(acc, cur, wr, wc, fr, fq, lds, wid, lane); S.done(cur); }
#undef PG8_SA
#undef PG8_SB
#undef PG8_STAGE
#undef PG8_LDA
#undef PG8_LDB
#undef PG8_MMA
#undef PG8_WAIT_V
#undef PG8_WAIT_L
#undef PG8_BAR
#undef PG8_SCHED
}
}
#define LAS __attribute__((address_space(3)))
typedef unsigned short bf16;
typedef float f32x4 __attribute__((ext_vector_type(4)));
typedef float f32x2 __attribute__((ext_vector_type(2)));
typedef float f32x16 __attribute__((ext_vector_type(16)));
typedef short bf16x8 __attribute__((ext_vector_type(8)));
typedef unsigned u32x4 __attribute__((ext_vector_type(4)));
typedef unsigned u32x2 __attribute__((ext_vector_type(2)));
typedef _Float16 f16x2 __attribute__((ext_vector_type(2)));
constexpr int NWAVES = 8, NTHR = 512;
constexpr int LDS_BYTES = 147456;
constexpr size_t MiB = 1u << 20;
constexpr size_t WS_MODS = 0;
constexpr size_t WS_H3X = 1 * MiB;
constexpr size_t WS_W4X = 9 * MiB;
constexpr size_t WS_WIN = 16 * MiB;
constexpr size_t WS_WOUT0 = 36 * MiB;
constexpr size_t WS_WGU0 = 44 * MiB;
constexpr size_t WS_WD0 = 88 * MiB;
constexpr size_t WS_HYSCR = 16 * MiB;
constexpr size_t WS_OIN = 110 * MiB;
constexpr size_t WS_OOUT = 134 * MiB;
constexpr size_t WS_WGU1 = 142 * MiB;
constexpr size_t WS_WD1 = 186 * MiB;
constexpr size_t WS_X = 208 * MiB;
constexpr size_t WS_H = 464 * MiB;
constexpr size_t WS_OV = 594 * MiB;
constexpr size_t WS_K = WS_OV, WS_VT = WS_OV + 65 * MiB, WS_Q = WS_OV + 130 * MiB, WS_U = WS_OV + 194 * MiB, WS_G = WS_OV + 258 * MiB;
constexpr size_t WS_END = 978 * MiB;
static_assert(WS_U - WS_Q == WS_G - WS_U, "Q/U/G equally spaced");

struct Args { const float* in[33]; float* out; unsigned char* ws; int ph_lo, ph_hi; };
constexpr int TAB_OFF = 143360;
__device__ __forceinline__ unsigned long long tab_ld(const LAS unsigned long long* tab, int i) {
    const unsigned long long v = tab[i]; const unsigned lo = __builtin_amdgcn_readfirstlane((unsigned)v), hi = __builtin_amdgcn_readfirstlane((unsigned)(v >> 32));
    return ((unsigned long long)hi << 32) | lo; }
struct LArgs { const LAS unsigned long long* tab; float* out; unsigned char* ws;
    __device__ __forceinline__ const float* in(int i) const { return (const float*)(const __attribute__((address_space(1))) float*)tab_ld(tab, i); } };
enum { I_X = 0, I_C, I_CTX, I_CCTX, I_ADAW, I_ADAB, I_NORM1, I_NORM2, I_FG, I_FU, I_FD, I_EWIN, I_EWOUT, I_ELAM, I_ESUBLN, I_ESNG, I_ESNB, I_ESW, I_ESB,
       I_OWIN, I_OCW, I_OCB, I_FW1, I_FB1, I_FW2, I_FB2, I_FW3, I_FB3, I_FFREQ, I_FW4, I_FBIAS, I_OWOUT, I_FNORM };

template <int O> __device__ __forceinline__ float swz_xor(float v) { return __builtin_bit_cast(float, __builtin_amdgcn_ds_swizzle(__builtin_bit_cast(int, v), (O << 10) | 0x1f)); }
__device__ __forceinline__ float xor32_get(float v, int xaddr) { return __builtin_bit_cast(float, __builtin_amdgcn_ds_bpermute(xaddr, __builtin_bit_cast(int, v))); }
__device__ __forceinline__ float wave_sum(float v) {
    v += swz_xor<1>(v); v += swz_xor<2>(v); v += swz_xor<4>(v); v += swz_xor<8>(v); v += swz_xor<16>(v);
    return __builtin_bit_cast(float, __builtin_amdgcn_readlane(__builtin_bit_cast(int, v), 0)) + __builtin_bit_cast(float, __builtin_amdgcn_readlane(__builtin_bit_cast(int, v), 32));
}
__device__ __forceinline__ unsigned f2bf(float f) { unsigned u = __builtin_bit_cast(unsigned, f); return (u + 0x7fffu + ((u >> 16) & 1u)) >> 16; }
__device__ __forceinline__ unsigned pk2(float lo, float hi) { return f2bf(lo) | (f2bf(hi) << 16); }
__device__ __forceinline__ float bf2f(unsigned h) { return __builtin_bit_cast(float, h << 16); }
__device__ __forceinline__ f32x2 cmul(f32x2 a, f32x2 b) { const f32x2 ar = {-a.y, a.x}; return ar * b.y + a * b.x; }

__device__ __forceinline__ void transpose_item(const float* W, int K, int N, bf16* WT, int dst_row0, LAS float* scr, int k0, int n0, int lane) {
#pragma unroll 8
    for (int i = 0; i < 32; ++i) { const int kk = 2 * i + (lane >> 5); scr[kk * 33 + (lane & 31)] = W[(size_t)(k0 + kk) * N + n0 + (lane & 31)]; }
    asm volatile("s_waitcnt vmcnt(0) lgkmcnt(0)" ::: "memory");
    const int c = lane & 7;
#pragma unroll
    for (int j = 0; j < 4; ++j) { const int n = (lane >> 3) + 8 * j; const LAS float* s = scr + (8 * c) * 33 + n;
        u32x4 o; o.x = pk2(s[0 * 33], s[1 * 33]); o.y = pk2(s[2 * 33], s[3 * 33]); o.z = pk2(s[4 * 33], s[5 * 33]); o.w = pk2(s[6 * 33], s[7 * 33]);
        *(u32x4*)(WT + (size_t)(dst_row0 + n) * K + k0 + 8 * c) = o; }
    asm volatile("s_waitcnt lgkmcnt(0)" ::: "memory");
}
template <int MAP> __device__ __forceinline__ void transpose_matrix(const float* W, int K, int N, bf16* WT, LAS float* scr, int gw, int NGW, int lane) {
    const int nblk = N / 32, nitems = (K / 64) * nblk;
    for (int it = gw; it < nitems; it += NGW) {
        const int kb = it / nblk, nb = it % nblk, n0 = nb * 32; int d = n0;
        if (MAP == 1) d = n0 < 1024 ? n0 + 2048 : (n0 < 3072 ? n0 - 1024 : n0);
        if (MAP == 2) d = 256 * (n0 >> 7) + (n0 & 127);
        if (MAP == 3) d = 256 * (n0 >> 7) + 128 + (n0 & 127);
        transpose_item(W, K, N, WT, d, scr, kb * 64, n0, lane);
    }
}
__device__ __forceinline__ void p0_prologue(const LArgs& a, LAS unsigned char* lds) {
    const int tid = opaque_tid(), lane = tid & 63, wid = tid >> 6;
    const int gw = blockIdx.x * NWAVES + wid, NGW = gridDim.x * NWAVES;
    unsigned char* ws = a.ws;
    LAS float* scr = (LAS float*)(lds + wid * 16384);
    {
        float* mods = (float*)(ws + WS_MODS);
        for (int it = gw; it < 3072; it += NGW) {
            const int layer = it / 1536, r = it % 1536, cc = r >> 3, kc = r & 7, col = cc * 64 + lane;
            const float* w = a.in(I_ADAW) + (size_t)layer * 2048 * 12288 + (size_t)(kc * 256) * 12288 + col;
            const float* c0 = a.in(I_C) + kc * 256; const float* c1 = c0 + 2048; const float* c2 = a.in(I_CCTX) + kc * 256;
            float a0 = 0.f, a1 = 0.f, a2 = 0.f;
#pragma unroll 8
            for (int k = 0; k < 256; ++k) { const float wv = w[(size_t)k * 12288]; a0 += pg8::silu_f(c0[k]) * wv; a1 += pg8::silu_f(c1[k]) * wv; a2 += pg8::silu_f(c2[k]) * wv; }
            if (kc == 0) { const float bb = a.in(I_ADAB)[layer * 12288 + col]; a0 += bb; a1 += bb; a2 += bb; }
            float* m = mods + (size_t)layer * 3 * 12288 + col;
            atomicAdd(m, a0); atomicAdd(m + 12288, a1); atomicAdd(m + 2 * 12288, a2);
        }
    }
    transpose_matrix<1>(a.in(I_EWIN), 2048, EVEN_IN, (bf16*)(ws + WS_WIN), scr, gw, NGW, lane);
    transpose_matrix<0>(a.in(I_EWOUT), 2048, 2048, (bf16*)(ws + WS_WOUT0), scr, gw, NGW, lane);
    transpose_matrix<0>(a.in(I_OWIN), 2048, HY_IN, (bf16*)(ws + WS_OIN), scr, gw, NGW, lane);
    transpose_matrix<0>(a.in(I_OWOUT), 2048, 2048, (bf16*)(ws + WS_OOUT), scr, gw, NGW, lane);
    for (int l = 0; l < 2; ++l) {
        bf16* gu = (bf16*)(ws + (l ? WS_WGU1 : WS_WGU0)); bf16* dn = (bf16*)(ws + (l ? WS_WD1 : WS_WD0));
        transpose_matrix<2>(a.in(I_FG) + (size_t)l * 2048 * DFF, 2048, DFF, gu, scr, gw, NGW, lane);
        transpose_matrix<3>(a.in(I_FU) + (size_t)l * 2048 * DFF, 2048, DFF, gu, scr, gw, NGW, lane);
        transpose_matrix<0>(a.in(I_FD) + (size_t)l * 2048 * DFF, DFF, 2048, dn, scr, gw, NGW, lane);
    }
    {
        bf16* W4X = (bf16*)(ws + WS_W4X); const float* w4 = a.in(I_FW4);
        for (int e = blockIdx.x * NTHR + tid; e < 64 * 8192; e += gridDim.x * NTHR) {
            const int k = e >> 13, col = e & 8191; const float w = w4[e]; const unsigned hi = f2bf(w); const unsigned lo = f2bf(w - bf2f(hi));
            bf16* o = W4X + (size_t)col * 256 + k; o[0] = (bf16)hi; o[64] = (bf16)hi; o[128] = (bf16)lo; o[192] = (bf16)lo;
        }
    }
    {
        bf16* H3X = (bf16*)(ws + WS_H3X);
        const float* w1 = a.in(I_FW1); const float* w2 = a.in(I_FW2); const float* w3 = a.in(I_FW3);
        const float b1 = a.in(I_FB1)[lane], b2 = a.in(I_FB2)[lane], b3 = a.in(I_FB3)[lane];
        const float fr0 = a.in(I_FFREQ)[lane] * 0.15915494309189535f, fr1 = a.in(I_FFREQ)[64 + lane] * 0.15915494309189535f, fr2 = a.in(I_FFREQ)[128 + lane] * 0.15915494309189535f;
        float w1c[33], w2c[64], w3c[64];
#pragma unroll
        for (int f = 0; f < 33; ++f) w1c[f] = w1[f * 64 + lane];
#pragma unroll
        for (int k = 0; k < 64; ++k) { w2c[k] = w2[k * 64 + lane]; w3c[k] = w3[k * 64 + lane]; }
        for (int pos = gw; pos < SEQ; pos += NGW) {
            float feat = 0.f;
            { const int bidx = (lane >= 17) ? lane - 17 : lane - 1; const float fb = 1e-4f + (float)(bidx < 0 ? 0 : bidx) * ((15.f - 1e-4f) / 15.f);
              double rv = (double)fb * (double)pos * (1.0 / 16384.0); rv -= __builtin_floor(rv); const float rf = (float)rv;
              if (lane == 0) feat = (float)pos * (1.f / 16383.f); else if (lane <= 16) feat = __builtin_amdgcn_cosf(rf); else if (lane <= 32) feat = -__builtin_amdgcn_sinf(rf); }
            float acc = b1;
#pragma unroll
            for (int f = 0; f < 33; ++f) acc += __builtin_bit_cast(float, __builtin_amdgcn_readlane(__builtin_bit_cast(int, feat), f)) * w1c[f];
            float h = __builtin_amdgcn_sinf(__builtin_amdgcn_fractf(fr0 * acc));
            acc = b2;
#pragma unroll
            for (int k = 0; k < 64; ++k) acc += __builtin_bit_cast(float, __builtin_amdgcn_readlane(__builtin_bit_cast(int, h), k)) * w2c[k];
            h = __builtin_amdgcn_sinf(__builtin_amdgcn_fractf(fr1 * acc));
            acc = b3;
#pragma unroll
            for (int k = 0; k < 64; ++k) acc += __builtin_bit_cast(float, __builtin_amdgcn_readlane(__builtin_bit_cast(int, h), k)) * w3c[k];
            h = __builtin_amdgcn_sinf(__builtin_amdgcn_fractf(fr2 * acc));
            const unsigned hi = f2bf(h), lo = f2bf(h - bf2f(hi));
            bf16* o = H3X + (size_t)pos * 256 + lane; o[0] = (bf16)hi; o[64] = (bf16)lo; o[128] = (bf16)hi; o[192] = (bf16)lo;
        }
    }
}

template <int SRC> __device__ __forceinline__ void prenorm_rows(const LArgs& a, int nrows, const float* nw, const float* mods_layer, int shift_part, bf16* dst) {
    const int tid = opaque_tid(), lane = tid & 63, wid = tid >> 6, gw = blockIdx.x * NWAVES + wid, NGW = gridDim.x * NWAVES;
    for (int chunk = gw; chunk < nrows / 16; chunk += NGW) {
        const int row0 = chunk * 16; const float* src0; int cond;
        if (SRC == 0) { if (row0 < MCTX) { src0 = a.in(I_CTX) + (size_t)row0 * DM; cond = 2; } else { src0 = a.in(I_X) + (size_t)(row0 - MCTX) * DM; cond = (row0 - MCTX) >> 14; } }
        else { src0 = (const float*)(a.ws + WS_X) + (size_t)row0 * DM; cond = row0 >> 14; }
        const float* sh = mods_layer + (size_t)cond * 12288 + shift_part * 2048; const float* sc = sh + 2048;
        f32x4 cs[8], sv[8];
#pragma unroll
        for (int j = 0; j < 8; ++j) { const int col = 4 * lane + 256 * j; cs[j] = *(const f32x4*)(nw + col) * (*(const f32x4*)(sc + col) + 1.f); sv[j] = *(const f32x4*)(sh + col); }
#pragma unroll 2
        for (int r = 0; r < 16; ++r) {
            const float* src = src0 + (size_t)r * DM; f32x4 v[8]; float ss = 0.f;
#pragma unroll
            for (int j = 0; j < 8; ++j) { v[j] = *(const f32x4*)(src + 4 * lane + 256 * j); ss += (v[j].x * v[j].x + v[j].y * v[j].y) + (v[j].z * v[j].z + v[j].w * v[j].w); }
            const float rn = 1.f / sqrtf(wave_sum(ss) * (1.f / DM) + 1e-6f);
#pragma unroll
            for (int j = 0; j < 8; ++j) { const int col = 4 * lane + 256 * j; const f32x4 o = v[j] * rn * cs[j] + sv[j]; u32x2 pq; pq.x = pk2(o.x, o.y); pq.y = pk2(o.z, o.w); *(u32x2*)(dst + (size_t)(row0 + r) * DM + col) = pq; }
        }
    }
}
__device__ __forceinline__ void final_norm_rows(const LArgs& a) {
    const int tid = opaque_tid(), lane = tid & 63, wid = tid >> 6, gw = blockIdx.x * NWAVES + wid, NGW = gridDim.x * NWAVES;
    const float* nw = a.in(I_FNORM);
    f32x4 cs[8];
#pragma unroll
    for (int j = 0; j < 8; ++j) cs[j] = *(const f32x4*)(nw + 4 * lane + 256 * j);
    for (int chunk = gw; chunk < MLAT / 16; chunk += NGW) {
#pragma unroll 2
        for (int r = 0; r < 16; ++r) {
            const int row = chunk * 16 + r; const float* src = (const float*)(a.ws + WS_X) + (size_t)row * DM; f32x4 v[8]; float ss = 0.f;
#pragma unroll
            for (int j = 0; j < 8; ++j) { v[j] = *(const f32x4*)(src + 4 * lane + 256 * j); ss += (v[j].x * v[j].x + v[j].y * v[j].y) + (v[j].z * v[j].z + v[j].w * v[j].w); }
            const float rn = 1.f / sqrtf(wave_sum(ss) * (1.f / DM) + 1e-6f);
#pragma unroll
            for (int j = 0; j < 8; ++j) { const int col = 4 * lane + 256 * j; *(f32x4*)(a.out + (size_t)row * DM + col) = v[j] * rn * cs[j]; }
        }
    }
}

__device__ __forceinline__ void attn_phase(const LArgs& a, LAS unsigned char* lds) {
    const int tid = opaque_tid(), lane = tid & 63, wid = tid >> 6, pr = wid >> 1, mp = wid & 1, r32 = lane & 31, hi = lane >> 5;
    const bf16* Qg = (const bf16*)(a.ws + WS_Q); const bf16* Kg = (const bf16*)(a.ws + WS_K); const bf16* Vt = (const bf16*)(a.ws + WS_VT);
    bf16* act = (bf16*)(a.ws + WS_H);
    float lam;
    { const float* lp = a.in(I_ELAM); const float v = wave_sum(lp[lane] * lp[64 + lane]), w = wave_sum(lp[128 + lane] * lp[192 + lane]); lam = __expf(v) - __expf(w) + 0.2f; }
    constexpr int KROW = 272, VROW = 144, KBUF = 64 * KROW, VBUF = 128 * VROW, NT = 260;
    const int xaddr = (lane ^ 32) << 2;
    const int kappa = (r32 & 16) | ((r32 & 4) << 1) | ((r32 & 8) >> 1) | (r32 & 3);
    const int krow_t = tid >> 4, kch = tid & 15, vrow_t = tid >> 3, vch = tid & 7;
    const float* subln = a.in(I_ESUBLN);
    for (int u = blockIdx.x; u < 2048; u += gridDim.x) {
        const int bh = u >> 7, qb = u & 127, b = bh >> 3, h = bh & 7;
        const bf16* Qp = Qg + (size_t)(b * SEQ + qb * 128 + pr * 32 + r32) * 1024 + h * 128 + mp * 64 + hi * 8;
        bf16x8 qf[4];
#pragma unroll
        for (int ks = 0; ks < 4; ++ks) qf[ks] = *(const bf16x8*)(Qp + ks * 16);
        f32x16 o[4];
#pragma unroll
        for (int d = 0; d < 4; ++d)
#pragma unroll
            for (int r = 0; r < 16; ++r) o[d][r] = 0.f;
        float mrun = -1e30f, lrun = 0.f;
        const bf16* kgp = Kg + (size_t)krow_t * 1024 + h * 128 + kch * 8;
        const bf16* vgp = Vt + (size_t)(h * 128 + vrow_t) * MALL + vch * 8;
        u32x4 kreg[2], vreg[2];
#define ATT_LOAD(j) do { const int kb0_ = (j) < 4 ? b * NCTX + (j) * 64 : MCTX + b * SEQ + ((j) - 4) * 64; \
            kreg[0] = *(const u32x4*)(kgp + (size_t)kb0_ * 1024); kreg[1] = *(const u32x4*)(kgp + (size_t)(kb0_ + 32) * 1024); \
            vreg[0] = *(const u32x4*)(vgp + kb0_); vreg[1] = *(const u32x4*)(vgp + (size_t)64 * MALL + kb0_); } while (0)
#define ATT_STORE(kbuf, vbuf) do { LAS unsigned char* kb_ = lds + (kbuf) * KBUF; LAS unsigned char* vb_ = lds + 2 * KBUF + (vbuf) * VBUF; \
            *(LAS u32x4*)(kb_ + krow_t * KROW + kch * 16) = kreg[0]; *(LAS u32x4*)(kb_ + (krow_t + 32) * KROW + kch * 16) = kreg[1]; \
            *(LAS u32x4*)(vb_ + vrow_t * VROW + vch * 16) = vreg[0]; *(LAS u32x4*)(vb_ + (vrow_t + 64) * VROW + vch * 16) = vreg[1]; } while (0)
#define ATT_VRD(DST, vb_, kstep) do { _Pragma("unroll") for (int d = 0; d < 4; ++d) DST[d] = *(const LAS bf16x8*)((vb_) + (32 * d + r32) * VROW + (kstep) * 32 + hi * 16); } while (0)
#define ATT_VMM(SRC, kstep) do { const bf16x8 pf = __builtin_bit_cast(bf16x8, pw[kstep]); _Pragma("unroll") for (int d = 0; d < 4; ++d) o[d] = __builtin_amdgcn_mfma_f32_32x32x16_bf16(SRC[d], pf, o[d], 0, 0, 0); } while (0)
#define ATT_PV_PRE(vbuf) do { const LAS unsigned char* vb_ = lds + 2 * KBUF + (vbuf) * VBUF; ATT_VRD(vfa, vb_, 0); __builtin_amdgcn_sched_barrier(0); } while (0)
#define ATT_PV(vbuf, PRE) do { const LAS unsigned char* vb_ = lds + 2 * KBUF + (vbuf) * VBUF; \
            if (!(PRE)) ATT_VRD(vfa, vb_, 0); \
            ATT_VRD(vfb, vb_, 1); __builtin_amdgcn_sched_barrier(0); ATT_VMM(vfa, 0); __builtin_amdgcn_sched_barrier(0); \
            ATT_VRD(vfa, vb_, 2); __builtin_amdgcn_sched_barrier(0); ATT_VMM(vfb, 1); __builtin_amdgcn_sched_barrier(0); \
            ATT_VRD(vfb, vb_, 3); __builtin_amdgcn_sched_barrier(0); ATT_VMM(vfa, 2); __builtin_amdgcn_sched_barrier(0); \
            ATT_VMM(vfb, 3); } while (0)
        const bool late = wid >= 4;
        u32x4 pw[4]; bf16x8 vfa[4], vfb[4];
#pragma unroll
        for (int i = 0; i < 4; ++i) pw[i] = (u32x4){0u, 0u, 0u, 0u};
        ATT_LOAD(0); ATT_STORE(0, 0); __syncthreads();
        int vprev = 2, vcur = 0, vnext = 1;
        for (int j = 0; j < NT; ++j) {
            const int cur = j & 1;
            if (j + 1 < NT) ATT_LOAD(j + 1);
            if (late && j > 0) ATT_PV(vprev, 0);
            const LAS unsigned char* kb_ = lds + cur * KBUF;
            f32x16 s[2];
#pragma unroll
            for (int kb = 0; kb < 2; ++kb) {
#pragma unroll
                for (int r = 0; r < 16; ++r) s[kb][r] = 0.f;
#pragma unroll
                for (int ks = 0; ks < 4; ++ks) { const bf16x8 kf = *(const LAS bf16x8*)(kb_ + (32 * kb + kappa) * KROW + mp * 128 + ks * 32 + hi * 16);
                    s[kb] = __builtin_amdgcn_mfma_f32_32x32x16_bf16(kf, qf[ks], s[kb], 0, 0, 0); }
            }
            if (!late) ATT_PV_PRE(vcur);
            float mx = s[0][0];
#pragma unroll
            for (int r = 1; r < 16; ++r) mx = fmaxf(mx, s[0][r]);
#pragma unroll
            for (int r = 0; r < 16; ++r) mx = fmaxf(mx, s[1][r]);
            mx = fmaxf(mx, xor32_get(mx, xaddr));
            const float mnew = fmaxf(mrun, mx);
            if (__any(mnew > mrun)) {
                const float alpha = __builtin_amdgcn_exp2f(mrun - mnew); lrun *= alpha;
#pragma unroll
                for (int d = 0; d < 4; ++d)
#pragma unroll
                    for (int r = 0; r < 16; ++r) o[d][r] *= alpha;
                mrun = mnew;
            }
            float psum = 0.f;
#pragma unroll
            for (int kb = 0; kb < 2; ++kb)
#pragma unroll
                for (int r = 0; r < 16; ++r) { const float pv = __builtin_amdgcn_exp2f(s[kb][r] - mrun); s[kb][r] = pv; psum += pv; }
            lrun += psum;
#pragma unroll
            for (int kb = 0; kb < 2; ++kb)
#pragma unroll
                for (int g = 0; g < 2; ++g) {
                    u32x4 w4; w4.x = pg8::cvt_pk_bf16(s[kb][8 * g + 0], s[kb][8 * g + 1]); w4.y = pg8::cvt_pk_bf16(s[kb][8 * g + 2], s[kb][8 * g + 3]);
                    w4.z = pg8::cvt_pk_bf16(s[kb][8 * g + 4], s[kb][8 * g + 5]); w4.w = pg8::cvt_pk_bf16(s[kb][8 * g + 6], s[kb][8 * g + 7]);
                    pw[2 * kb + g] = w4;
                }
            if (!late) ATT_PV(vcur, 1);
            if (j + 1 < NT) ATT_STORE(cur ^ 1, vnext);
            __syncthreads();
            { const int t_ = vprev; vprev = vcur; vcur = vnext; vnext = t_; }
        }
        if (late) ATT_PV(vprev, 0);
        __syncthreads();
#undef ATT_LOAD
#undef ATT_STORE
#undef ATT_PV
#undef ATT_PV_PRE
#undef ATT_VRD
#undef ATT_VMM
        const float ltot = lrun + xor32_get(lrun, xaddr); const float inv = 1.f / ltot;
        LAS float* xch = (LAS float*)lds + pr * 4096;
        if (mp == 1) { const float f = inv * lam;
#pragma unroll
            for (int d = 0; d < 4; ++d)
#pragma unroll
                for (int r = 0; r < 16; ++r) xch[(d * 16 + r) * 64 + lane] = o[d][r] * f; }
        __syncthreads();
        if (mp == 0) {
            float ss = 0.f;
#pragma unroll
            for (int d = 0; d < 4; ++d)
#pragma unroll
                for (int r = 0; r < 16; ++r) { const float dv = o[d][r] * inv - xch[(d * 16 + r) * 64 + lane]; o[d][r] = dv; ss += dv * dv; }
            ss += xor32_get(ss, xaddr);
            const float rn = (1.f / sqrtf(ss * (1.f / 128.f) + 1e-5f)) * 0.8f;
            bf16* orow = act + (size_t)(b * SEQ + qb * 128 + pr * 32 + r32) * DM + h * 128;
#pragma unroll
            for (int d = 0; d < 4; ++d)
#pragma unroll
                for (int j4 = 0; j4 < 4; ++j4) { const int dv0 = 32 * d + 8 * j4 + 4 * hi; const f32x4 g = *(const f32x4*)(subln + dv0);
                    u32x2 w; w.x = pk2(o[d][4 * j4 + 0] * rn * g.x, o[d][4 * j4 + 1] * rn * g.y); w.y = pk2(o[d][4 * j4 + 2] * rn * g.z, o[d][4 * j4 + 3] * rn * g.w);
                    *(u32x2*)(orow + dv0) = w; }
        }
        __syncthreads();
    }
}

__device__ __forceinline__ void sgu_phase(const LArgs& a, LAS unsigned char* lds) {
    const int tid = opaque_tid(), lane = tid & 63, wid = tid >> 6, r32 = lane & 31, hi = lane >> 5;
    constexpr int ROWB = 272;
    LAS unsigned char* WsB = lds; LAS unsigned char* VVt = lds + 128 * ROWB;
    const bf16* Ug = (const bf16*)(a.ws + WS_U); const bf16* Gg = (const bf16*)(a.ws + WS_G); bf16* act = (bf16*)(a.ws + WS_H);
    for (int u = blockIdx.x; u < 2048; u += gridDim.x) {
        const int g = u & 7, row0 = (u >> 3) * 128;
        const f32x4* wsrc = (const f32x4*)(a.in(I_ESW) + (size_t)g * 16384);
#pragma unroll
        for (int i = 0; i < 8; ++i) { const int idx = tid + NTHR * i; const f32x4 w = wsrc[idx]; const int pr_ = idx >> 5, q4 = (idx & 31) * 4;
            u32x2 pk; pk.x = pk2(w.x, w.y); pk.y = pk2(w.z, w.w); *(LAS u32x2*)(WsB + pr_ * ROWB + q4 * 2) = pk; }
        const float ng0 = a.in(I_ESNG)[g * 128 + 2 * lane], ng1 = a.in(I_ESNG)[g * 128 + 2 * lane + 1], nb0 = a.in(I_ESNB)[g * 128 + 2 * lane], nb1 = a.in(I_ESNB)[g * 128 + 2 * lane + 1];
#pragma unroll
        for (int rr = 0; rr < 16; ++rr) {
            const int r = wid * 16 + rr; const unsigned pk = *(const unsigned*)(Gg + (size_t)(row0 + r) * 1024 + g * 128 + 2 * lane);
            const float x0 = bf2f(pk & 0xffffu), x1 = bf2f(pk >> 16);
            const float mean = wave_sum(x0 + x1) * (1.f / 128.f); const float d0 = x0 - mean, d1 = x1 - mean;
            const float rstd = 1.f / sqrtf(wave_sum(d0 * d0 + d1 * d1) * (1.f / 128.f) + 1e-5f);
            *(LAS bf16*)(VVt + (2 * lane) * ROWB + r * 2) = (bf16)f2bf(d0 * rstd * ng0 + nb0); *(LAS bf16*)(VVt + (2 * lane + 1) * ROWB + r * 2) = (bf16)f2bf(d1 * rstd * ng1 + nb1);
        }
        __syncthreads();
        const int cblk = wid >> 1;
        f32x16 acc[2];
#pragma unroll
        for (int i = 0; i < 2; ++i)
#pragma unroll
            for (int r = 0; r < 16; ++r) acc[i][r] = 0.f;
#pragma unroll
        for (int ks = 0; ks < 8; ++ks) {
            const bf16x8 af = *(const LAS bf16x8*)(VVt + (32 * cblk + r32) * ROWB + ks * 32 + hi * 16);
#pragma unroll
            for (int i = 0; i < 2; ++i) { const int pblk = (wid & 1) * 2 + i; const bf16x8 bfr = *(const LAS bf16x8*)(WsB + (32 * pblk + r32) * ROWB + ks * 32 + hi * 16);
                acc[i] = __builtin_amdgcn_mfma_f32_32x32x16_bf16(af, bfr, acc[i], 0, 0, 0); }
        }
#pragma unroll
        for (int i = 0; i < 2; ++i) {
            const int p = 32 * ((wid & 1) * 2 + i) + r32; const float bs = a.in(I_ESB)[g * 128 + p];
            const bf16* up = Ug + (size_t)(row0 + p) * 1024 + g * 128 + 32 * cblk + 4 * hi; bf16* op = act + (size_t)(row0 + p) * DM + 1024 + g * 128 + 32 * cblk + 4 * hi;
#pragma unroll
            for (int j4 = 0; j4 < 4; ++j4) {
                const u32x2 uu = *(const u32x2*)(up + 8 * j4);
                const f32x4 mix = {acc[i][4 * j4 + 0] + bs, acc[i][4 * j4 + 1] + bs, acc[i][4 * j4 + 2] + bs, acc[i][4 * j4 + 3] + bs};
                const f32x4 o = (f32x4){bf2f(uu.x & 0xffffu), bf2f(uu.x >> 16), bf2f(uu.y & 0xffffu), bf2f(uu.y >> 16)} * mix;
                u32x2 w; w.x = pk2(o.x, o.y); w.y = pk2(o.z, o.w); *(u32x2*)(op + 8 * j4) = w;
            }
        }
        __syncthreads();
    }
}

__device__ __forceinline__ void bfly_fwd(f32x2& x0, f32x2& x1, f32x2& x2, f32x2& x3, const f32x2 w1) {
    const f32x2 w2 = cmul(w1, w1);
    const f32x2 y0 = x0 + x2, y1 = x1 + x3, y2 = cmul(x0 - x2, w1), t = cmul(x1 - x3, w1); const f32x2 y3 = {t.y, -t.x};
    x0 = y0 + y1; x1 = cmul(y0 - y1, w2); x2 = y2 + y3; x3 = cmul(y2 - y3, w2);
}
__device__ __forceinline__ void bfly_inv(f32x2& x0, f32x2& x1, f32x2& x2, f32x2& x3, const f32x2 w2) {
    const f32x2 w = cmul(w2, w2);
    const f32x2 t1 = cmul(x1, w), t3 = cmul(x3, w);
    const f32x2 y0 = x0 + t1, y1 = x0 - t1, y2 = x2 + t3, y3 = x2 - t3;
    const f32x2 u2 = cmul(y2, w2), u3 = cmul(y3, w2); const f32x2 u3i = {-u3.y, u3.x};
    x0 = y0 + u2; x1 = y1 + u3i; x2 = y0 - u2; x3 = y1 - u3i;
}
__device__ __forceinline__ void fft_fwd(LAS f32x2* X, int tid) {
    const f32x2 R1 = {0.92387953251128674f, -0.38268343236508977f}, R2 = {0.70710678118654752f, -0.70710678118654752f}, R3 = {0.38268343236508977f, -0.92387953251128674f};
    for (int lgb = 10; lgb >= 2; lgb -= 4) {
        const int h = 1 << lgb; const float inv16h = 1.f / (float)(16 * h);
#pragma unroll 2
        for (int G = tid; G < 1024; G += NTHR) {
            const int j = G & (h - 1), base = ((G >> lgb) << (lgb + 4)) + j;
            f32x2 x[4][4];
#pragma unroll
            for (int a = 0; a < 4; ++a)
#pragma unroll
                for (int bb = 0; bb < 4; ++bb) x[a][bb] = X[base + a * 4 * h + bb * h];
            const float rev = (float)j * inv16h; const f32x2 wb = {__builtin_amdgcn_cosf(rev), -__builtin_amdgcn_sinf(rev)};
            bfly_fwd(x[0][0], x[1][0], x[2][0], x[3][0], wb);
            bfly_fwd(x[0][1], x[1][1], x[2][1], x[3][1], cmul(wb, R1));
            bfly_fwd(x[0][2], x[1][2], x[2][2], x[3][2], cmul(wb, R2));
            bfly_fwd(x[0][3], x[1][3], x[2][3], x[3][3], cmul(wb, R3));
            const f32x2 wb2 = cmul(wb, wb), wl = cmul(wb2, wb2);
#pragma unroll
            for (int a = 0; a < 4; ++a) bfly_fwd(x[a][0], x[a][1], x[a][2], x[a][3], wl);
#pragma unroll
            for (int a = 0; a < 4; ++a)
#pragma unroll
                for (int bb = 0; bb < 4; ++bb) X[base + a * 4 * h + bb * h] = x[a][bb];
        }
        __syncthreads();
    }
#pragma unroll 4
    for (int q = tid; q < 4096; q += NTHR) {
        const int i0 = 4 * q; f32x2 x0 = X[i0], x1 = X[i0 + 1], x2 = X[i0 + 2], x3 = X[i0 + 3];
        bfly_fwd(x0, x1, x2, x3, (f32x2){1.f, 0.f});
        X[i0] = x0; X[i0 + 1] = x1; X[i0 + 2] = x2; X[i0 + 3] = x3;
    }
    __syncthreads();
}
__device__ __forceinline__ void fft_inv(LAS f32x2* X, int tid) {
    const f32x2 R1 = {0.92387953251128674f, 0.38268343236508977f}, R2 = {0.70710678118654752f, 0.70710678118654752f}, R3 = {0.38268343236508977f, 0.92387953251128674f};
    for (int lga = 0; lga <= 8; lga += 4) {
        const int h = 1 << lga; const float inv16h = 1.f / (float)(16 * h);
#pragma unroll 2
        for (int G = tid; G < 1024; G += NTHR) {
            const int j = G & (h - 1), base = ((G >> lga) << (lga + 4)) + j;
            f32x2 x[4][4];
#pragma unroll
            for (int a = 0; a < 4; ++a)
#pragma unroll
                for (int bb = 0; bb < 4; ++bb) x[a][bb] = X[base + a * 4 * h + bb * h];
            const float rev = (float)j * inv16h; const f32x2 wb = {__builtin_amdgcn_cosf(rev), __builtin_amdgcn_sinf(rev)};
            const f32x2 wb2 = cmul(wb, wb), wl = cmul(wb2, wb2);
#pragma unroll
            for (int a = 0; a < 4; ++a) bfly_inv(x[a][0], x[a][1], x[a][2], x[a][3], wl);
            bfly_inv(x[0][0], x[1][0], x[2][0], x[3][0], wb);
            bfly_inv(x[0][1], x[1][1], x[2][1], x[3][1], cmul(wb, R1));
            bfly_inv(x[0][2], x[1][2], x[2][2], x[3][2], cmul(wb, R2));
            bfly_inv(x[0][3], x[1][3], x[2][3], x[3][3], cmul(wb, R3));
#pragma unroll
            for (int a = 0; a < 4; ++a)
#pragma unroll
                for (int bb = 0; bb < 4; ++bb) X[base + a * 4 * h + bb * h] = x[a][bb];
        }
        __syncthreads();
    }
#pragma unroll 4
    for (int q = tid; q < 4096; q += NTHR) {
        f32x2 x0 = X[q], x1 = X[q + 4096], x2 = X[q + 8192], x3 = X[q + 12288];
        const float rev = (float)q * (1.f / 16384.f);
        bfly_inv(x0, x1, x2, x3, (f32x2){__builtin_amdgcn_cosf(rev), __builtin_amdgcn_sinf(rev)});
        X[q] = x0; X[q + 4096] = x1; X[q + 8192] = x2; X[q + 12288] = x3;
    }
    __syncthreads();
}
__device__ __forceinline__ void pointwise_filter(const LAS f32x2* X, f32x4* Hs, float scale, int tid) {
#pragma unroll 2
    for (int s = tid; s < 8192; s += NTHR) {
        if (s == 0) { const f32x2 A = X[0], Cm = X[1]; Hs[0] = (f32x4){(A.x + A.y) * scale, (A.x - A.y) * scale, Cm.x * scale, -Cm.y * scale}; }
        else {
            const int i1 = 2 * s, i2 = i1 ^ ((1 << (31 - __clz(i1))) - 1); const int p = (int)(__brev((unsigned)i1) >> 18);
            const f32x2 A = X[i1], B = X[i2];
            const f32x2 E = {0.5f * (A.x + B.x), 0.5f * (A.y - B.y)}; const f32x2 Dm = {A.x - B.x, A.y + B.y}; const f32x2 O = {0.5f * Dm.y, -0.5f * Dm.x};
            const float rev = (float)p * (1.f / 32768.f); const float c = __builtin_amdgcn_cosf(rev), sn = __builtin_amdgcn_sinf(rev);
            const f32x2 WO = cmul((f32x2){c, -sn}, O);
            Hs[s] = (f32x4){(E.x + WO.x) * scale, (E.y + WO.y) * scale, (E.x - WO.x) * scale, -(E.y - WO.y) * scale};
        }
    }
    __syncthreads();
}
__device__ __forceinline__ void pointwise_data(LAS f32x2* X, const f32x4* Hs, int tid) {
#pragma unroll 4
    for (int s = tid; s < 8192; s += NTHR) {
        const f32x4 hh = Hs[s];
        if (s == 0) {
            const f32x2 A = X[0]; const float Y0 = (A.x + A.y) * hh.x, YM = (A.x - A.y) * hh.y; X[0] = (f32x2){0.5f * (Y0 + YM), 0.5f * (Y0 - YM)};
            const f32x2 Cm = X[1]; const f32x2 Y = cmul((f32x2){Cm.x, -Cm.y}, (f32x2){hh.z, hh.w}); X[1] = (f32x2){Y.x, -Y.y};
        } else {
            const int i1 = 2 * s, i2 = i1 ^ ((1 << (31 - __clz(i1))) - 1); const int p = (int)(__brev((unsigned)i1) >> 18);
            const f32x2 A = X[i1], B = X[i2];
            const f32x2 E = {0.5f * (A.x + B.x), 0.5f * (A.y - B.y)}; const f32x2 Dm = {A.x - B.x, A.y + B.y}; const f32x2 O = {0.5f * Dm.y, -0.5f * Dm.x};
            const float rev = (float)p * (1.f / 32768.f); const float c = __builtin_amdgcn_cosf(rev), sn = __builtin_amdgcn_sinf(rev);
            const f32x2 WO = cmul((f32x2){c, -sn}, O);
            const f32x2 Xk = E + WO; const f32x2 Xk2 = {E.x - WO.x, -(E.y - WO.y)};
            const f32x2 Yk = cmul(Xk, (f32x2){hh.x, hh.y}), Yk2 = cmul(Xk2, (f32x2){hh.z, hh.w});
            const f32x2 Ye = {0.5f * (Yk.x + Yk2.x), 0.5f * (Yk.y - Yk2.y)}; const f32x2 Dd = {Yk.x - Yk2.x, Yk.y + Yk2.y};
            const f32x2 Yo = cmul((f32x2){0.5f * c, 0.5f * sn}, Dd);
            X[i1] = (f32x2){Ye.x - Yo.y, Ye.y + Yo.x}; X[i2] = (f32x2){Ye.x + Yo.y, Yo.x - Ye.y};
        }
    }
    __syncthreads();
}
__device__ __forceinline__ void h8_to_f(const u32x4 raw, float* e) {
#pragma unroll
    for (int i = 0; i < 4; ++i) { const unsigned w = raw[i];
        e[2 * i] = (float)__builtin_bit_cast(_Float16, (unsigned short)(w & 0xffffu)); e[2 * i + 1] = (float)__builtin_bit_cast(_Float16, (unsigned short)(w >> 16)); }
}
struct Z10 { u32x4 raw; _Float16 zm, zp; };
__device__ __forceinline__ Z10 sconv8_load(const _Float16* z, int t0) {
    Z10 r; r.raw = *(const u32x4*)(z + t0); r.zm = z[t0 > 0 ? t0 - 1 : 0]; r.zp = z[t0 + 8 < SEQ ? t0 + 8 : SEQ - 1]; return r;
}
__device__ __forceinline__ void sconv8_calc(const Z10& r, int t0, float w0, float w1, float w2, float bias, float* y) {
    float e[10]; e[0] = t0 > 0 ? (float)r.zm : 0.f; e[9] = (t0 + 8 < SEQ) ? (float)r.zp : 0.f; h8_to_f(r.raw, e + 1);
#pragma unroll
    for (int i = 0; i < 8; ++i) y[i] = bias + w0 * e[i] + w1 * e[i + 1] + w2 * e[i + 2];
}
constexpr size_t HY_WG_BYTES = 262144 + 65536;
__device__ __forceinline__ void hyena_phase(const LArgs& a, LAS unsigned char* lds) {
    const int tid0 = opaque_tid(), lane = tid0 & 63, wid = tid0 >> 6;
    LAS f32x2* X = (LAS f32x2*)lds; LAS float* red = (LAS float*)(lds + 131072);
    const _Float16* ZT = (const _Float16*)(a.ws + WS_OV); const _Float16* KT = (const _Float16*)a.out;
    bf16* YT = (bf16*)(a.ws + WS_H);
    f32x4* Hs = (f32x4*)(a.ws + WS_HYSCR + (size_t)blockIdx.x * HY_WG_BYTES); f32x4* Ys = Hs + 16384;
    const float* cw = a.in(I_OCW); const float* cb = a.in(I_OCB);
    for (int c = blockIdx.x; c < 2048; c += gridDim.x) {
        int tid = tid0; asm volatile("" : "+v"(tid));
        const float dkc = -__builtin_fabsf(MIN_DECAY_F + (float)c * ((MAX_DECAY_F - MIN_DECAY_F) / 2047.f)) * (1.4426950408889634f / 16383.f);
        for (int n = 0; n < 2; ++n) {
            const _Float16* fw = KT + (size_t)(n * 4096 + c) * SEQ; const _Float16* bw = KT + (size_t)(n * 4096 + 2048 + c) * SEQ;
            float l1 = 0.f;
            u32x4 rf[4], rb[4]; _Float16 rt[4];
#pragma unroll
            for (int j = 0; j < 4; ++j) { const int mm0 = 4 * (tid + NTHR * j); rf[j] = *(const u32x4*)(fw + 2 * mm0); rb[j] = *(const u32x4*)(bw + 16376 - 2 * mm0); rt[j] = bw[mm0 > 0 ? 16384 - 2 * mm0 : 16383]; }
#pragma unroll
            for (int j = 0; j < 4; ++j) {
                const int mm0 = 4 * (tid + NTHR * j);
                float e[8], cc[8]; h8_to_f(rf[j], e); h8_to_f(rb[j], cc);
                float top = mm0 > 0 ? (float)rt[j] : 0.f;
                {
                    const float tf = (float)(2 * mm0), tb = (float)(16376 - 2 * mm0);
#pragma unroll
                    for (int i = 0; i < 8; ++i) { e[i] *= __builtin_amdgcn_exp2f(dkc * (tf + (float)i)); cc[i] *= __builtin_amdgcn_exp2f(dkc * (tb + (float)i)); }
                    top *= __builtin_amdgcn_exp2f(dkc * (tb + 8.f));
                }
#pragma unroll
                for (int i = 0; i < 8; ++i) l1 += __builtin_fabsf(e[i]);
#pragma unroll
                for (int i = 1; i < 8; ++i) l1 += __builtin_fabsf(cc[i]);
                l1 += __builtin_fabsf(top);
                *(LAS f32x4*)(X + mm0) = (f32x4){e[0], e[1], e[2], e[3]}; *(LAS f32x4*)(X + mm0 + 2) = (f32x4){e[4], e[5], e[6], e[7]};
                *(LAS f32x4*)(X + 8192 + mm0) = (f32x4){top, cc[7], cc[6], cc[5]}; *(LAS f32x4*)(X + 8192 + mm0 + 2) = (f32x4){cc[4], cc[3], cc[2], cc[1]};
            }
            l1 = wave_sum(l1); if (lane == 0) red[wid] = l1;
            __syncthreads();
            float tot = 0.f;
#pragma unroll
            for (int w = 0; w < NWAVES; ++w) tot += red[w];
            fft_fwd(X, tid);
            pointwise_filter(X, Hs + n * 8192, 1.f / (16384.f * tot), tid);
        }
        const float w00 = cw[c], w01 = cw[HY_IN + c], w02 = cw[2 * HY_IN + c], b0 = cb[c];
        const float w10 = cw[2048 + c], w11 = cw[HY_IN + 2048 + c], w12 = cw[2 * HY_IN + 2048 + c], b1 = cb[2048 + c];
        const float w20 = cw[4096 + c], w21 = cw[HY_IN + 4096 + c], w22 = cw[2 * HY_IN + 4096 + c], b2 = cb[4096 + c];
        const float fb0 = a.in(I_FBIAS)[c], fb1 = a.in(I_FBIAS)[2048 + c];
        for (int b = 0; b < NB; ++b) {
            const _Float16* zv = ZT + (size_t)c * MLAT + b * SEQ; const _Float16* zx1 = ZT + (size_t)(2048 + c) * MLAT + b * SEQ; const _Float16* zx2 = ZT + (size_t)(4096 + c) * MLAT + b * SEQ;
            {
                Z10 zr[4];
#pragma unroll
                for (int j = 0; j < 4; ++j) zr[j] = sconv8_load(zv, 8 * (tid + NTHR * j));
#pragma unroll
                for (int j = 0; j < 4; ++j) { const int mm0 = 4 * (tid + NTHR * j); float y[8]; sconv8_calc(zr[j], 2 * mm0, w00, w01, w02, b0, y);
                    *(LAS f32x4*)(X + mm0) = (f32x4){y[0], y[1], y[2], y[3]}; *(LAS f32x4*)(X + mm0 + 2) = (f32x4){y[4], y[5], y[6], y[7]};
                    *(LAS f32x4*)(X + 8192 + mm0) = (f32x4){0.f, 0.f, 0.f, 0.f}; *(LAS f32x4*)(X + 8192 + mm0 + 2) = (f32x4){0.f, 0.f, 0.f, 0.f}; }
            }
            __syncthreads();
            fft_fwd(X, tid); pointwise_data(X, Hs, tid); fft_inv(X, tid);
            Z10 za[4], zb[4];
#pragma unroll
            for (int j = 0; j < 4; ++j) { za[j] = sconv8_load(zv, 8 * (tid + NTHR * j)); zb[j] = sconv8_load(zx1, 8 * (tid + NTHR * j)); }
#pragma unroll
            for (int j = 0; j < 4; ++j) { const int mm0 = 4 * (tid + NTHR * j); float y0[8], g[8]; sconv8_calc(za[j], 2 * mm0, w00, w01, w02, b0, y0); sconv8_calc(zb[j], 2 * mm0, w10, w11, w12, b1, g);
                const f32x4 r0 = *(const LAS f32x4*)(X + mm0), r1 = *(const LAS f32x4*)(X + mm0 + 2);
                const f32x4 o0 = (f32x4){g[0], g[1], g[2], g[3]} * (r0 + (f32x4){y0[0], y0[1], y0[2], y0[3]} * fb0), o1 = (f32x4){g[4], g[5], g[6], g[7]} * (r1 + (f32x4){y0[4], y0[5], y0[6], y0[7]} * fb0);
                *(LAS f32x4*)(X + mm0) = o0; *(LAS f32x4*)(X + mm0 + 2) = o1; Ys[mm0 / 2] = o0; Ys[mm0 / 2 + 1] = o1;
                *(LAS f32x4*)(X + 8192 + mm0) = (f32x4){0.f, 0.f, 0.f, 0.f}; *(LAS f32x4*)(X + 8192 + mm0 + 2) = (f32x4){0.f, 0.f, 0.f, 0.f}; }
            __syncthreads();
            fft_fwd(X, tid); pointwise_data(X, Hs + 8192, tid); fft_inv(X, tid);
#pragma unroll
            for (int j = 0; j < 4; ++j) za[j] = sconv8_load(zx2, 8 * (tid + NTHR * j));
            f32x4 qv[4][2];
#pragma unroll
            for (int j = 0; j < 4; ++j) { const int mm0 = 4 * (tid + NTHR * j); qv[j][0] = Ys[mm0 / 2]; qv[j][1] = Ys[mm0 / 2 + 1]; }
#pragma unroll
            for (int j = 0; j < 4; ++j) { const int mm0 = 4 * (tid + NTHR * j); float g[8]; sconv8_calc(za[j], 2 * mm0, w20, w21, w22, b2, g);
                const f32x4 r0 = *(const LAS f32x4*)(X + mm0), r1 = *(const LAS f32x4*)(X + mm0 + 2);
                const f32x4 o0 = (f32x4){g[0], g[1], g[2], g[3]} * (r0 + qv[j][0] * fb1), o1 = (f32x4){g[4], g[5], g[6], g[7]} * (r1 + qv[j][1] * fb1);
                u32x4 w; w.x = pk2(o0.x, o0.y); w.y = pk2(o0.z, o0.w); w.z = pk2(o1.x, o1.y); w.w = pk2(o1.z, o1.w);
                *(u32x4*)(YT + (size_t)c * MLAT + b * SEQ + 2 * mm0) = w; }
            __syncthreads();
        }
    }
}
__device__ __forceinline__ void transpose_phase(const LArgs& a, LAS unsigned char* lds) {
    const int tid = opaque_tid(), lane = tid & 63, wid = tid >> 6, gw = blockIdx.x * NWAVES + wid, NGW = gridDim.x * NWAVES;
    const bf16* YT = (const bf16*)(a.ws + WS_H); bf16* Y = (bf16*)(a.ws + WS_OV);
    LAS bf16* T = (LAS bf16*)(lds + wid * 16384);
    for (int it = gw; it < 32 * 512; it += NGW) {
        const int c0 = (it & 31) * 64, t0 = (it >> 5) * 64;
#pragma unroll
        for (int i = 0; i < 8; ++i) { const int ch = 8 * i + (lane >> 3), k = lane & 7; *(LAS u32x4*)(T + ch * 72 + 8 * k) = *(const u32x4*)(YT + (size_t)(c0 + ch) * MLAT + t0 + 8 * k); }
        asm volatile("s_waitcnt vmcnt(0) lgkmcnt(0)" ::: "memory");
#pragma unroll
        for (int i = 0; i < 8; ++i) { const int t = 8 * i + (lane >> 3), k = lane & 7; unsigned short e[8];
#pragma unroll
            for (int q = 0; q < 8; ++q) e[q] = T[(8 * k + q) * 72 + t];
            u32x4 w; w.x = e[0] | ((unsigned)e[1] << 16); w.y = e[2] | ((unsigned)e[3] << 16); w.z = e[4] | ((unsigned)e[5] << 16); w.w = e[6] | ((unsigned)e[7] << 16);
            *(u32x4*)(Y + (size_t)(t0 + t) * DM + c0 + 8 * k) = w; }
        asm volatile("s_waitcnt lgkmcnt(0)" ::: "memory");
    }
}

#define XB_TMO      128
#define XB_XCNT(j)  (256  + 64 * (j))
#define XB_XSUB(j)  (1280 + 64 * (j))
#define XB_XGEN(j)  (2304 + 64 * (j))
#define XB_TOP      3328
#define XB_TOPGEN   3392
#define XCD_BAR_WORDS 3456
#define XB_SPIN_CAP (1u << 18)

__device__ __forceinline__ unsigned xb_ld(unsigned* p)              { return __hip_atomic_load(p, __ATOMIC_RELAXED, __HIP_MEMORY_SCOPE_AGENT); }
__device__ __forceinline__ unsigned xb_add(unsigned* p, unsigned v) { return __hip_atomic_fetch_add(p, v, __ATOMIC_RELAXED, __HIP_MEMORY_SCOPE_AGENT); }
__device__ __forceinline__ unsigned xb_xcc_id() { return (unsigned)__builtin_amdgcn_s_getreg((3 << 11) | 20) & 0xFu; }
#define XB_SPIN(cond, bar) do { unsigned _sp = 0; while (cond) { __builtin_amdgcn_s_sleep(1); \
    if ((++_sp & 255u) == 0u) { if (xb_ld(&(bar)[XB_TMO])) break; if (_sp > XB_SPIN_CAP) { atomicAdd(&(bar)[XB_TMO], 1u); break; } } } } while (0)

struct XcdBarrier {
    unsigned* bar; unsigned x;
    volatile LAS unsigned* st;
};

__device__ __forceinline__ XcdBarrier xcd_barrier_post(unsigned* bar, volatile LAS unsigned* st) {
    XcdBarrier b; b.bar = bar; b.x = xb_xcc_id(); b.st = st;
    if (threadIdx.x == 0) (void)xb_add(&bar[XB_XCNT(b.x)], 1u);
    return b;
}
__device__ __forceinline__ void xcd_barrier_complete(unsigned* bar, unsigned x, unsigned& nloc, unsigned& nx) {
    const unsigned G = gridDim.x * gridDim.y * gridDim.z;
    unsigned sum, cnt, mine, sp = 0u;
    for (;;) {
        sum = 0u; cnt = 0u; mine = 0u;
#pragma unroll
        for (unsigned j = 0; j < 16; ++j) { const unsigned c = xb_ld(&bar[XB_XCNT(j)]); sum += c; cnt += (c > 0u) ? 1u : 0u; mine = (j == x) ? c : mine; }
        if (sum == G) break;
        __builtin_amdgcn_s_sleep(1);
        if ((++sp & 255u) == 0u) { if (xb_ld(&bar[XB_TMO])) break; if (sp > XB_SPIN_CAP) { atomicAdd(&bar[XB_TMO], 1u); break; } }
    }
    nloc = mine > 0u ? mine : 1u; nx = cnt > 0u ? cnt : 1u;
}

__device__ __forceinline__ void xcd_barrier(const XcdBarrier& b) {
    asm volatile("s_waitcnt vmcnt(0)" ::: "memory");
    __syncthreads();
    if (threadIdx.x == 0) {
        unsigned* bar = b.bar;
        __builtin_amdgcn_s_waitcnt(0);
        unsigned nloc = b.st[0], nx = b.st[1];
        if (nloc == 0u) { xcd_barrier_complete(bar, b.x, nloc, nx); b.st[0] = nloc; b.st[1] = nx; }
        const unsigned old = xb_add(&bar[XB_XSUB(b.x)], 1u);
        const unsigned gen = old / nloc;
        if (old + 1u == (gen + 1u) * nloc) {
            __builtin_amdgcn_fence(__ATOMIC_RELEASE, "agent");
            asm volatile("s_waitcnt vmcnt(0)" ::: "memory");
            const unsigned og = xb_add(&bar[XB_TOP], 1u);
            const unsigned tg = og / nx;
            if (og + 1u == (tg + 1u) * nx) xb_add(&bar[XB_TOPGEN], 1u);
            else XB_SPIN(xb_ld(&bar[XB_TOPGEN]) == tg, bar);
            __builtin_amdgcn_fence(__ATOMIC_ACQUIRE, "agent");
            xb_add(&bar[XB_XGEN(b.x)], 1u);
            asm volatile("s_waitcnt vmcnt(0)" ::: "memory");
        } else {
            XB_SPIN(xb_ld(&bar[XB_XGEN(b.x)]) == gen, bar);
            __builtin_amdgcn_fence(__ATOMIC_ACQUIRE, "agent");
            asm volatile("s_waitcnt vmcnt(0)" ::: "memory");
        }
    }
    __syncthreads();
}

constexpr size_t WS_BAR = 524288;
constexpr int XB_LDS_OFF = TAB_OFF + 512;
constexpr int N_PHASES = 20;
constexpr unsigned SYNC_AFTER = 0xFFFFFu & ~((1u << 2) | (1u << 3) | (1u << 5) | (1u << 19));
#ifndef PHSEL
#define PHSEL 0xfffff
#endif
#define PHON(k) ((PHSEL >> (k)) & 1)
__global__ void __launch_bounds__(NTHR, 2) mega_fwd(Args a_in) {
    extern __shared__ __attribute__((aligned(16))) unsigned char lds[];
    PG8_LAS unsigned char* ldsl = (PG8_LAS unsigned char*)lds;
    const int G = gridDim.x, cid = blockIdx.x;
    LAS unsigned long long* tab = (LAS unsigned long long*)(ldsl + TAB_OFF);
    if (threadIdx.x == 0) {
#pragma unroll
        for (int i = 0; i < 33; ++i) tab[i] = (unsigned long long)a_in.in[i];
        tab[33] = (unsigned long long)a_in.out; tab[34] = (unsigned long long)a_in.ws;
    }
    if (threadIdx.x == 0) { ((LAS unsigned*)(ldsl + XB_LDS_OFF))[0] = 0u; ((LAS unsigned*)(ldsl + XB_LDS_OFF))[1] = 0u; }
    __syncthreads();
    const int ph_lo = a_in.ph_lo, ph_hi = a_in.ph_hi;
    (void)xcd_barrier_post((unsigned*)(a_in.ws + WS_BAR), (volatile LAS unsigned*)(ldsl + XB_LDS_OFF));
#ifndef REPEAT_MASK
#define REPEAT_MASK 0
#endif
    for (int ph2 = 2 * ph_lo; ph2 < 2 * ph_hi; ++ph2) {
        const int ph = ph2 >> 1;
        if ((ph2 & 1) && !((REPEAT_MASK >> ph) & 1)) continue;
        const bool last_pass = (ph2 & 1) || !((REPEAT_MASK >> ph) & 1);
        unsigned tab_off = TAB_OFF; asm volatile("" : "+s"(tab_off) :: "memory");
        const LAS unsigned long long* tabl = (const LAS unsigned long long*)(ldsl + tab_off);
        const LArgs a{tabl, (float*)(__attribute__((address_space(1))) float*)tab_ld(tabl, 33), (unsigned char*)(__attribute__((address_space(1))) unsigned char*)tab_ld(tabl, 34)};
        unsigned char* ws = a.ws;
        const float* mods = (const float*)(ws + WS_MODS);
        const int layer = ph >= 11 ? 1 : 0;
        const float* modsL = mods + (size_t)layer * 3 * 12288;
        switch (ph) {
        case 0: if (PHON(0)) p0_prologue(a, ldsl); break;
        case 1: if (PHON(1)) prenorm_rows<0>(a, MALL, a.in(I_NORM1), modsL, 0, (bf16*)(ws + WS_H)); break;
        case 2: if (PHON(2)) {
            {
                pg8::Gemm g{(const bf16*)(ws + WS_H), (const bf16*)(ws + WS_WIN), MALL, 1024, 2048};
                pg8::EpiIn0 E; E.out0 = (bf16*)(ws + WS_K); E.grp_stride = 0; E.scale0 = 1.f; E.lat0 = MCTX;
                pg8::StaticOrder S; S.init(g.M, g.N, G, cid);
                pg8::gemm_phase<pg8::EpiIn0, pg8::StaticOrder, true, true>(ldsl, g, S, E);
            }
            {
                pg8::Gemm g{(const bf16*)(ws + WS_H) + (size_t)MCTX * DM, (const bf16*)(ws + WS_WIN) + (size_t)2048 * DM, MLAT, 3072, 2048};
                pg8::EpiIn0 E; E.out0 = (bf16*)(ws + WS_Q); E.grp_stride = (WS_U - WS_Q) / 2; E.scale0 = 0.125f * 1.4426950408889634f; E.lat0 = 0;
                pg8::StaticOrder S; S.init(g.M, g.N, G, cid);
                pg8::gemm_phase<pg8::EpiIn0, pg8::StaticOrder, true, true>(ldsl, g, S, E);
            }
        } break;
        case 3: if (PHON(3)) {
            pg8::Gemm g{(const bf16*)(ws + WS_WIN) + (size_t)1024 * DM, (const bf16*)(ws + WS_H), 1024, MALL, 2048}; pg8::EpiPlain16<0> E; E.O = (bf16*)(ws + WS_VT); E.ldc = MALL;
            pg8::StaticOrder S; S.init(g.M, g.N, G, (cid + G / 2) % G);
            pg8::gemm_phase<pg8::EpiPlain16<0>, pg8::StaticOrder, true, true>(ldsl, g, S, E);
        } break;
        case 4: if (PHON(4)) {
            pg8::Gemm g{(const bf16*)(ws + WS_W4X), (const bf16*)(ws + WS_H3X), 8192, SEQ, 256}; pg8::EpiPlain16<1> E; E.O = (bf16*)a.out; E.ldc = SEQ;
            pg8::StaticOrder S; S.init(g.M, g.N, G, cid);
            pg8::gemm_phase<pg8::EpiPlain16<1>, pg8::StaticOrder, true, true>(ldsl, g, S, E);
        } break;
        case 5: if (PHON(5)) attn_phase(a, ldsl); break;
        case 6: if (PHON(6)) sgu_phase(a, ldsl); break;
        case 7: case 10: case 15: case 18: if (PHON(7)) {
            pg8::Gemm g; pg8::EpiResid E; E.gate_bstride = 12288; E.out = (float*)(ws + WS_X);
            if (ph == 7) { g = pg8::Gemm{(const bf16*)(ws + WS_H), (const bf16*)(ws + WS_WOUT0), MLAT, 2048, 2048}; E.base = a.in(I_X); E.gate = modsL + 2 * 2048; }
            else if (ph == 15) { g = pg8::Gemm{(const bf16*)(ws + WS_OV), (const bf16*)(ws + WS_OOUT), MLAT, 2048, 2048}; E.base = (const float*)(ws + WS_X); E.gate = modsL + 2 * 2048; }
            else { g = pg8::Gemm{(const bf16*)(ws + WS_OV), (const bf16*)(ws + (layer ? WS_WD1 : WS_WD0)), MLAT, 2048, DFF}; E.base = (const float*)(ws + WS_X); E.gate = modsL + 5 * 2048; }
            pg8::StaticOrder S; S.init(g.M, g.N, G, cid);
            pg8::gemm_phase<pg8::EpiResid, pg8::StaticOrder, true, true>(ldsl, g, S, E);
        } break;
        case 8: case 16: if (PHON(8)) prenorm_rows<1>(a, MLAT, a.in(I_NORM2) + layer * DM, modsL, 3, (bf16*)(ws + WS_H)); break;
        case 9: case 17: if (PHON(9)) {
            pg8::Gemm g{(const bf16*)(ws + WS_H), (const bf16*)(ws + (layer ? WS_WGU1 : WS_WGU0)), MLAT, 2 * DFF, 2048}; pg8::EpiSwiglu E; E.O = (bf16*)(ws + WS_OV);
            pg8::StaticOrder S; S.init(g.M, g.N, G, cid);
            pg8::gemm_phase<pg8::EpiSwiglu, pg8::StaticOrder, true, true>(ldsl, g, S, E);
        } break;
        case 11: if (PHON(11)) prenorm_rows<1>(a, MLAT, a.in(I_NORM1) + DM, modsL, 0, (bf16*)(ws + WS_H)); break;
        case 12: if (PHON(12)) {
            pg8::Gemm g{(const bf16*)(ws + WS_OIN), (const bf16*)(ws + WS_H), HY_IN, MLAT, 2048}; pg8::EpiPlain16<1> E; E.O = (bf16*)(ws + WS_OV); E.ldc = MLAT;
            pg8::StaticOrder S; S.init(g.M, g.N, G, cid);
            pg8::gemm_phase<pg8::EpiPlain16<1>, pg8::StaticOrder, true, true>(ldsl, g, S, E);
        } break;
        case 13: if (PHON(13)) hyena_phase(a, ldsl); break;
        case 14: if (PHON(14)) transpose_phase(a, ldsl); break;
        case 19: if (PHON(19)) final_norm_rows(a); break;
        default: break;
        }
        if (ph + 1 < ph_hi && (((SYNC_AFTER >> ph) & 1u) || !last_pass)) { if (ph == 0) cg::this_grid().sync();
            else { XcdBarrier xb; xb.bar = (unsigned*)(a.ws + WS_BAR); xb.x = xb_xcc_id(); xb.st = (volatile LAS unsigned*)(ldsl + XB_LDS_OFF); xcd_barrier(xb); } }
        else if (ph + 1 < ph_hi) __syncthreads();
    }
}

extern "C" void kernel_launch(void* const* d_in, const int* in_sizes, int n_in, void* d_out, int out_size, void* d_ws, size_t ws_size, hipStream_t stream) {
    static int grid = 0;
    if (grid == 0) {
        if (n_in != 33 || out_size != MLAT * DM || ws_size < WS_END) { fprintf(stderr, "kernel_launch: unexpected shapes (n_in %d, out %d, ws %zu)\n", n_in, out_size, ws_size); grid = -1; return; }
        int dev = 0, cus = 0, per_cu = 0;
        hipGetDevice(&dev); hipDeviceGetAttribute(&cus, hipDeviceAttributeMultiprocessorCount, dev);
        hipFuncSetAttribute((const void*)mega_fwd, hipFuncAttributeMaxDynamicSharedMemorySize, LDS_BYTES);
        if (hipOccupancyMaxActiveBlocksPerMultiprocessor(&per_cu, (const void*)mega_fwd, NTHR, LDS_BYTES) != hipSuccess || per_cu < 1) per_cu = 1;
        (void)hipGetLastError();
        grid = cus * per_cu;
    }
    if (grid < 0) return;
    hipMemsetAsync(d_ws, 0, 1 * MiB, stream);
    Args a{};
    for (int i = 0; i < 33; ++i) a.in[i] = (const float*)d_in[i];
    a.out = (float*)d_out; a.ws = (unsigned char*)d_ws;
#if N_LAUNCH_MODE == 1
    a.ph_lo = 0; a.ph_hi = N_PHASES;
    void* args[] = {&a};
    hipError_t e = hipLaunchCooperativeKernel((const void*)mega_fwd, dim3(grid), dim3(NTHR), args, LDS_BYTES, stream);
    if (e != hipSuccess) fprintf(stderr, "cooperative launch failed: %s (grid %d)\n", hipGetErrorString(e), grid);
#else
    for (int ph = 0; ph < N_PHASES; ++ph) { a.ph_lo = ph; a.ph_hi = ph + 1; hipLaunchKernelGGL(mega_fwd, dim3(grid), dim3(NTHR), LDS_BYTES, stream, a); }
#endif
}
```

```cpp
#include <hip/hip_runtime.h>
#include <hip/hip_cooperative_groups.h>
#include <cstdio>
#include <cstdint>
namespace cg = cooperative_groups;
#ifndef N_LAUNCH_MODE
#define N_LAUNCH_MODE 1
#endif
constexpr int DM = 2048, SEQ = 16384, NB = 2, MLAT = NB * SEQ  , NCTX = 256, MCTX = NB * NCTX  , MALL = MLAT + MCTX  ;
constexpr int DFF = 5632, EVEN_IN = 5120, HY_IN = 6144;
constexpr float MIN_DECAY_F = -3.0701134573253945f, MAX_DECAY_F = -15.350567286626973f;
__device__ __forceinline__ int opaque_tid() { int t = threadIdx.x; asm volatile("" : "+v"(t)); return t; }
namespace pg8 {
#define PG8_LAS __attribute__((address_space(3)))
typedef unsigned short bf16_t;
typedef short bf16x8 __attribute__((ext_vector_type(8)));
typedef float f32x4 __attribute__((ext_vector_type(4)));
typedef unsigned u32x4 __attribute__((ext_vector_type(4)));
constexpr int BM = 256, BK = 64, HALF = 128, HTB = HALF * BK * 2  , STAGE_BYTES = 8 * HTB, NXCD = 8, WGM = 2;

__host__ __device__ __forceinline__ int lds_byte(int r, int c) { const int st = (r >> 4) * 2 + (c >> 5), rr = r & 15, cc = c & 31, ob = rr * 64 + cc * 2; return st * 1024 + (ob ^ (((ob >> 9) & 1) << 5)); }
__host__ __device__ __forceinline__ void stage_rc(int b, int& R, int& C) { const int st = b / 1024, sb = b % 1024, swz = sb ^ (((sb >> 9) & 1) << 5); R = (st >> 1) * 16 + swz / 64; C = (st & 1) * 32 + (swz % 64) / 2; }
__host__ __device__ __forceinline__ int perm32(int rho) { const int n = rho >> 4, i = rho & 15; return 8 * (i >> 2) + 4 * n + (i & 3); }

struct Unit { int pm, pn; };
struct Gemm { const bf16_t* A; const bf16_t* Bt; int M, N, K; };

struct StaticOrder {
    int nM, nN, nwg, G, c;
    __host__ __device__ void init(int M, int N, int G_, int c_) { nM = M / BM; nN = N / BM; nwg = nM * nN; G = G_; c = c_; }
    __host__ __device__ bool next(int i, Unit& u) const {
        const long L = (long)i * G + c; if (L >= nwg) return false;
        int wgid = (int)L; { const int q = nwg / NXCD, r = nwg % NXCD, xcd = wgid % NXCD, off = wgid / NXCD; wgid = (xcd < r ? xcd * (q + 1) : r * (q + 1) + (xcd - r) * q) + off; }
        const int nig = WGM * nN, gid = wgid / nig, fm = gid * WGM, gsz = (nM - fm) < WGM ? (nM - fm) : WGM;
        u.pm = fm + ((wgid % nig) % gsz); u.pn = (wgid % nig) / gsz; return true;
    }
    __device__ __forceinline__ void a_ready(const Unit&) const {}
    __device__ __forceinline__ void done(const Unit&) const {}
};

__device__ __forceinline__ unsigned cvt_pk_bf16(float lo, float hi) { unsigned r; asm volatile("v_cvt_pk_bf16_f32 %0, %1, %2" : "=v"(r) : "v"(lo), "v"(hi)); return r; }
typedef _Float16 f16x2_t __attribute__((ext_vector_type(2)));
typedef unsigned u32x2 __attribute__((ext_vector_type(2)));
__device__ __forceinline__ unsigned cvt_pk_f16(float lo, float hi) { unsigned r; asm volatile("v_cvt_pkrtz_f16_f32 %0, %1, %2" : "=v"(r) : "v"(lo), "v"(hi)); return r; }
__device__ __forceinline__ float gelu_tanh(float x) {
    const float y = 0.7978845608028654f * (x + 0.044715f * x * x * x);
    const float e = __builtin_amdgcn_exp2f(y * 2.8853900817779268f);
    const float t = 1.f - 2.f * __builtin_amdgcn_rcpf(1.f + e);
    return 0.5f * x * (1.f + t);
}
__device__ __forceinline__ float silu_f(float x) { return x * __builtin_amdgcn_rcpf(1.f + __builtin_amdgcn_exp2f(-x * 1.4426950408889634f)); }

template <int mode> struct EpiPlain16 {
    static constexpr bool PERM = true, AFTER_DRAIN = false;
    unsigned short* O; int ldc;
    __device__ __forceinline__ void operator()(const f32x4 (&acc)[2][2][4][2], const Unit& u, int wr, int wc, int fr, int fq) const {
        const int row0 = u.pm * BM + wr * 64 + fr, col0 = u.pn * BM + wc * 32 + 8 * fq;
#pragma unroll
        for (int ai = 0; ai < 2; ++ai)
#pragma unroll
            for (int m = 0; m < 4; ++m) {
                const int row = row0 + ai * HALF + m * 16; unsigned short* rowp = O + (size_t)row * ldc + col0;
                float dk = 0.f;
                if (mode == 2) { const int c = row & 2047; const float delta = __builtin_fabsf(MIN_DECAY_F + (float)c * ((MAX_DECAY_F - MIN_DECAY_F) / 2047.f)); dk = -delta * (1.4426950408889634f / 16383.f); }
#pragma unroll
                for (int bj = 0; bj < 2; ++bj) {
                    f32x4 v0 = acc[ai][bj][m][0], v1 = acc[ai][bj][m][1];
                    if (mode == 2) { const float t0 = (float)(col0 + bj * HALF);
#pragma unroll
                        for (int j = 0; j < 4; ++j) { v0[j] *= __builtin_amdgcn_exp2f(dk * (t0 + (float)j)); v1[j] *= __builtin_amdgcn_exp2f(dk * (t0 + (float)(4 + j))); } }
                    u32x4 w;
                    if (mode == 0) { w.x = cvt_pk_bf16(v0[0], v0[1]); w.y = cvt_pk_bf16(v0[2], v0[3]); w.z = cvt_pk_bf16(v1[0], v1[1]); w.w = cvt_pk_bf16(v1[2], v1[3]); }
                    else { w.x = cvt_pk_f16(v0[0], v0[1]); w.y = cvt_pk_f16(v0[2], v0[3]); w.z = cvt_pk_f16(v1[0], v1[1]); w.w = cvt_pk_f16(v1[2], v1[3]); }
                    *(u32x4*)(rowp + bj * HALF) = w;
                }
                asm volatile("" ::: "memory");
            }
    }
};
struct EpiIn0 {
    static constexpr bool PERM = false, AFTER_DRAIN = false;
    unsigned short* out0; size_t grp_stride; float scale0; int lat0;
    __device__ __forceinline__ void operator()(const f32x4 (&acc)[2][2][4][2], const Unit& u, int wr, int wc, int fr, int fq) const {
        const int grp = (u.pn * BM) >> 10, colt = (u.pn * BM) & 1023;
        unsigned short* base = out0 + (size_t)grp * grp_stride;
        const int kd = grp == 0 ? 0 : 2;
        const float sc = scale0;
        const int col0 = colt + wc * 32 + 4 * fq, row0 = u.pm * BM + wr * 64 + fr;
        if (kd == 0) {
            const bool lat = (u.pm * BM) >= lat0;
            float invrev[4];
#pragma unroll
            for (int j = 0; j < 4; ++j) invrev[j] = __builtin_amdgcn_exp2f(-(float)(4 * fq + j) * (13.287712379549449f / 16.f)) * 0.15915494309189535f;
#pragma unroll
            for (int ai = 0; ai < 2; ++ai)
#pragma unroll
                for (int m = 0; m < 4; ++m) {
                    const int row = row0 + ai * HALF + m * 16; const int t = (row - lat0) & 16383;
                    const float pos = (wc & 1) ? (float)(t & 63) : (float)(t >> 6);
                    float cs[4], sn[4];
#pragma unroll
                    for (int j = 0; j < 4; ++j) { const float r = __builtin_amdgcn_fractf(pos * invrev[j]); cs[j] = lat ? __builtin_amdgcn_cosf(r) : 1.f; sn[j] = lat ? __builtin_amdgcn_sinf(r) : 0.f; }
                    unsigned short* rowp = base + (size_t)row * 1024 + col0;
#pragma unroll
                    for (int bj = 0; bj < 2; ++bj) {
                        const f32x4 x1 = acc[ai][bj][m][0], x2 = acc[ai][bj][m][1]; float o1[4], o2[4];
#pragma unroll
                        for (int j = 0; j < 4; ++j) { o1[j] = (x1[j] * cs[j] - x2[j] * sn[j]) * sc; o2[j] = (x2[j] * cs[j] + x1[j] * sn[j]) * sc; }
                        u32x2 w1, w2; w1.x = cvt_pk_bf16(o1[0], o1[1]); w1.y = cvt_pk_bf16(o1[2], o1[3]); w2.x = cvt_pk_bf16(o2[0], o2[1]); w2.y = cvt_pk_bf16(o2[2], o2[3]);
                        *(u32x2*)(rowp + bj * HALF) = w1; *(u32x2*)(rowp + bj * HALF + 16) = w2;
                    }
                    asm volatile("" ::: "memory");
                }
        } else {
#pragma unroll
            for (int ai = 0; ai < 2; ++ai)
#pragma unroll
                for (int m = 0; m < 4; ++m) {
                    const int row = row0 + ai * HALF + m * 16; unsigned short* rowp = base + (size_t)row * 1024 + col0;
#pragma unroll
                    for (int bj = 0; bj < 2; ++bj)
#pragma unroll
                        for (int n = 0; n < 2; ++n) { const f32x4 v = acc[ai][bj][m][n]; u32x2 w; w.x = cvt_pk_bf16(gelu_tanh(v[0]), gelu_tanh(v[1])); w.y = cvt_pk_bf16(gelu_tanh(v[2]), gelu_tanh(v[3]));
                            *(u32x2*)(rowp + bj * HALF + n * 16) = w; }
                    asm volatile("" ::: "memory");
                }
        }
    }
};
struct EpiResid {
    static constexpr bool PERM = false, AFTER_DRAIN = false;
    const float* base; float* out; const float* gate; int gate_bstride;
    __device__ __forceinline__ void operator()(const f32x4 (&acc)[2][2][4][2], const Unit& u, int wr, int wc, int fr, int fq) const {
        const int col0 = u.pn * BM + wc * 32 + 4 * fq, row0 = u.pm * BM + wr * 64 + fr; const float* gp = gate + (size_t)((u.pm * BM) >> 14) * gate_bstride + col0;
        f32x4 gv[2][2];
#pragma unroll
        for (int bj = 0; bj < 2; ++bj)
#pragma unroll
            for (int n = 0; n < 2; ++n) gv[bj][n] = *(const f32x4*)(gp + bj * HALF + n * 16);
#pragma unroll
        for (int ai = 0; ai < 2; ++ai) {
            f32x4 bs[4][2][2];
#pragma unroll
            for (int m = 0; m < 4; ++m) { const size_t off = (size_t)(row0 + ai * HALF + m * 16) * 2048 + col0;
#pragma unroll
                for (int bj = 0; bj < 2; ++bj)
#pragma unroll
                    for (int n = 0; n < 2; ++n) bs[m][bj][n] = *(const f32x4*)(base + off + bj * HALF + n * 16); }
#pragma unroll
            for (int m = 0; m < 4; ++m) { const size_t off = (size_t)(row0 + ai * HALF + m * 16) * 2048 + col0;
#pragma unroll
                for (int bj = 0; bj < 2; ++bj)
#pragma unroll
                    for (int n = 0; n < 2; ++n) *(f32x4*)(out + off + bj * HALF + n * 16) = bs[m][bj][n] + gv[bj][n] * acc[ai][bj][m][n]; }
            asm volatile("" ::: "memory");
        }
    }
};
struct EpiSwiglu {
    static constexpr bool PERM = true, AFTER_DRAIN = false;
    unsigned short* O;
    __device__ __forceinline__ void operator()(const f32x4 (&acc)[2][2][4][2], const Unit& u, int wr, int wc, int fr, int fq) const {
        const int col0 = u.pn * HALF + wc * 32 + 8 * fq, row0 = u.pm * BM + wr * 64 + fr;
#pragma unroll
        for (int ai = 0; ai < 2; ++ai)
#pragma unroll
            for (int m = 0; m < 4; ++m) {
                float o[8];
#pragma unroll
                for (int n = 0; n < 2; ++n)
#pragma unroll
                    for (int j = 0; j < 4; ++j) o[4 * n + j] = silu_f(acc[ai][0][m][n][j]) * acc[ai][1][m][n][j];
                u32x4 w; w.x = cvt_pk_bf16(o[0], o[1]); w.y = cvt_pk_bf16(o[2], o[3]); w.z = cvt_pk_bf16(o[4], o[5]); w.w = cvt_pk_bf16(o[6], o[7]);
                *(u32x4*)(O + (size_t)(row0 + ai * HALF + m * 16) * DFF + col0) = w;
                asm volatile("" ::: "memory");
            }
    }
};
template <class Epi, class Sched, bool ALIGN_EPI = false, bool SP2 = false>
__device__ __forceinline__ void gemm_phase(PG8_LAS unsigned char* lds, const Gemm g, const Sched& S, const Epi& E) {
    const int tid = opaque_tid(), wid = __builtin_amdgcn_readfirstlane(tid >> 6), lane = tid & 63, wr = wid >> 2, wc = wid & 3, fr = lane & 15, fq = lane >> 4;
    const int K = g.K, nt = K / BK;
    unsigned voffA[2], voffB[2];
#pragma unroll
    for (int i = 0; i < 2; ++i) { int R, C; stage_rc(tid * 16 + i * 8192, R, C); const int Rb = Epi::PERM ? ((R & ~31) + perm32(R & 31)) : R;
        voffA[i] = (unsigned)(R * K + C) * 2u; voffB[i] = (unsigned)(Rb * K + C) * 2u; }
    const size_t kstep = (size_t)(BK * 2);
    const size_t hstep = (size_t)HALF * K * 2;
    const size_t tstep = 2 * hstep;
    const unsigned ldsw = (unsigned)wid * 1024u;
    const int aoff = lds_byte(wr * 64 + fr, fq * 8), boff = lds_byte(wc * 32 + fr, fq * 8);
#define PG8_SA(b, h) (((b) * 2 + (h)) * HTB)
#define PG8_SB(b, h) ((4 + (b) * 2 + (h)) * HTB)
#define PG8_STAGE(bufoff, gbase, voff) do { _Pragma("unroll") for (int _i = 0; _i < 2; ++_i) \
        __builtin_amdgcn_global_load_lds((const unsigned*)((const char*)(gbase) + (voff)[_i]), (PG8_LAS unsigned*)(lds + (bufoff) + ldsw + _i * 8192), 16, 0, 0); } while (0)
#define PG8_LDA(dst, b, h) do { _Pragma("unroll") for (int m = 0; m < 4; ++m) _Pragma("unroll") for (int k = 0; k < 2; ++k) dst[m][k] = *(const PG8_LAS bf16x8*)(lds + PG8_SA(b, h) + aoff + m * 2048 + k * 1024); } while (0)
#define PG8_LDB(dst, b, h) do { _Pragma("unroll") for (int n = 0; n < 2; ++n) _Pragma("unroll") for (int k = 0; k < 2; ++k) dst[n][k] = *(const PG8_LAS bf16x8*)(lds + PG8_SB(b, h) + boff + n * 2048 + k * 1024); } while (0)
#define PG8_MMA(ai, bj, At, Bt) do { __builtin_amdgcn_s_setprio(1); _Pragma("unroll") for (int m = 0; m < 4; ++m) _Pragma("unroll") for (int n = 0; n < 2; ++n) _Pragma("unroll") for (int k = 0; k < 2; ++k) \
        acc[ai][bj][m][n] = __builtin_amdgcn_mfma_f32_16x16x32_bf16(Bt[n][k], At[m][k], acc[ai][bj][m][n], 0, 0, 0); __builtin_amdgcn_s_setprio(0); } while (0)
#define PG8_WAIT_V(n) asm volatile("s_waitcnt vmcnt(" #n ")" ::: "memory")
#define PG8_WAIT_L(n) asm volatile("s_waitcnt lgkmcnt(" #n ")" ::: "memory")
#define PG8_BAR __builtin_amdgcn_s_barrier()
#define PG8_SCHED __builtin_amdgcn_sched_barrier(0)
    Unit cur, nxt; int ui = 0;
    if (!S.next(0, cur)) return;
    f32x4 acc[2][2][4][2];
#pragma unroll
    for (int a = 0; a < 2; ++a)
#pragma unroll
        for (int b = 0; b < 2; ++b)
#pragma unroll
            for (int m = 0; m < 4; ++m)
#pragma unroll
                for (int n = 0; n < 2; ++n) acc[a][b][m][n] = (f32x4){0.f, 0.f, 0.f, 0.f};
    bf16x8 At[4][2], B0[2][2], B1[2][2];
    const char* cA = (const char*)g.A + (size_t)cur.pm * tstep; const char* cB = (const char*)g.Bt + (size_t)cur.pn * tstep;
    S.a_ready(cur);
    if constexpr (SP2) {
        PG8_STAGE(PG8_SB(0, 0), cB, voffB); PG8_STAGE(PG8_SB(0, 1), cB + hstep, voffB); PG8_STAGE(PG8_SA(0, 0), cA, voffA); PG8_STAGE(PG8_SA(0, 1), cA + hstep, voffA);
        if (wr == 1) PG8_BAR;
        PG8_WAIT_V(2); PG8_BAR;
        PG8_STAGE(PG8_SB(1, 0), cB + kstep, voffB); PG8_STAGE(PG8_SA(1, 0), cA + kstep, voffA); PG8_STAGE(PG8_SB(1, 1), cB + hstep + kstep, voffB);
        PG8_WAIT_V(6); PG8_BAR;
    } else {
        PG8_STAGE(PG8_SB(0, 0), cB, voffB); PG8_STAGE(PG8_SA(0, 0), cA, voffA); PG8_STAGE(PG8_SB(0, 1), cB + hstep, voffB); PG8_STAGE(PG8_SA(0, 1), cA + hstep, voffA);
        if (wr == 1) PG8_BAR;
        PG8_WAIT_V(4); PG8_BAR;
        PG8_STAGE(PG8_SB(1, 0), cB + kstep, voffB); PG8_STAGE(PG8_SA(1, 0), cA + kstep, voffA); PG8_STAGE(PG8_SB(1, 1), cB + hstep + kstep, voffB);
        PG8_WAIT_V(6); PG8_BAR;
    }
    for (;;) {
        const bool has_next = S.next(ui + 1, nxt);
        const char* nA = has_next ? (const char*)g.A + (size_t)nxt.pm * tstep : cA; const char* nB = has_next ? (const char*)g.Bt + (size_t)nxt.pn * tstep : cB;
        for (int t = 0; t < nt; t += 2) {
            const bool last = (t == nt - 2);
            const char* a1 = cA + (size_t)(t + 1) * kstep;
            const char* a2 = last ? nA : cA + (size_t)(t + 2) * kstep; const char* b2 = last ? nB : cB + (size_t)(t + 2) * kstep;
            const char* a3 = a2 + kstep; const char* b3 = b2 + kstep;
            if (last && has_next) S.a_ready(nxt);
            if constexpr (SP2) {
            PG8_LDB(B0, 0, 0); PG8_LDB(B1, 0, 1); PG8_SCHED; PG8_LDA(At, 0, 0); PG8_STAGE(PG8_SA(1, 1), a1 + hstep, voffA);
            PG8_WAIT_V(8); PG8_WAIT_L(0); PG8_BAR; PG8_MMA(0, 0, At, B0); PG8_MMA(0, 1, At, B1); PG8_BAR; PG8_SCHED;
            PG8_LDA(At, 0, 1); PG8_STAGE(PG8_SB(0, 0), b2, voffB); PG8_STAGE(PG8_SB(0, 1), b2 + hstep, voffB); PG8_STAGE(PG8_SA(0, 0), a2, voffA);
            PG8_WAIT_V(8); PG8_WAIT_L(0); PG8_BAR; PG8_MMA(1, 0, At, B0); PG8_MMA(1, 1, At, B1); PG8_BAR; PG8_SCHED;
            PG8_LDB(B0, 1, 0); PG8_LDB(B1, 1, 1); PG8_SCHED; PG8_LDA(At, 1, 0); PG8_STAGE(PG8_SA(0, 1), a2 + hstep, voffA);
            PG8_WAIT_V(8); PG8_WAIT_L(0); PG8_BAR; PG8_MMA(0, 0, At, B0); PG8_MMA(0, 1, At, B1); PG8_BAR; PG8_SCHED;
            PG8_LDA(At, 1, 1); PG8_STAGE(PG8_SB(1, 0), b3, voffB); PG8_STAGE(PG8_SB(1, 1), b3 + hstep, voffB); PG8_STAGE(PG8_SA(1, 0), a3, voffA);
            PG8_WAIT_V(8); PG8_WAIT_L(0); PG8_BAR; PG8_MMA(1, 0, At, B0); PG8_MMA(1, 1, At, B1); PG8_BAR; PG8_SCHED;
            } else {
            PG8_LDB(B0, 0, 0); PG8_SCHED; PG8_LDA(At, 0, 0); PG8_STAGE(PG8_SA(1, 1), a1 + hstep, voffA);
            PG8_WAIT_L(8); PG8_BAR; PG8_WAIT_L(0); PG8_MMA(0, 0, At, B0); PG8_BAR; PG8_SCHED;
            PG8_LDB(B1, 0, 1); PG8_STAGE(PG8_SB(0, 0), b2, voffB);
            PG8_BAR; PG8_WAIT_L(0); PG8_MMA(0, 1, At, B1); PG8_BAR;
            PG8_LDA(At, 0, 1); PG8_STAGE(PG8_SA(0, 0), a2, voffA);
            PG8_BAR; PG8_WAIT_L(0); PG8_MMA(1, 0, At, B0); PG8_BAR; PG8_SCHED;
            PG8_STAGE(PG8_SB(0, 1), b2 + hstep, voffB);
            PG8_WAIT_V(6); PG8_BAR; PG8_MMA(1, 1, At, B1); PG8_BAR;
            PG8_LDB(B0, 1, 0); PG8_SCHED; PG8_LDA(At, 1, 0); PG8_STAGE(PG8_SA(0, 1), a2 + hstep, voffA);
            PG8_WAIT_L(8); PG8_BAR; PG8_WAIT_L(0); PG8_MMA(0, 0, At, B0); PG8_BAR; PG8_SCHED;
            PG8_LDB(B1, 1, 1); PG8_STAGE(PG8_SB(1, 0), b3, voffB);
            PG8_BAR; PG8_WAIT_L(0); PG8_MMA(0, 1, At, B1); PG8_BAR;
            PG8_LDA(At, 1, 1); PG8_STAGE(PG8_SA(1, 0), a3, voffA);
            PG8_BAR; PG8_WAIT_L(0); PG8_MMA(1, 0, At, B0); PG8_BAR; PG8_SCHED;
            PG8_STAGE(PG8_SB(1, 1), b3 + hstep, voffB);
            PG8_WAIT_V(6); PG8_BAR; PG8_MMA(1, 1, At, B1); PG8_BAR;
            }
        }
        if constexpr (ALIGN_EPI) { if (wr == 0) PG8_BAR; }
        if constexpr (!Epi::AFTER_DRAIN) { E(acc, cur, wr, wc, fr, fq); S.done(cur); }
        if (!has_next) break;
#pragma unroll
        for (int a = 0; a < 2; ++a)
#pragma unroll
            for (int b = 0; b < 2; ++b)
#pragma unroll
                for (int m = 0; m < 4; ++m)
#pragma unroll
                    for (int n = 0; n < 2; ++n) acc[a][b][m][n] = (f32x4){0.f, 0.f, 0.f, 0.f};
        cur = nxt; cA = nA; cB = nB; ++ui;
        if constexpr (ALIGN_EPI) { if (wr == 1) PG8_BAR; }
    }
    PG8_WAIT_V(0);
    if constexpr (!ALIGN_EPI) { if (wr == 0) PG8_BAR; }
    PG8_BAR;
    if constexpr (Epi::AFTER_DRAIN) { E.fused(acc, cur, wr, wc, fr, fq, lds, wid, lane); S.done(cur); }
#undef PG8_SA
#undef PG8_SB
#undef PG8_STAGE
#undef PG8_LDA
#undef PG8_LDB
#undef PG8_MMA
#undef PG8_WAIT_V
#undef PG8_WAIT_L
#undef PG8_BAR
#undef PG8_SCHED
}
}
#define LAS __attribute__((address_space(3)))
typedef unsigned short bf16;
typedef float f32x4 __attribute__((ext_vector_type(4)));
typedef float f32x2 __attribute__((ext_vector_type(2)));
typedef float f32x16 __attribute__((ext_vector_type(16)));
typedef short bf16x8 __attribute__((ext_vector_type(8)));
typedef unsigned u32x4 __attribute__((ext_vector_type(4)));
typedef unsigned u32x2 __attribute__((ext_vector_type(2)));
typedef _Float16 f16x2 __attribute__((ext_vector_type(2)));
constexpr int NWAVES = 8, NTHR = 512;
constexpr int LDS_BYTES = 147456;
constexpr size_t MiB = 1u << 20;
constexpr size_t WS_MODS = 0;
constexpr size_t WS_H3X = 1 * MiB;
constexpr size_t WS_W4X = 9 * MiB;
constexpr size_t WS_WIN = 16 * MiB;
constexpr size_t WS_WOUT0 = 36 * MiB;
constexpr size_t WS_WGU0 = 44 * MiB;
constexpr size_t WS_WD0 = 88 * MiB;
constexpr size_t WS_HYSCR = 16 * MiB;
constexpr size_t WS_OIN = 110 * MiB;
constexpr size_t WS_OOUT = 134 * MiB;
constexpr size_t WS_WGU1 = 142 * MiB;
constexpr size_t WS_WD1 = 186 * MiB;
constexpr size_t WS_X = 208 * MiB;
constexpr size_t WS_H = 464 * MiB;
constexpr size_t WS_OV = 594 * MiB;
constexpr size_t WS_K = WS_OV, WS_VT = WS_OV + 65 * MiB, WS_Q = WS_OV + 130 * MiB, WS_U = WS_OV + 194 * MiB, WS_G = WS_OV + 258 * MiB;
constexpr size_t WS_END = 978 * MiB;
static_assert(WS_U - WS_Q == WS_G - WS_U, "Q/U/G equally spaced");

struct Args { const float* in[33]; float* out; unsigned char* ws; int ph_lo, ph_hi; };
constexpr int TAB_OFF = 143360;
__device__ __forceinline__ unsigned long long tab_ld(const LAS unsigned long long* tab, int i) {
    const unsigned long long v = tab[i]; const unsigned lo = __builtin_amdgcn_readfirstlane((unsigned)v), hi = __builtin_amdgcn_readfirstlane((unsigned)(v >> 32));
    return ((unsigned long long)hi << 32) | lo; }
struct LArgs { const LAS unsigned long long* tab; float* out; unsigned char* ws;
    __device__ __forceinline__ const float* in(int i) const { return (const float*)(const __attribute__((address_space(1))) float*)tab_ld(tab, i); } };
enum { I_X = 0, I_C, I_CTX, I_CCTX, I_ADAW, I_ADAB, I_NORM1, I_NORM2, I_FG, I_FU, I_FD, I_EWIN, I_EWOUT, I_ELAM, I_ESUBLN, I_ESNG, I_ESNB, I_ESW, I_ESB,
       I_OWIN, I_OCW, I_OCB, I_FW1, I_FB1, I_FW2, I_FB2, I_FW3, I_FB3, I_FFREQ, I_FW4, I_FBIAS, I_OWOUT, I_FNORM };

template <int O> __device__ __forceinline__ float swz_xor(float v) { return __builtin_bit_cast(float, __builtin_amdgcn_ds_swizzle(__builtin_bit_cast(int, v), (O << 10) | 0x1f)); }
__device__ __forceinline__ float xor32_get(float v, int xaddr) { return __builtin_bit_cast(float, __builtin_amdgcn_ds_bpermute(xaddr, __builtin_bit_cast(int, v))); }
__device__ __forceinline__ float wave_sum(float v) {
    v += swz_xor<1>(v); v += swz_xor<2>(v); v += swz_xor<4>(v); v += swz_xor<8>(v); v += swz_xor<16>(v);
    return __builtin_bit_cast(float, __builtin_amdgcn_readlane(__builtin_bit_cast(int, v), 0)) + __builtin_bit_cast(float, __builtin_amdgcn_readlane(__builtin_bit_cast(int, v), 32));
}
__device__ __forceinline__ unsigned f2bf(float f) { unsigned u = __builtin_bit_cast(unsigned, f); return (u + 0x7fffu + ((u >> 16) & 1u)) >> 16; }
__device__ __forceinline__ unsigned pk2(float lo, float hi) { return f2bf(lo) | (f2bf(hi) << 16); }
__device__ __forceinline__ float bf2f(unsigned h) { return __builtin_bit_cast(float, h << 16); }
__device__ __forceinline__ f32x2 cmul(f32x2 a, f32x2 b) { const f32x2 ar = {-a.y, a.x}; return ar * b.y + a * b.x; }

__device__ __forceinline__ void transpose_item(const float* W, int K, int N, bf16* WT, int dst_row0, LAS float* scr, int k0, int n0, int lane) {
#pragma unroll 8
    for (int i = 0; i < 32; ++i) { const int kk = 2 * i + (lane >> 5); scr[kk * 33 + (lane & 31)] = W[(size_t)(k0 + kk) * N + n0 + (lane & 31)]; }
    asm volatile("s_waitcnt vmcnt(0) lgkmcnt(0)" ::: "memory");
    const int c = lane & 7;
#pragma unroll
    for (int j = 0; j < 4; ++j) { const int n = (lane >> 3) + 8 * j; const LAS float* s = scr + (8 * c) * 33 + n;
        u32x4 o; o.x = pk2(s[0 * 33], s[1 * 33]); o.y = pk2(s[2 * 33], s[3 * 33]); o.z = pk2(s[4 * 33], s[5 * 33]); o.w = pk2(s[6 * 33], s[7 * 33]);
        *(u32x4*)(WT + (size_t)(dst_row0 + n) * K + k0 + 8 * c) = o; }
    asm volatile("s_waitcnt lgkmcnt(0)" ::: "memory");
}
template <int MAP> __device__ __forceinline__ void transpose_matrix(const float* W, int K, int N, bf16* WT, LAS float* scr, int gw, int NGW, int lane) {
    const int nblk = N / 32, nitems = (K / 64) * nblk;
    for (int it = gw; it < nitems; it += NGW) {
        const int kb = it / nblk, nb = it % nblk, n0 = nb * 32; int d = n0;
        if (MAP == 1) d = n0 < 1024 ? n0 + 2048 : (n0 < 3072 ? n0 - 1024 : n0);
        if (MAP == 2) d = 256 * (n0 >> 7) + (n0 & 127);
        if (MAP == 3) d = 256 * (n0 >> 7) + 128 + (n0 & 127);
        transpose_item(W, K, N, WT, d, scr, kb * 64, n0, lane);
    }
}
__device__ __forceinline__ void p0_prologue(const LArgs& a, LAS unsigned char* lds) {
    const int tid = opaque_tid(), lane = tid & 63, wid = tid >> 6;
    const int gw = blockIdx.x * NWAVES + wid, NGW = gridDim.x * NWAVES;
    unsigned char* ws = a.ws;
    LAS float* scr = (LAS float*)(lds + wid * 16384);
    {
        float* mods = (float*)(ws + WS_MODS);
        for (int it = gw; it < 3072; it += NGW) {
            const int layer = it / 1536, r = it % 1536, cc = r >> 3, kc = r & 7, col = cc * 64 + lane;
            const float* w = a.in(I_ADAW) + (size_t)layer * 2048 * 12288 + (size_t)(kc * 256) * 12288 + col;
            const float* c0 = a.in(I_C) + kc * 256; const float* c1 = c0 + 2048; const float* c2 = a.in(I_CCTX) + kc * 256;
            float a0 = 0.f, a1 = 0.f, a2 = 0.f;
#pragma unroll 8
            for (int k = 0; k < 256; ++k) { const float wv = w[(size_t)k * 12288]; a0 += pg8::silu_f(c0[k]) * wv; a1 += pg8::silu_f(c1[k]) * wv; a2 += pg8::silu_f(c2[k]) * wv; }
            if (kc == 0) { const float bb = a.in(I_ADAB)[layer * 12288 + col]; a0 += bb; a1 += bb; a2 += bb; }
            float* m = mods + (size_t)layer * 3 * 12288 + col;
            atomicAdd(m, a0); atomicAdd(m + 12288, a1); atomicAdd(m + 2 * 12288, a2);
        }
    }
    transpose_matrix<1>(a.in(I_EWIN), 2048, EVEN_IN, (bf16*)(ws + WS_WIN), scr, gw, NGW, lane);
    transpose_matrix<0>(a.in(I_EWOUT), 2048, 2048, (bf16*)(ws + WS_WOUT0), scr, gw, NGW, lane);
    transpose_matrix<0>(a.in(I_OWIN), 2048, HY_IN, (bf16*)(ws + WS_OIN), scr, gw, NGW, lane);
    transpose_matrix<0>(a.in(I_OWOUT), 2048, 2048, (bf16*)(ws + WS_OOUT), scr, gw, NGW, lane);
    for (int l = 0; l < 2; ++l) {
        bf16* gu = (bf16*)(ws + (l ? WS_WGU1 : WS_WGU0)); bf16* dn = (bf16*)(ws + (l ? WS_WD1 : WS_WD0));
        transpose_matrix<2>(a.in(I_FG) + (size_t)l * 2048 * DFF, 2048, DFF, gu, scr, gw, NGW, lane);
        transpose_matrix<3>(a.in(I_FU) + (size_t)l * 2048 * DFF, 2048, DFF, gu, scr, gw, NGW, lane);
        transpose_matrix<0>(a.in(I_FD) + (size_t)l * 2048 * DFF, DFF, 2048, dn, scr, gw, NGW, lane);
    }
    {
        bf16* W4X = (bf16*)(ws + WS_W4X); const float* w4 = a.in(I_FW4);
        for (int e = blockIdx.x * NTHR + tid; e < 64 * 8192; e += gridDim.x * NTHR) {
            const int k = e >> 13, col = e & 8191; const float w = w4[e]; const unsigned hi = f2bf(w); const unsigned lo = f2bf(w - bf2f(hi));
            bf16* o = W4X + (size_t)col * 256 + k; o[0] = (bf16)hi; o[64] = (bf16)hi; o[128] = (bf16)lo; o[192] = (bf16)lo;
        }
    }
    {
        bf16* H3X = (bf16*)(ws + WS_H3X);
        const float* w1 = a.in(I_FW1); const float* w2 = a.in(I_FW2); const float* w3 = a.in(I_FW3);
        const float b1 = a.in(I_FB1)[lane], b2 = a.in(I_FB2)[lane], b3 = a.in(I_FB3)[lane];
        const float fr0 = a.in(I_FFREQ)[lane] * 0.15915494309189535f, fr1 = a.in(I_FFREQ)[64 + lane] * 0.15915494309189535f, fr2 = a.in(I_FFREQ)[128 + lane] * 0.15915494309189535f;
        float w1c[33], w2c[64], w3c[64];
#pragma unroll
        for (int f = 0; f < 33; ++f) w1c[f] = w1[f * 64 + lane];
#pragma unroll
        for (int k = 0; k < 64; ++k) { w2c[k] = w2[k * 64 + lane]; w3c[k] = w3[k * 64 + lane]; }
        for (int pos = gw; pos < SEQ; pos += NGW) {
            float feat = 0.f;
            { const int bidx = (lane >= 17) ? lane - 17 : lane - 1; const float fb = 1e-4f + (float)(bidx < 0 ? 0 : bidx) * ((15.f - 1e-4f) / 15.f);
              double rv = (double)fb * (double)pos * (1.0 / 16384.0); rv -= __builtin_floor(rv); const float rf = (float)rv;
              if (lane == 0) feat = (float)pos * (1.f / 16383.f); else if (lane <= 16) feat = __builtin_amdgcn_cosf(rf); else if (lane <= 32) feat = -__builtin_amdgcn_sinf(rf); }
            float acc = b1;
#pragma unroll
            for (int f = 0; f < 33; ++f) acc += __builtin_bit_cast(float, __builtin_amdgcn_readlane(__builtin_bit_cast(int, feat), f)) * w1c[f];
            float h = __builtin_amdgcn_sinf(__builtin_amdgcn_fractf(fr0 * acc));
            acc = b2;
#pragma unroll
            for (int k = 0; k < 64; ++k) acc += __builtin_bit_cast(float, __builtin_amdgcn_readlane(__builtin_bit_cast(int, h), k)) * w2c[k];
            h = __builtin_amdgcn_sinf(__builtin_amdgcn_fractf(fr1 * acc));
            acc = b3;
#pragma unroll
            for (int k = 0; k < 64; ++k) acc += __builtin_bit_cast(float, __builtin_amdgcn_readlane(__builtin_bit_cast(int, h), k)) * w3c[k];
            h = __builtin_amdgcn_sinf(__builtin_amdgcn_fractf(fr2 * acc));
            const unsigned hi = f2bf(h), lo = f2bf(h - bf2f(hi));
            bf16* o = H3X + (size_t)pos * 256 + lane; o[0] = (bf16)hi; o[64] = (bf16)lo; o[128] = (bf16)hi; o[192] = (bf16)lo;
        }
    }
}

template <int SRC> __device__ __forceinline__ void prenorm_rows(const LArgs& a, int nrows, const float* nw, const float* mods_layer, int shift_part, bf16* dst) {
    const int tid = opaque_tid(), lane = tid & 63, wid = tid >> 6, gw = blockIdx.x * NWAVES + wid, NGW = gridDim.x * NWAVES;
    for (int chunk = gw; chunk < nrows / 16; chunk += NGW) {
        const int row0 = chunk * 16; const float* src0; int cond;
        if (SRC == 0) { if (row0 < MCTX) { src0 = a.in(I_CTX) + (size_t)row0 * DM; cond = 2; } else { src0 = a.in(I_X) + (size_t)(row0 - MCTX) * DM; cond = (row0 - MCTX) >> 14; } }
        else { src0 = (const float*)(a.ws + WS_X) + (size_t)row0 * DM; cond = row0 >> 14; }
        const float* sh = mods_layer + (size_t)cond * 12288 + shift_part * 2048; const float* sc = sh + 2048;
        f32x4 cs[8], sv[8];
#pragma unroll
        for (int j = 0; j < 8; ++j) { const int col = 4 * lane + 256 * j; cs[j] = *(const f32x4*)(nw + col) * (*(const f32x4*)(sc + col) + 1.f); sv[j] = *(const f32x4*)(sh + col); }
#pragma unroll 2
        for (int r = 0; r < 16; ++r) {
            const float* src = src0 + (size_t)r * DM; f32x4 v[8]; float ss = 0.f;
#pragma unroll
            for (int j = 0; j < 8; ++j) { v[j] = *(const f32x4*)(src + 4 * lane + 256 * j); ss += (v[j].x * v[j].x + v[j].y * v[j].y) + (v[j].z * v[j].z + v[j].w * v[j].w); }
            const float rn = 1.f / sqrtf(wave_sum(ss) * (1.f / DM) + 1e-6f);
#pragma unroll
            for (int j = 0; j < 8; ++j) { const int col = 4 * lane + 256 * j; const f32x4 o = v[j] * rn * cs[j] + sv[j]; u32x2 pq; pq.x = pk2(o.x, o.y); pq.y = pk2(o.z, o.w); *(u32x2*)(dst + (size_t)(row0 + r) * DM + col) = pq; }
        }
    }
}
__device__ __forceinline__ void final_norm_rows(const LArgs& a) {
    const int tid = opaque_tid(), lane = tid & 63, wid = tid >> 6, gw = blockIdx.x * NWAVES + wid, NGW = gridDim.x * NWAVES;
    const float* nw = a.in(I_FNORM);
    f32x4 cs[8];
#pragma unroll
    for (int j = 0; j < 8; ++j) cs[j] = *(const f32x4*)(nw + 4 * lane + 256 * j);
    for (int chunk = gw; chunk < MLAT / 16; chunk += NGW) {
#pragma unroll 2
        for (int r = 0; r < 16; ++r) {
            const int row = chunk * 16 + r; const float* src = (const float*)(a.ws + WS_X) + (size_t)row * DM; f32x4 v[8]; float ss = 0.f;
#pragma unroll
            for (int j = 0; j < 8; ++j) { v[j] = *(const f32x4*)(src + 4 * lane + 256 * j); ss += (v[j].x * v[j].x + v[j].y * v[j].y) + (v[j].z * v[j].z + v[j].w * v[j].w); }
            const float rn = 1.f / sqrtf(wave_sum(ss) * (1.f / DM) + 1e-6f);
#pragma unroll
            for (int j = 0; j < 8; ++j) { const int col = 4 * lane + 256 * j; *(f32x4*)(a.out + (size_t)row * DM + col) = v[j] * rn * cs[j]; }
        }
    }
}

__device__ __forceinline__ void attn_phase(const LArgs& a, LAS unsigned char* lds) {
    const int tid = opaque_tid(), lane = tid & 63, wid = tid >> 6, pr = wid >> 1, mp = wid & 1, r32 = lane & 31, hi = lane >> 5;
    const bf16* Qg = (const bf16*)(a.ws + WS_Q); const bf16* Kg = (const bf16*)(a.ws + WS_K); const bf16* Vt = (const bf16*)(a.ws + WS_VT);
    bf16* act = (bf16*)(a.ws + WS_H);
    float lam;
    { const float* lp = a.in(I_ELAM); const float v = wave_sum(lp[lane] * lp[64 + lane]), w = wave_sum(lp[128 + lane] * lp[192 + lane]); lam = __expf(v) - __expf(w) + 0.2f; }
    constexpr int KROW = 272, VROW = 144, KBUF = 64 * KROW, VBUF = 128 * VROW, NT = 260;
    const int xaddr = (lane ^ 32) << 2;
    const int kappa = (r32 & 16) | ((r32 & 4) << 1) | ((r32 & 8) >> 1) | (r32 & 3);
    const int krow_t = tid >> 4, kch = tid & 15, vrow_t = tid >> 3, vch = tid & 7;
    const float* subln = a.in(I_ESUBLN);
    for (int u = blockIdx.x; u < 2048; u += gridDim.x) {
        const int bh = u >> 7, qb = u & 127, b = bh >> 3, h = bh & 7;
        const bf16* Qp = Qg + (size_t)(b * SEQ + qb * 128 + pr * 32 + r32) * 1024 + h * 128 + mp * 64 + hi * 8;
        bf16x8 qf[4];
#pragma unroll
        for (int ks = 0; ks < 4; ++ks) qf[ks] = *(const bf16x8*)(Qp + ks * 16);
        f32x16 o[4];
#pragma unroll
        for (int d = 0; d < 4; ++d)
#pragma unroll
            for (int r = 0; r < 16; ++r) o[d][r] = 0.f;
        float mrun = -1e30f, lrun = 0.f;
        const bf16* kgp = Kg + (size_t)krow_t * 1024 + h * 128 + kch * 8;
        const bf16* vgp = Vt + (size_t)(h * 128 + vrow_t) * MALL + vch * 8;
        u32x4 kreg[2], vreg[2];
#define ATT_LOAD(j) do { const int kb0_ = (j) < 4 ? b * NCTX + (j) * 64 : MCTX + b * SEQ + ((j) - 4) * 64; \
            kreg[0] = *(const u32x4*)(kgp + (size_t)kb0_ * 1024); kreg[1] = *(const u32x4*)(kgp + (size_t)(kb0_ + 32) * 1024); \
            vreg[0] = *(const u32x4*)(vgp + kb0_); vreg[1] = *(const u32x4*)(vgp + (size_t)64 * MALL + kb0_); } while (0)
#define ATT_STORE(kbuf, vbuf) do { LAS unsigned char* kb_ = lds + (kbuf) * KBUF; LAS unsigned char* vb_ = lds + 2 * KBUF + (vbuf) * VBUF; \
            *(LAS u32x4*)(kb_ + krow_t * KROW + kch * 16) = kreg[0]; *(LAS u32x4*)(kb_ + (krow_t + 32) * KROW + kch * 16) = kreg[1]; \
            *(LAS u32x4*)(vb_ + vrow_t * VROW + vch * 16) = vreg[0]; *(LAS u32x4*)(vb_ + (vrow_t + 64) * VROW + vch * 16) = vreg[1]; } while (0)
#define ATT_VRD(DST, vb_, kstep) do { _Pragma("unroll") for (int d = 0; d < 4; ++d) DST[d] = *(const LAS bf16x8*)((vb_) + (32 * d + r32) * VROW + (kstep) * 32 + hi * 16); } while (0)
#define ATT_VMM(SRC, kstep) do { const bf16x8 pf = __builtin_bit_cast(bf16x8, pw[kstep]); _Pragma("unroll") for (int d = 0; d < 4; ++d) o[d] = __builtin_amdgcn_mfma_f32_32x32x16_bf16(SRC[d], pf, o[d], 0, 0, 0); } while (0)
#define ATT_PV_PRE(vbuf) do { const LAS unsigned char* vb_ = lds + 2 * KBUF + (vbuf) * VBUF; ATT_VRD(vfa, vb_, 0); __builtin_amdgcn_sched_barrier(0); } while (0)
#define ATT_PV(vbuf, PRE) do { const LAS unsigned char* vb_ = lds + 2 * KBUF + (vbuf) * VBUF; \
            if (!(PRE)) ATT_VRD(vfa, vb_, 0); \
            ATT_VRD(vfb, vb_, 1); __builtin_amdgcn_sched_barrier(0); ATT_VMM(vfa, 0); __builtin_amdgcn_sched_barrier(0); \
            ATT_VRD(vfa, vb_, 2); __builtin_amdgcn_sched_barrier(0); ATT_VMM(vfb, 1); __builtin_amdgcn_sched_barrier(0); \
            ATT_VRD(vfb, vb_, 3); __builtin_amdgcn_sched_barrier(0); ATT_VMM(vfa, 2); __builtin_amdgcn_sched_barrier(0); \
            ATT_VMM(vfb, 3); } while (0)
        const bool late = wid >= 4;
        u32x4 pw[4]; bf16x8 vfa[4], vfb[4];
#pragma unroll
        for (int i = 0; i < 4; ++i) pw[i] = (u32x4){0u, 0u, 0u, 0u};
        ATT_LOAD(0); ATT_STORE(0, 0); __syncthreads();
        int vprev = 2, vcur = 0, vnext = 1;
        for (int j = 0; j < NT; ++j) {
            const int cur = j & 1;
            if (j + 1 < NT) ATT_LOAD(j + 1);
            if (late && j > 0) ATT_PV(vprev, 0);
            const LAS unsigned char* kb_ = lds + cur * KBUF;
            f32x16 s[2];
#pragma unroll
            for (int kb = 0; kb < 2; ++kb) {
#pragma unroll
                for (int r = 0; r < 16; ++r) s[kb][r] = 0.f;
#pragma unroll
                for (int ks = 0; ks < 4; ++ks) { const bf16x8 kf = *(const LAS bf16x8*)(kb_ + (32 * kb + kappa) * KROW + mp * 128 + ks * 32 + hi * 16);
                    s[kb] = __builtin_amdgcn_mfma_f32_32x32x16_bf16(kf, qf[ks], s[kb], 0, 0, 0); }
            }
            if (!late) ATT_PV_PRE(vcur);
            float mx = s[0][0];
#pragma unroll
            for (int r = 1; r < 16; ++r) mx = fmaxf(mx, s[0][r]);
#pragma unroll
            for (int r = 0; r < 16; ++r) mx = fmaxf(mx, s[1][r]);
            mx = fmaxf(mx, xor32_get(mx, xaddr));
            const float mnew = fmaxf(mrun, mx);
            if (__any(mnew > mrun)) {
                const float alpha = __builtin_amdgcn_exp2f(mrun - mnew); lrun *= alpha;
#pragma unroll
                for (int d = 0; d < 4; ++d)
#pragma unroll
                    for (int r = 0; r < 16; ++r) o[d][r] *= alpha;
                mrun = mnew;
            }
            float psum = 0.f;
#pragma unroll
            for (int kb = 0; kb < 2; ++kb)
#pragma unroll
                for (int r = 0; r < 16; ++r) { const float pv = __builtin_amdgcn_exp2f(s[kb][r] - mrun); s[kb][r] = pv; psum += pv; }
            lrun += psum;
#pragma unroll
            for (int kb = 0; kb < 2; ++kb)
#pragma unroll
                for (int g = 0; g < 2; ++g) {
                    u32x4 w4; w4.x = pg8::cvt_pk_bf16(s[kb][8 * g + 0], s[kb][8 * g + 1]); w4.y = pg8::cvt_pk_bf16(s[kb][8 * g + 2], s[kb][8 * g + 3]);
                    w4.z = pg8::cvt_pk_bf16(s[kb][8 * g + 4], s[kb][8 * g + 5]); w4.w = pg8::cvt_pk_bf16(s[kb][8 * g + 6], s[kb][8 * g + 7]);
                    pw[2 * kb + g] = w4;
                }
            if (!late) ATT_PV(vcur, 1);
            if (j + 1 < NT) ATT_STORE(cur ^ 1, vnext);
            __syncthreads();
            { const int t_ = vprev; vprev = vcur; vcur = vnext; vnext = t_; }
        }
        if (late) ATT_PV(vprev, 0);
        __syncthreads();
#undef ATT_LOAD
#undef ATT_STORE
#undef ATT_PV
#undef ATT_PV_PRE
#undef ATT_VRD
#undef ATT_VMM
        const float ltot = lrun + xor32_get(lrun, xaddr); const float inv = 1.f / ltot;
        LAS float* xch = (LAS float*)lds + pr * 4096;
        if (mp == 1) { const float f = inv * lam;
#pragma unroll
            for (int d = 0; d < 4; ++d)
#pragma unroll
                for (int r = 0; r < 16; ++r) xch[(d * 16 + r) * 64 + lane] = o[d][r] * f; }
        __syncthreads();
        if (mp == 0) {
            float ss = 0.f;
#pragma unroll
            for (int d = 0; d < 4; ++d)
#pragma unroll
                for (int r = 0; r < 16; ++r) { const float dv = o[d][r] * inv - xch[(d * 16 + r) * 64 + lane]; o[d][r] = dv; ss += dv * dv; }
            ss += xor32_get(ss, xaddr);
            const float rn = (1.f / sqrtf(ss * (1.f / 128.f) + 1e-5f)) * 0.8f;
            bf16* orow = act + (size_t)(b * SEQ + qb * 128 + pr * 32 + r32) * DM + h * 128;
#pragma unroll
            for (int d = 0; d < 4; ++d)
#pragma unroll
                for (int j4 = 0; j4 < 4; ++j4) { const int dv0 = 32 * d + 8 * j4 + 4 * hi; const f32x4 g = *(const f32x4*)(subln + dv0);
                    u32x2 w; w.x = pk2(o[d][4 * j4 + 0] * rn * g.x, o[d][4 * j4 + 1] * rn * g.y); w.y = pk2(o[d][4 * j4 + 2] * rn * g.z, o[d][4 * j4 + 3] * rn * g.w);
                    *(u32x2*)(orow + dv0) = w; }
        }
        __syncthreads();
    }
}

__device__ __forceinline__ void sgu_phase(const LArgs& a, LAS unsigned char* lds) {
    const int tid = opaque_tid(), lane = tid & 63, wid = tid >> 6, r32 = lane & 31, hi = lane >> 5;
    constexpr int ROWB = 272;
    LAS unsigned char* WsB = lds; LAS unsigned char* VVt = lds + 128 * ROWB;
    const bf16* Ug = (const bf16*)(a.ws + WS_U); const bf16* Gg = (const bf16*)(a.ws + WS_G); bf16* act = (bf16*)(a.ws + WS_H);
    const bool same_g = (gridDim.x & 7) == 0;
    for (int u = blockIdx.x, first = 1; u < 2048; u += gridDim.x, first = 0) {
        const int g = u & 7, row0 = (u >> 3) * 128;
        if (first || !same_g) {
            const f32x4* wsrc = (const f32x4*)(a.in(I_ESW) + (size_t)g * 16384);
#pragma unroll
            for (int i = 0; i < 8; ++i) { const int idx = tid + NTHR * i; const f32x4 w = wsrc[idx]; const int pr_ = idx >> 5, q4 = (idx & 31) * 4;
                u32x2 pk; pk.x = pk2(w.x, w.y); pk.y = pk2(w.z, w.w); *(LAS u32x2*)(WsB + pr_ * ROWB + q4 * 2) = pk; }
        }
        const float ng0 = a.in(I_ESNG)[g * 128 + 2 * lane], ng1 = a.in(I_ESNG)[g * 128 + 2 * lane + 1], nb0 = a.in(I_ESNB)[g * 128 + 2 * lane], nb1 = a.in(I_ESNB)[g * 128 + 2 * lane + 1];
#pragma unroll
        for (int rr = 0; rr < 16; ++rr) {
            const int r = wid * 16 + rr; const unsigned pk = *(const unsigned*)(Gg + (size_t)(row0 + r) * 1024 + g * 128 + 2 * lane);
            const float x0 = bf2f(pk & 0xffffu), x1 = bf2f(pk >> 16);
            const float mean = wave_sum(x0 + x1) * (1.f / 128.f); const float d0 = x0 - mean, d1 = x1 - mean;
            const float rstd = 1.f / sqrtf(wave_sum(d0 * d0 + d1 * d1) * (1.f / 128.f) + 1e-5f);
            *(LAS bf16*)(VVt + (2 * lane) * ROWB + r * 2) = (bf16)f2bf(d0 * rstd * ng0 + nb0); *(LAS bf16*)(VVt + (2 * lane + 1) * ROWB + r * 2) = (bf16)f2bf(d1 * rstd * ng1 + nb1);
        }
        __syncthreads();
        const int cblk = wid >> 1;
        f32x16 acc[2];
#pragma unroll
        for (int i = 0; i < 2; ++i)
#pragma unroll
            for (int r = 0; r < 16; ++r) acc[i][r] = 0.f;
#pragma unroll
        for (int ks = 0; ks < 8; ++ks) {
            const bf16x8 af = *(const LAS bf16x8*)(VVt + (32 * cblk + r32) * ROWB + ks * 32 + hi * 16);
#pragma unroll
            for (int i = 0; i < 2; ++i) { const int pblk = (wid & 1) * 2 + i; const bf16x8 bfr = *(const LAS bf16x8*)(WsB + (32 * pblk + r32) * ROWB + ks * 32 + hi * 16);
                acc[i] = __builtin_amdgcn_mfma_f32_32x32x16_bf16(af, bfr, acc[i], 0, 0, 0); }
        }
#pragma unroll
        for (int i = 0; i < 2; ++i) {
            const int p = 32 * ((wid & 1) * 2 + i) + r32; const float bs = a.in(I_ESB)[g * 128 + p];
            const bf16* up = Ug + (size_t)(row0 + p) * 1024 + g * 128 + 32 * cblk + 4 * hi; bf16* op = act + (size_t)(row0 + p) * DM + 1024 + g * 128 + 32 * cblk + 4 * hi;
#pragma unroll
            for (int j4 = 0; j4 < 4; ++j4) {
                const u32x2 uu = *(const u32x2*)(up + 8 * j4);
                const f32x4 mix = {acc[i][4 * j4 + 0] + bs, acc[i][4 * j4 + 1] + bs, acc[i][4 * j4 + 2] + bs, acc[i][4 * j4 + 3] + bs};
                const f32x4 o = (f32x4){bf2f(uu.x & 0xffffu), bf2f(uu.x >> 16), bf2f(uu.y & 0xffffu), bf2f(uu.y >> 16)} * mix;
                u32x2 w; w.x = pk2(o.x, o.y); w.y = pk2(o.z, o.w); *(u32x2*)(op + 8 * j4) = w;
            }
        }
        __syncthreads();
    }
}

__device__ __forceinline__ void bfly_fwd(f32x2& x0, f32x2& x1, f32x2& x2, f32x2& x3, const f32x2 w1) {
    const f32x2 w2 = cmul(w1, w1);
    const f32x2 y0 = x0 + x2, y1 = x1 + x3, y2 = cmul(x0 - x2, w1), t = cmul(x1 - x3, w1); const f32x2 y3 = {t.y, -t.x};
    x0 = y0 + y1; x1 = cmul(y0 - y1, w2); x2 = y2 + y3; x3 = cmul(y2 - y3, w2);
}
__device__ __forceinline__ void bfly_inv(f32x2& x0, f32x2& x1, f32x2& x2, f32x2& x3, const f32x2 w2) {
    const f32x2 w = cmul(w2, w2);
    const f32x2 t1 = cmul(x1, w), t3 = cmul(x3, w);
    const f32x2 y0 = x0 + t1, y1 = x0 - t1, y2 = x2 + t3, y3 = x2 - t3;
    const f32x2 u2 = cmul(y2, w2), u3 = cmul(y3, w2); const f32x2 u3i = {-u3.y, u3.x};
    x0 = y0 + u2; x1 = y1 + u3i; x2 = y0 - u2; x3 = y1 - u3i;
}
__device__ __forceinline__ void fft_fwd(LAS f32x2* X, int tid) {
    const f32x2 R1 = {0.92387953251128674f, -0.38268343236508977f}, R2 = {0.70710678118654752f, -0.70710678118654752f}, R3 = {0.38268343236508977f, -0.92387953251128674f};
    for (int lgb = 10; lgb >= 2; lgb -= 4) {
        const int h = 1 << lgb; const float inv16h = 1.f / (float)(16 * h);
#pragma unroll 2
        for (int G = tid; G < 1024; G += NTHR) {
            const int j = G & (h - 1), base = ((G >> lgb) << (lgb + 4)) + j;
            f32x2 x[4][4];
#pragma unroll
            for (int a = 0; a < 4; ++a)
#pragma unroll
                for (int bb = 0; bb < 4; ++bb) x[a][bb] = X[base + a * 4 * h + bb * h];
            const float rev = (float)j * inv16h; const f32x2 wb = {__builtin_amdgcn_cosf(rev), -__builtin_amdgcn_sinf(rev)};
            bfly_fwd(x[0][0], x[1][0], x[2][0], x[3][0], wb);
            bfly_fwd(x[0][1], x[1][1], x[2][1], x[3][1], cmul(wb, R1));
            bfly_fwd(x[0][2], x[1][2], x[2][2], x[3][2], cmul(wb, R2));
            bfly_fwd(x[0][3], x[1][3], x[2][3], x[3][3], cmul(wb, R3));
            const f32x2 wb2 = cmul(wb, wb), wl = cmul(wb2, wb2);
#pragma unroll
            for (int a = 0; a < 4; ++a) bfly_fwd(x[a][0], x[a][1], x[a][2], x[a][3], wl);
#pragma unroll
            for (int a = 0; a < 4; ++a)
#pragma unroll
                for (int bb = 0; bb < 4; ++bb) X[base + a * 4 * h + bb * h] = x[a][bb];
        }
        __syncthreads();
    }
#pragma unroll 4
    for (int q = tid; q < 4096; q += NTHR) {
        const int i0 = 4 * q; f32x2 x0 = X[i0], x1 = X[i0 + 1], x2 = X[i0 + 2], x3 = X[i0 + 3];
        bfly_fwd(x0, x1, x2, x3, (f32x2){1.f, 0.f});
        X[i0] = x0; X[i0 + 1] = x1; X[i0 + 2] = x2; X[i0 + 3] = x3;
    }
    __syncthreads();
}
__device__ __forceinline__ void fft_inv(LAS f32x2* X, int tid) {
    const f32x2 R1 = {0.92387953251128674f, 0.38268343236508977f}, R2 = {0.70710678118654752f, 0.70710678118654752f}, R3 = {0.38268343236508977f, 0.92387953251128674f};
    for (int lga = 0; lga <= 8; lga += 4) {
        const int h = 1 << lga; const float inv16h = 1.f / (float)(16 * h);
#pragma unroll 2
        for (int G = tid; G < 1024; G += NTHR) {
            const int j = G & (h - 1), base = ((G >> lga) << (lga + 4)) + j;
            f32x2 x[4][4];
#pragma unroll
            for (int a = 0; a < 4; ++a)
#pragma unroll
                for (int bb = 0; bb < 4; ++bb) x[a][bb] = X[base + a * 4 * h + bb * h];
            const float rev = (float)j * inv16h; const f32x2 wb = {__builtin_amdgcn_cosf(rev), __builtin_amdgcn_sinf(rev)};
            const f32x2 wb2 = cmul(wb, wb), wl = cmul(wb2, wb2);
#pragma unroll
            for (int a = 0; a < 4; ++a) bfly_inv(x[a][0], x[a][1], x[a][2], x[a][3], wl);
            bfly_inv(x[0][0], x[1][0], x[2][0], x[3][0], wb);
            bfly_inv(x[0][1], x[1][1], x[2][1], x[3][1], cmul(wb, R1));
            bfly_inv(x[0][2], x[1][2], x[2][2], x[3][2], cmul(wb, R2));
            bfly_inv(x[0][3], x[1][3], x[2][3], x[3][3], cmul(wb, R3));
#pragma unroll
            for (int a = 0; a < 4; ++a)
#pragma unroll
                for (int bb = 0; bb < 4; ++bb) X[base + a * 4 * h + bb * h] = x[a][bb];
        }
        __syncthreads();
    }
#pragma unroll 4
    for (int q = tid; q < 4096; q += NTHR) {
        f32x2 x0 = X[q], x1 = X[q + 4096], x2 = X[q + 8192], x3 = X[q + 12288];
        const float rev = (float)q * (1.f / 16384.f);
        bfly_inv(x0, x1, x2, x3, (f32x2){__builtin_amdgcn_cosf(rev), __builtin_amdgcn_sinf(rev)});
        X[q] = x0; X[q + 4096] = x1; X[q + 8192] = x2; X[q + 12288] = x3;
    }
    __syncthreads();
}
__device__ __forceinline__ void pointwise_filter(const LAS f32x2* X, f32x4* Hs, float scale, int tid) {
#pragma unroll 2
    for (int s = tid; s < 8192; s += NTHR) {
        if (s == 0) { const f32x2 A = X[0], Cm = X[1]; Hs[0] = (f32x4){(A.x + A.y) * scale, (A.x - A.y) * scale, Cm.x * scale, -Cm.y * scale}; }
        else {
            const int i1 = 2 * s, i2 = i1 ^ ((1 << (31 - __clz(i1))) - 1); const int p = (int)(__brev((unsigned)i1) >> 18);
            const f32x2 A = X[i1], B = X[i2];
            const f32x2 E = {0.5f * (A.x + B.x), 0.5f * (A.y - B.y)}; const f32x2 Dm = {A.x - B.x, A.y + B.y}; const f32x2 O = {0.5f * Dm.y, -0.5f * Dm.x};
            const float rev = (float)p * (1.f / 32768.f); const float c = __builtin_amdgcn_cosf(rev), sn = __builtin_amdgcn_sinf(rev);
            const f32x2 WO = cmul((f32x2){c, -sn}, O);
            Hs[s] = (f32x4){(E.x + WO.x) * scale, (E.y + WO.y) * scale, (E.x - WO.x) * scale, -(E.y - WO.y) * scale};
        }
    }
    __syncthreads();
}
__device__ __forceinline__ void pointwise_data(LAS f32x2* X, const f32x4* Hs, int tid) {
#pragma unroll 4
    for (int s = tid; s < 8192; s += NTHR) {
        const f32x4 hh = Hs[s];
        if (s == 0) {
            const f32x2 A = X[0]; const float Y0 = (A.x + A.y) * hh.x, YM = (A.x - A.y) * hh.y; X[0] = (f32x2){0.5f * (Y0 + YM), 0.5f * (Y0 - YM)};
            const f32x2 Cm = X[1]; const f32x2 Y = cmul((f32x2){Cm.x, -Cm.y}, (f32x2){hh.z, hh.w}); X[1] = (f32x2){Y.x, -Y.y};
        } else {
            const int i1 = 2 * s, i2 = i1 ^ ((1 << (31 - __clz(i1))) - 1); const int p = (int)(__brev((unsigned)i1) >> 18);
            const f32x2 A = X[i1], B = X[i2];
            const f32x2 E = {0.5f * (A.x + B.x), 0.5f * (A.y - B.y)}; const f32x2 Dm = {A.x - B.x, A.y + B.y}; const f32x2 O = {0.5f * Dm.y, -0.5f * Dm.x};
            const float rev = (float)p * (1.f / 32768.f); const float c = __builtin_amdgcn_cosf(rev), sn = __builtin_amdgcn_sinf(rev);
            const f32x2 WO = cmul((f32x2){c, -sn}, O);
            const f32x2 Xk = E + WO; const f32x2 Xk2 = {E.x - WO.x, -(E.y - WO.y)};
            const f32x2 Yk = cmul(Xk, (f32x2){hh.x, hh.y}), Yk2 = cmul(Xk2, (f32x2){hh.z, hh.w});
            const f32x2 Ye = {0.5f * (Yk.x + Yk2.x), 0.5f * (Yk.y - Yk2.y)}; const f32x2 Dd = {Yk.x - Yk2.x, Yk.y + Yk2.y};
            const f32x2 Yo = cmul((f32x2){0.5f * c, 0.5f * sn}, Dd);
            X[i1] = (f32x2){Ye.x - Yo.y, Ye.y + Yo.x}; X[i2] = (f32x2){Ye.x + Yo.y, Yo.x - Ye.y};
        }
    }
    __syncthreads();
}
__device__ __forceinline__ void h8_to_f(const u32x4 raw, float* e) {
#pragma unroll
    for (int i = 0; i < 4; ++i) { const unsigned w = raw[i];
        e[2 * i] = (float)__builtin_bit_cast(_Float16, (unsigned short)(w & 0xffffu)); e[2 * i + 1] = (float)__builtin_bit_cast(_Float16, (unsigned short)(w >> 16)); }
}
struct Z10 { u32x4 raw; _Float16 zm, zp; };
__device__ __forceinline__ Z10 sconv8_load(const _Float16* z, int t0) {
    Z10 r; r.raw = *(const u32x4*)(z + t0); r.zm = z[t0 > 0 ? t0 - 1 : 0]; r.zp = z[t0 + 8 < SEQ ? t0 + 8 : SEQ - 1]; return r;
}
__device__ __forceinline__ void sconv8_calc(const Z10& r, int t0, float w0, float w1, float w2, float bias, float* y) {
    float e[10]; e[0] = t0 > 0 ? (float)r.zm : 0.f; e[9] = (t0 + 8 < SEQ) ? (float)r.zp : 0.f; h8_to_f(r.raw, e + 1);
#pragma unroll
    for (int i = 0; i < 8; ++i) y[i] = bias + w0 * e[i] + w1 * e[i + 1] + w2 * e[i + 2];
}
constexpr size_t HY_WG_BYTES = 262144 + 65536;
__device__ __forceinline__ void hyena_phase(const LArgs& a, LAS unsigned char* lds) {
    const int tid0 = opaque_tid(), lane = tid0 & 63, wid = tid0 >> 6;
    LAS f32x2* X = (LAS f32x2*)lds; LAS float* red = (LAS float*)(lds + 131072);
    const _Float16* ZT = (const _Float16*)(a.ws + WS_OV); const _Float16* KT = (const _Float16*)a.out;
    bf16* YT = (bf16*)(a.ws + WS_H);
    f32x4* Hs = (f32x4*)(a.ws + WS_HYSCR + (size_t)blockIdx.x * HY_WG_BYTES); f32x4* Ys = Hs + 16384;
    const float* cw = a.in(I_OCW); const float* cb = a.in(I_OCB);
    for (int c = blockIdx.x; c < 2048; c += gridDim.x) {
        int tid = tid0; asm volatile("" : "+v"(tid));
        const float dkc = -__builtin_fabsf(MIN_DECAY_F + (float)c * ((MAX_DECAY_F - MIN_DECAY_F) / 2047.f)) * (1.4426950408889634f / 16383.f);
        for (int n = 0; n < 2; ++n) {
            const _Float16* fw = KT + (size_t)(n * 4096 + c) * SEQ; const _Float16* bw = KT + (size_t)(n * 4096 + 2048 + c) * SEQ;
            float l1 = 0.f;
            u32x4 rf[4], rb[4]; _Float16 rt[4];
#pragma unroll
            for (int j = 0; j < 4; ++j) { const int mm0 = 4 * (tid + NTHR * j); rf[j] = *(const u32x4*)(fw + 2 * mm0); rb[j] = *(const u32x4*)(bw + 16376 - 2 * mm0); rt[j] = bw[mm0 > 0 ? 16384 - 2 * mm0 : 16383]; }
#pragma unroll
            for (int j = 0; j < 4; ++j) {
                const int mm0 = 4 * (tid + NTHR * j);
                float e[8], cc[8]; h8_to_f(rf[j], e); h8_to_f(rb[j], cc);
                float top = mm0 > 0 ? (float)rt[j] : 0.f;
                {
                    const float tf = (float)(2 * mm0), tb = (float)(16376 - 2 * mm0);
#pragma unroll
                    for (int i = 0; i < 8; ++i) { e[i] *= __builtin_amdgcn_exp2f(dkc * (tf + (float)i)); cc[i] *= __builtin_amdgcn_exp2f(dkc * (tb + (float)i)); }
                    top *= __builtin_amdgcn_exp2f(dkc * (tb + 8.f));
                }
#pragma unroll
                for (int i = 0; i < 8; ++i) l1 += __builtin_fabsf(e[i]);
#pragma unroll
                for (int i = 1; i < 8; ++i) l1 += __builtin_fabsf(cc[i]);
                l1 += __builtin_fabsf(top);
                *(LAS f32x4*)(X + mm0) = (f32x4){e[0], e[1], e[2], e[3]}; *(LAS f32x4*)(X + mm0 + 2) = (f32x4){e[4], e[5], e[6], e[7]};
                *(LAS f32x4*)(X + 8192 + mm0) = (f32x4){top, cc[7], cc[6], cc[5]}; *(LAS f32x4*)(X + 8192 + mm0 + 2) = (f32x4){cc[4], cc[3], cc[2], cc[1]};
            }
            l1 = wave_sum(l1); if (lane == 0) red[wid] = l1;
            __syncthreads();
            float tot = 0.f;
#pragma unroll
            for (int w = 0; w < NWAVES; ++w) tot += red[w];
            fft_fwd(X, tid);
            pointwise_filter(X, Hs + n * 8192, 1.f / (16384.f * tot), tid);
        }
        const float w00 = cw[c], w01 = cw[HY_IN + c], w02 = cw[2 * HY_IN + c], b0 = cb[c];
        const float w10 = cw[2048 + c], w11 = cw[HY_IN + 2048 + c], w12 = cw[2 * HY_IN + 2048 + c], b1 = cb[2048 + c];
        const float w20 = cw[4096 + c], w21 = cw[HY_IN + 4096 + c], w22 = cw[2 * HY_IN + 4096 + c], b2 = cb[4096 + c];
        const float fb0 = a.in(I_FBIAS)[c], fb1 = a.in(I_FBIAS)[2048 + c];
        for (int b = 0; b < NB; ++b) {
            const _Float16* zv = ZT + (size_t)c * MLAT + b * SEQ; const _Float16* zx1 = ZT + (size_t)(2048 + c) * MLAT + b * SEQ; const _Float16* zx2 = ZT + (size_t)(4096 + c) * MLAT + b * SEQ;
            {
                Z10 zr[4];
#pragma unroll
                for (int j = 0; j < 4; ++j) zr[j] = sconv8_load(zv, 8 * (tid + NTHR * j));
#pragma unroll
                for (int j = 0; j < 4; ++j) { const int mm0 = 4 * (tid + NTHR * j); float y[8]; sconv8_calc(zr[j], 2 * mm0, w00, w01, w02, b0, y);
                    *(LAS f32x4*)(X + mm0) = (f32x4){y[0], y[1], y[2], y[3]}; *(LAS f32x4*)(X + mm0 + 2) = (f32x4){y[4], y[5], y[6], y[7]};
                    *(LAS f32x4*)(X + 8192 + mm0) = (f32x4){0.f, 0.f, 0.f, 0.f}; *(LAS f32x4*)(X + 8192 + mm0 + 2) = (f32x4){0.f, 0.f, 0.f, 0.f}; }
            }
            __syncthreads();
            fft_fwd(X, tid); pointwise_data(X, Hs, tid); fft_inv(X, tid);
            Z10 za[4], zb[4];
#pragma unroll
            for (int j = 0; j < 4; ++j) { za[j] = sconv8_load(zv, 8 * (tid + NTHR * j)); zb[j] = sconv8_load(zx1, 8 * (tid + NTHR * j)); }
#pragma unroll
            for (int j = 0; j < 4; ++j) { const int mm0 = 4 * (tid + NTHR * j); float y0[8], g[8]; sconv8_calc(za[j], 2 * mm0, w00, w01, w02, b0, y0); sconv8_calc(zb[j], 2 * mm0, w10, w11, w12, b1, g);
                const f32x4 r0 = *(const LAS f32x4*)(X + mm0), r1 = *(const LAS f32x4*)(X + mm0 + 2);
                const f32x4 o0 = (f32x4){g[0], g[1], g[2], g[3]} * (r0 + (f32x4){y0[0], y0[1], y0[2], y0[3]} * fb0), o1 = (f32x4){g[4], g[5], g[6], g[7]} * (r1 + (f32x4){y0[4], y0[5], y0[6], y0[7]} * fb0);
                *(LAS f32x4*)(X + mm0) = o0; *(LAS f32x4*)(X + mm0 + 2) = o1; Ys[mm0 / 2] = o0; Ys[mm0 / 2 + 1] = o1;
                *(LAS f32x4*)(X + 8192 + mm0) = (f32x4){0.f, 0.f, 0.f, 0.f}; *(LAS f32x4*)(X + 8192 + mm0 + 2) = (f32x4){0.f, 0.f, 0.f, 0.f}; }
            __syncthreads();
            fft_fwd(X, tid); pointwise_data(X, Hs + 8192, tid); fft_inv(X, tid);
#pragma unroll
            for (int j = 0; j < 4; ++j) za[j] = sconv8_load(zx2, 8 * (tid + NTHR * j));
            f32x4 qv[4][2];
#pragma unroll
            for (int j = 0; j < 4; ++j) { const int mm0 = 4 * (tid + NTHR * j); qv[j][0] = Ys[mm0 / 2]; qv[j][1] = Ys[mm0 / 2 + 1]; }
#pragma unroll
            for (int j = 0; j < 4; ++j) { const int mm0 = 4 * (tid + NTHR * j); float g[8]; sconv8_calc(za[j], 2 * mm0, w20, w21, w22, b2, g);
                const f32x4 r0 = *(const LAS f32x4*)(X + mm0), r1 = *(const LAS f32x4*)(X + mm0 + 2);
                const f32x4 o0 = (f32x4){g[0], g[1], g[2], g[3]} * (r0 + qv[j][0] * fb1), o1 = (f32x4){g[4], g[5], g[6], g[7]} * (r1 + qv[j][1] * fb1);
                u32x4 w; w.x = pk2(o0.x, o0.y); w.y = pk2(o0.z, o0.w); w.z = pk2(o1.x, o1.y); w.w = pk2(o1.z, o1.w);
                *(u32x4*)(YT + (size_t)c * MLAT + b * SEQ + 2 * mm0) = w; }
            __syncthreads();
        }
    }
}
__device__ __forceinline__ void transpose_phase(const LArgs& a, LAS unsigned char* lds) {
    const int tid = opaque_tid(), lane = tid & 63, wid = tid >> 6, gw = blockIdx.x * NWAVES + wid, NGW = gridDim.x * NWAVES;
    const bf16* YT = (const bf16*)(a.ws + WS_H); bf16* Y = (bf16*)(a.ws + WS_OV);
    LAS bf16* T = (LAS bf16*)(lds + wid * 16384);
    for (int it = gw; it < 32 * 512; it += NGW) {
        const int c0 = (it & 31) * 64, t0 = (it >> 5) * 64;
#pragma unroll
        for (int i = 0; i < 8; ++i) { const int ch = 8 * i + (lane >> 3), k = lane & 7; *(LAS u32x4*)(T + ch * 72 + 8 * k) = *(const u32x4*)(YT + (size_t)(c0 + ch) * MLAT + t0 + 8 * k); }
        asm volatile("s_waitcnt vmcnt(0) lgkmcnt(0)" ::: "memory");
#pragma unroll
        for (int i = 0; i < 8; ++i) { const int t = 8 * i + (lane >> 3), k = lane & 7; unsigned short e[8];
#pragma unroll
            for (int q = 0; q < 8; ++q) e[q] = T[(8 * k + q) * 72 + t];
            u32x4 w; w.x = e[0] | ((unsigned)e[1] << 16); w.y = e[2] | ((unsigned)e[3] << 16); w.z = e[4] | ((unsigned)e[5] << 16); w.w = e[6] | ((unsigned)e[7] << 16);
            *(u32x4*)(Y + (size_t)(t0 + t) * DM + c0 + 8 * k) = w; }
        asm volatile("s_waitcnt lgkmcnt(0)" ::: "memory");
    }
}

#define XB_TMO      128
#define XB_XCNT(j)  (256  + 64 * (j))
#define XB_XSUB(j)  (1280 + 64 * (j))
#define XB_XGEN(j)  (2304 + 64 * (j))
#define XB_TOP      3328
#define XB_TOPGEN   3392
#define XCD_BAR_WORDS 3456
#define XB_SPIN_CAP (1u << 18)

__device__ __forceinline__ unsigned xb_ld(unsigned* p)              { return __hip_atomic_load(p, __ATOMIC_RELAXED, __HIP_MEMORY_SCOPE_AGENT); }
__device__ __forceinline__ unsigned xb_add(unsigned* p, unsigned v) { return __hip_atomic_fetch_add(p, v, __ATOMIC_RELAXED, __HIP_MEMORY_SCOPE_AGENT); }
__device__ __forceinline__ unsigned xb_xcc_id() { return (unsigned)__builtin_amdgcn_s_getreg((3 << 11) | 20) & 0xFu; }
#define XB_SPIN(cond, bar) do { unsigned _sp = 0; while (cond) { __builtin_amdgcn_s_sleep(1); \
    if ((++_sp & 255u) == 0u) { if (xb_ld(&(bar)[XB_TMO])) break; if (_sp > XB_SPIN_CAP) { atomicAdd(&(bar)[XB_TMO], 1u); break; } } } } while (0)

struct XcdBarrier {
    unsigned* bar; unsigned x;
    volatile LAS unsigned* st;
};

__device__ __forceinline__ XcdBarrier xcd_barrier_post(unsigned* bar, volatile LAS unsigned* st) {
    XcdBarrier b; b.bar = bar; b.x = xb_xcc_id(); b.st = st;
    if (threadIdx.x == 0) (void)xb_add(&bar[XB_XCNT(b.x)], 1u);
    return b;
}
__device__ __forceinline__ void xcd_barrier_complete(unsigned* bar, unsigned x, unsigned& nloc, unsigned& nx) {
    const unsigned G = gridDim.x * gridDim.y * gridDim.z;
    unsigned sum, cnt, mine, sp = 0u;
    for (;;) {
        sum = 0u; cnt = 0u; mine = 0u;
#pragma unroll
        for (unsigned j = 0; j < 16; ++j) { const unsigned c = xb_ld(&bar[XB_XCNT(j)]); sum += c; cnt += (c > 0u) ? 1u : 0u; mine = (j == x) ? c : mine; }
        if (sum == G) break;
        __builtin_amdgcn_s_sleep(1);
        if ((++sp & 255u) == 0u) { if (xb_ld(&bar[XB_TMO])) break; if (sp > XB_SPIN_CAP) { atomicAdd(&bar[XB_TMO], 1u); break; } }
    }
    nloc = mine > 0u ? mine : 1u; nx = cnt > 0u ? cnt : 1u;
}

__device__ __forceinline__ void xcd_barrier(const XcdBarrier& b) {
    asm volatile("s_waitcnt vmcnt(0)" ::: "memory");
    __syncthreads();
    if (threadIdx.x == 0) {
        unsigned* bar = b.bar;
        __builtin_amdgcn_s_waitcnt(0);
        unsigned nloc = b.st[0], nx = b.st[1];
        if (nloc == 0u) { xcd_barrier_complete(bar, b.x, nloc, nx); b.st[0] = nloc; b.st[1] = nx; }
        const unsigned old = xb_add(&bar[XB_XSUB(b.x)], 1u);
        const unsigned gen = old / nloc;
        if (old + 1u == (gen + 1u) * nloc) {
            __builtin_amdgcn_fence(__ATOMIC_RELEASE, "agent");
            asm volatile("s_waitcnt vmcnt(0)" ::: "memory");
            const unsigned og = xb_add(&bar[XB_TOP], 1u);
            const unsigned tg = og / nx;
            if (og + 1u == (tg + 1u) * nx) xb_add(&bar[XB_TOPGEN], 1u);
            else XB_SPIN(xb_ld(&bar[XB_TOPGEN]) == tg, bar);
            __builtin_amdgcn_fence(__ATOMIC_ACQUIRE, "agent");
            xb_add(&bar[XB_XGEN(b.x)], 1u);
            asm volatile("s_waitcnt vmcnt(0)" ::: "memory");
        } else {
            XB_SPIN(xb_ld(&bar[XB_XGEN(b.x)]) == gen, bar);
            __builtin_amdgcn_fence(__ATOMIC_ACQUIRE, "agent");
            asm volatile("s_waitcnt vmcnt(0)" ::: "memory");
        }
    }
    __syncthreads();
}

constexpr size_t WS_BAR = 524288;
constexpr int XB_LDS_OFF = TAB_OFF + 512;
constexpr int N_PHASES = 20;
constexpr unsigned SYNC_AFTER = 0xFFFFFu & ~((1u << 2) | (1u << 3) | (1u << 5) | (1u << 19));
#ifndef PHSEL
#define PHSEL 0xfffff
#endif
#define PHON(k) ((PHSEL >> (k)) & 1)
__global__ void __launch_bounds__(NTHR, 2) mega_fwd(Args a_in) {
    extern __shared__ __attribute__((aligned(16))) unsigned char lds[];
    PG8_LAS unsigned char* ldsl = (PG8_LAS unsigned char*)lds;
    const int G = gridDim.x, cid = blockIdx.x;
    LAS unsigned long long* tab = (LAS unsigned long long*)(ldsl + TAB_OFF);
    if (threadIdx.x == 0) {
#pragma unroll
        for (int i = 0; i < 33; ++i) tab[i] = (unsigned long long)a_in.in[i];
        tab[33] = (unsigned long long)a_in.out; tab[34] = (unsigned long long)a_in.ws;
    }
    if (threadIdx.x == 0) { ((LAS unsigned*)(ldsl + XB_LDS_OFF))[0] = 0u; ((LAS unsigned*)(ldsl + XB_LDS_OFF))[1] = 0u; }
    __syncthreads();
    const int ph_lo = a_in.ph_lo, ph_hi = a_in.ph_hi;
    (void)xcd_barrier_post((unsigned*)(a_in.ws + WS_BAR), (volatile LAS unsigned*)(ldsl + XB_LDS_OFF));
#ifndef REPEAT_MASK
#define REPEAT_MASK 0
#endif
    for (int ph2 = 2 * ph_lo; ph2 < 2 * ph_hi; ++ph2) {
        const int ph = ph2 >> 1;
        if ((ph2 & 1) && !((REPEAT_MASK >> ph) & 1)) continue;
        const bool last_pass = (ph2 & 1) || !((REPEAT_MASK >> ph) & 1);
        unsigned tab_off = TAB_OFF; asm volatile("" : "+s"(tab_off) :: "memory");
        const LAS unsigned long long* tabl = (const LAS unsigned long long*)(ldsl + tab_off);
        const LArgs a{tabl, (float*)(__attribute__((address_space(1))) float*)tab_ld(tabl, 33), (unsigned char*)(__attribute__((address_space(1))) unsigned char*)tab_ld(tabl, 34)};
        unsigned char* ws = a.ws;
        const float* mods = (const float*)(ws + WS_MODS);
        const int layer = ph >= 11 ? 1 : 0;
        const float* modsL = mods + (size_t)layer * 3 * 12288;
        switch (ph) {
        case 0: if (PHON(0)) p0_prologue(a, ldsl); break;
        case 1: if (PHON(1)) prenorm_rows<0>(a, MALL, a.in(I_NORM1), modsL, 0, (bf16*)(ws + WS_H)); break;
        case 2: if (PHON(2)) {
            {
                pg8::Gemm g{(const bf16*)(ws + WS_H), (const bf16*)(ws + WS_WIN), MALL, 1024, 2048};
                pg8::EpiIn0 E; E.out0 = (bf16*)(ws + WS_K); E.grp_stride = 0; E.scale0 = 1.f; E.lat0 = MCTX;
                pg8::StaticOrder S; S.init(g.M, g.N, G, cid);
                pg8::gemm_phase<pg8::EpiIn0, pg8::StaticOrder, true, true>(ldsl, g, S, E);
            }
            {
                pg8::Gemm g{(const bf16*)(ws + WS_H) + (size_t)MCTX * DM, (const bf16*)(ws + WS_WIN) + (size_t)2048 * DM, MLAT, 3072, 2048};
                pg8::EpiIn0 E; E.out0 = (bf16*)(ws + WS_Q); E.grp_stride = (WS_U - WS_Q) / 2; E.scale0 = 0.125f * 1.4426950408889634f; E.lat0 = 0;
                pg8::StaticOrder S; S.init(g.M, g.N, G, cid);
                pg8::gemm_phase<pg8::EpiIn0, pg8::StaticOrder, true, true>(ldsl, g, S, E);
            }
        } break;
        case 3: if (PHON(3)) {
            pg8::Gemm g{(const bf16*)(ws + WS_WIN) + (size_t)1024 * DM, (const bf16*)(ws + WS_H), 1024, MALL, 2048}; pg8::EpiPlain16<0> E; E.O = (bf16*)(ws + WS_VT); E.ldc = MALL;
            pg8::StaticOrder S; S.init(g.M, g.N, G, (cid + G / 2) % G);
            pg8::gemm_phase<pg8::EpiPlain16<0>, pg8::StaticOrder, true, true>(ldsl, g, S, E);
        } break;
        case 4: if (PHON(4)) {
            pg8::Gemm g{(const bf16*)(ws + WS_W4X), (const bf16*)(ws + WS_H3X), 8192, SEQ, 256}; pg8::EpiPlain16<1> E; E.O = (bf16*)a.out; E.ldc = SEQ;
            pg8::StaticOrder S; S.init(g.M, g.N, G, cid);
            pg8::gemm_phase<pg8::EpiPlain16<1>, pg8::StaticOrder, true, true>(ldsl, g, S, E);
        } break;
        case 5: if (PHON(5)) attn_phase(a, ldsl); break;
        case 6: if (PHON(6)) sgu_phase(a, ldsl); break;
        case 7: case 10: case 15: case 18: if (PHON(7)) {
            pg8::Gemm g; pg8::EpiResid E; E.gate_bstride = 12288; E.out = (float*)(ws + WS_X);
            if (ph == 7) { g = pg8::Gemm{(const bf16*)(ws + WS_H), (const bf16*)(ws + WS_WOUT0), MLAT, 2048, 2048}; E.base = a.in(I_X); E.gate = modsL + 2 * 2048; }
            else if (ph == 15) { g = pg8::Gemm{(const bf16*)(ws + WS_OV), (const bf16*)(ws + WS_OOUT), MLAT, 2048, 2048}; E.base = (const float*)(ws + WS_X); E.gate = modsL + 2 * 2048; }
            else { g = pg8::Gemm{(const bf16*)(ws + WS_OV), (const bf16*)(ws + (layer ? WS_WD1 : WS_WD0)), MLAT, 2048, DFF}; E.base = (const float*)(ws + WS_X); E.gate = modsL + 5 * 2048; }
            pg8::StaticOrder S; S.init(g.M, g.N, G, cid);
            pg8::gemm_phase<pg8::EpiResid, pg8::StaticOrder, true, true>(ldsl, g, S, E);
        } break;
        case 8: case 16: if (PHON(8)) prenorm_rows<1>(a, MLAT, a.in(I_NORM2) + layer * DM, modsL, 3, (bf16*)(ws + WS_H)); break;
        case 9: case 17: if (PHON(9)) {
            pg8::Gemm g{(const bf16*)(ws + WS_H), (const bf16*)(ws + (layer ? WS_WGU1 : WS_WGU0)), MLAT, 2 * DFF, 2048}; pg8::EpiSwiglu E; E.O = (bf16*)(ws + WS_OV);
            pg8::StaticOrder S; S.init(g.M, g.N, G, cid);
            pg8::gemm_phase<pg8::EpiSwiglu, pg8::StaticOrder, true, true>(ldsl, g, S, E);
        } break;
        case 11: if (PHON(11)) prenorm_rows<1>(a, MLAT, a.in(I_NORM1) + DM, modsL, 0, (bf16*)(ws + WS_H)); break;
        case 12: if (PHON(12)) {
            pg8::Gemm g{(const bf16*)(ws + WS_OIN), (const bf16*)(ws + WS_H), HY_IN, MLAT, 2048}; pg8::EpiPlain16<1> E; E.O = (bf16*)(ws + WS_OV); E.ldc = MLAT;
            pg8::StaticOrder S; S.init(g.M, g.N, G, cid);
            pg8::gemm_phase<pg8::EpiPlain16<1>, pg8::StaticOrder, true, true>(ldsl, g, S, E);
        } break;
        case 13: if (PHON(13)) hyena_phase(a, ldsl); break;
        case 14: if (PHON(14)) transpose_phase(a, ldsl); break;
        case 19: if (PHON(19)) final_norm_rows(a); break;
        default: break;
        }
        if (ph + 1 < ph_hi && (((SYNC_AFTER >> ph) & 1u) || !last_pass)) { if (ph == 0) cg::this_grid().sync();
            else { XcdBarrier xb; xb.bar = (unsigned*)(a.ws + WS_BAR); xb.x = xb_xcc_id(); xb.st = (volatile LAS unsigned*)(ldsl + XB_LDS_OFF); xcd_barrier(xb); } }
        else if (ph + 1 < ph_hi) __syncthreads();
    }
}

extern "C" void kernel_launch(void* const* d_in, const int* in_sizes, int n_in, void* d_out, int out_size, void* d_ws, size_t ws_size, hipStream_t stream) {
    static int grid = 0;
    if (grid == 0) {
        if (n_in != 33 || out_size != MLAT * DM || ws_size < WS_END) { fprintf(stderr, "kernel_launch: unexpected shapes (n_in %d, out %d, ws %zu)\n", n_in, out_size, ws_size); grid = -1; return; }
        int dev = 0, cus = 0, per_cu = 0;
        hipGetDevice(&dev); hipDeviceGetAttribute(&cus, hipDeviceAttributeMultiprocessorCount, dev);
        hipFuncSetAttribute((const void*)mega_fwd, hipFuncAttributeMaxDynamicSharedMemorySize, LDS_BYTES);
        if (hipOccupancyMaxActiveBlocksPerMultiprocessor(&per_cu, (const void*)mega_fwd, NTHR, LDS_BYTES) != hipSuccess || per_cu < 1) per_cu = 1;
        (void)hipGetLastError();
        grid = cus * per_cu;
    }
    if (grid < 0) return;
    hipMemsetAsync(d_ws, 0, 1 * MiB, stream);
    Args a{};
    for (int i = 0; i < 33; ++i) a.in[i] = (const float*)d_in[i];
    a.out = (float*)d_out; a.ws = (unsigned char*)d_ws;
#if N_LAUNCH_MODE == 1
    a.ph_lo = 0; a.ph_hi = N_PHASES;
    void* args[] = {&a};
    hipError_t e = hipLaunchCooperativeKernel((const void*)mega_fwd, dim3(grid), dim3(NTHR), args, LDS_BYTES, stream);
    if (e != hipSuccess) fprintf(stderr, "cooperative launch failed: %s (grid %d)\n", hipGetErrorString(e), grid);
#else
    for (int ph = 0; ph < N_PHASES; ++ph) { a.ph_lo = ph; a.ph_hi = ph + 1; hipLaunchKernelGGL(mega_fwd, dim3(grid), dim3(NTHR), LDS_BYTES, stream, a); }
#endif
}
```

```cpp
#include <hip/hip_runtime.h>
#include <hip/hip_cooperative_groups.h>
#include <cstdio>
#include <cstdint>
namespace cg = cooperative_groups;
#ifndef N_LAUNCH_MODE
#define N_LAUNCH_MODE 1
#endif
constexpr int DM = 2048, SEQ = 16384, NB = 2, MLAT = NB * SEQ  , NCTX = 256, MCTX = NB * NCTX  , MALL = MLAT + MCTX  ;
constexpr int DFF = 5632, EVEN_IN = 5120, HY_IN = 6144;
constexpr float MIN_DECAY_F = -3.0701134573253945f, MAX_DECAY_F = -15.350567286626973f;
__device__ __forceinline__ int opaque_tid() { int t = threadIdx.x; asm volatile("" : "+v"(t)); return t; }
namespace pg8 {
#define PG8_LAS __attribute__((address_space(3)))
typedef unsigned short bf16_t;
typedef short bf16x8 __attribute__((ext_vector_type(8)));
typedef float f32x4 __attribute__((ext_vector_type(4)));
typedef unsigned u32x4 __attribute__((ext_vector_type(4)));
constexpr int BM = 256, BK = 64, HALF = 128, HTB = HALF * BK * 2  , STAGE_BYTES = 8 * HTB, NXCD = 8, WGM = 2;

__host__ __device__ __forceinline__ int lds_byte(int r, int c) { const int st = (r >> 4) * 2 + (c >> 5), rr = r & 15, cc = c & 31, ob = rr * 64 + cc * 2; return st * 1024 + (ob ^ (((ob >> 9) & 1) << 5)); }
__host__ __device__ __forceinline__ void stage_rc(int b, int& R, int& C) { const int st = b / 1024, sb = b % 1024, swz = sb ^ (((sb >> 9) & 1) << 5); R = (st >> 1) * 16 + swz / 64; C = (st & 1) * 32 + (swz % 64) / 2; }
__host__ __device__ __forceinline__ int perm32(int rho) { const int n = rho >> 4, i = rho & 15; return 8 * (i >> 2) + 4 * n + (i & 3); }

struct Unit { int pm, pn; };
struct Gemm { const bf16_t* A; const bf16_t* Bt; int M, N, K; };

struct StaticOrder {
    int nM, nN, nwg, G, c, wgm;
    __host__ __device__ void init(int M, int N, int G_, int c_, int wgm_ = WGM) { nM = M / BM; nN = N / BM; nwg = nM * nN; G = G_; c = c_; wgm = wgm_; }
    __host__ __device__ bool next(int i, Unit& u) const {
        const long L = (long)i * G + c; if (L >= nwg) return false;
        int wgid = (int)L; { const int q = nwg / NXCD, r = nwg % NXCD, xcd = wgid % NXCD, off = wgid / NXCD; wgid = (xcd < r ? xcd * (q + 1) : r * (q + 1) + (xcd - r) * q) + off; }
        const int nig = wgm * nN, gid = wgid / nig, fm = gid * wgm, gsz = (nM - fm) < wgm ? (nM - fm) : wgm;
        u.pm = fm + ((wgid % nig) % gsz); u.pn = (wgid % nig) / gsz; return true;
    }
    __device__ __forceinline__ void a_ready(const Unit&) const {}
    __device__ __forceinline__ void done(const Unit&) const {}
};

__device__ __forceinline__ unsigned cvt_pk_bf16(float lo, float hi) { unsigned r; asm volatile("v_cvt_pk_bf16_f32 %0, %1, %2" : "=v"(r) : "v"(lo), "v"(hi)); return r; }
typedef _Float16 f16x2_t __attribute__((ext_vector_type(2)));
typedef unsigned u32x2 __attribute__((ext_vector_type(2)));
__device__ __forceinline__ unsigned cvt_pk_f16(float lo, float hi) { unsigned r; asm volatile("v_cvt_pkrtz_f16_f32 %0, %1, %2" : "=v"(r) : "v"(lo), "v"(hi)); return r; }
__device__ __forceinline__ float gelu_tanh(float x) {
    const float y = 0.7978845608028654f * (x + 0.044715f * x * x * x);
    const float e = __builtin_amdgcn_exp2f(y * 2.8853900817779268f);
    const float t = 1.f - 2.f * __builtin_amdgcn_rcpf(1.f + e);
    return 0.5f * x * (1.f + t);
}
__device__ __forceinline__ float silu_f(float x) { return x * __builtin_amdgcn_rcpf(1.f + __builtin_amdgcn_exp2f(-x * 1.4426950408889634f)); }

template <int mode> struct EpiPlain16 {
    static constexpr bool PERM = true, AFTER_DRAIN = false;
    unsigned short* O; int ldc;
    __device__ __forceinline__ void operator()(const f32x4 (&acc)[2][2][4][2], const Unit& u, int wr, int wc, int fr, int fq) const {
        const int row0 = u.pm * BM + wr * 64 + fr, col0 = u.pn * BM + wc * 32 + 8 * fq;
#pragma unroll
        for (int ai = 0; ai < 2; ++ai)
#pragma unroll
            for (int m = 0; m < 4; ++m) {
                const int row = row0 + ai * HALF + m * 16; unsigned short* rowp = O + (size_t)row * ldc + col0;
                float dk = 0.f;
                if (mode == 2) { const int c = row & 2047; const float delta = __builtin_fabsf(MIN_DECAY_F + (float)c * ((MAX_DECAY_F - MIN_DECAY_F) / 2047.f)); dk = -delta * (1.4426950408889634f / 16383.f); }
#pragma unroll
                for (int bj = 0; bj < 2; ++bj) {
                    f32x4 v0 = acc[ai][bj][m][0], v1 = acc[ai][bj][m][1];
                    if (mode == 2) { const float t0 = (float)(col0 + bj * HALF);
#pragma unroll
                        for (int j = 0; j < 4; ++j) { v0[j] *= __builtin_amdgcn_exp2f(dk * (t0 + (float)j)); v1[j] *= __builtin_amdgcn_exp2f(dk * (t0 + (float)(4 + j))); } }
                    u32x4 w;
                    if (mode == 0) { w.x = cvt_pk_bf16(v0[0], v0[1]); w.y = cvt_pk_bf16(v0[2], v0[3]); w.z = cvt_pk_bf16(v1[0], v1[1]); w.w = cvt_pk_bf16(v1[2], v1[3]); }
                    else { w.x = cvt_pk_f16(v0[0], v0[1]); w.y = cvt_pk_f16(v0[2], v0[3]); w.z = cvt_pk_f16(v1[0], v1[1]); w.w = cvt_pk_f16(v1[2], v1[3]); }
                    *(u32x4*)(rowp + bj * HALF) = w;
                }
                asm volatile("" ::: "memory");
            }
    }
};
struct EpiIn0 {
    static constexpr bool PERM = false, AFTER_DRAIN = false;
    unsigned short* out0; size_t grp_stride; float scale0; int lat0;
    __device__ __forceinline__ void operator()(const f32x4 (&acc)[2][2][4][2], const Unit& u, int wr, int wc, int fr, int fq) const {
        const int grp = (u.pn * BM) >> 10, colt = (u.pn * BM) & 1023;
        unsigned short* base = out0 + (size_t)grp * grp_stride;
        const int kd = grp == 0 ? 0 : 2;
        const float sc = scale0;
        const int col0 = colt + wc * 32 + 4 * fq, row0 = u.pm * BM + wr * 64 + fr;
        if (kd == 0) {
            const bool lat = (u.pm * BM) >= lat0;
            float invrev[4];
#pragma unroll
            for (int j = 0; j < 4; ++j) invrev[j] = __builtin_amdgcn_exp2f(-(float)(4 * fq + j) * (13.287712379549449f / 16.f)) * 0.15915494309189535f;
#pragma unroll
            for (int ai = 0; ai < 2; ++ai)
#pragma unroll
                for (int m = 0; m < 4; ++m) {
                    const int row = row0 + ai * HALF + m * 16; const int t = (row - lat0) & 16383;
                    const float pos = (wc & 1) ? (float)(t & 63) : (float)(t >> 6);
                    float cs[4], sn[4];
#pragma unroll
                    for (int j = 0; j < 4; ++j) { const float r = __builtin_amdgcn_fractf(pos * invrev[j]); cs[j] = lat ? __builtin_amdgcn_cosf(r) : 1.f; sn[j] = lat ? __builtin_amdgcn_sinf(r) : 0.f; }
                    unsigned short* rowp = base + (size_t)row * 1024 + col0;
#pragma unroll
                    for (int bj = 0; bj < 2; ++bj) {
                        const f32x4 x1 = acc[ai][bj][m][0], x2 = acc[ai][bj][m][1]; float o1[4], o2[4];
#pragma unroll
                        for (int j = 0; j < 4; ++j) { o1[j] = (x1[j] * cs[j] - x2[j] * sn[j]) * sc; o2[j] = (x2[j] * cs[j] + x1[j] * sn[j]) * sc; }
                        u32x2 w1, w2; w1.x = cvt_pk_bf16(o1[0], o1[1]); w1.y = cvt_pk_bf16(o1[2], o1[3]); w2.x = cvt_pk_bf16(o2[0], o2[1]); w2.y = cvt_pk_bf16(o2[2], o2[3]);
                        *(u32x2*)(rowp + bj * HALF) = w1; *(u32x2*)(rowp + bj * HALF + 16) = w2;
                    }
                    asm volatile("" ::: "memory");
                }
        } else {
#pragma unroll
            for (int ai = 0; ai < 2; ++ai)
#pragma unroll
                for (int m = 0; m < 4; ++m) {
                    const int row = row0 + ai * HALF + m * 16; unsigned short* rowp = base + (size_t)row * 1024 + col0;
#pragma unroll
                    for (int bj = 0; bj < 2; ++bj)
#pragma unroll
                        for (int n = 0; n < 2; ++n) { const f32x4 v = acc[ai][bj][m][n]; u32x2 w; w.x = cvt_pk_bf16(gelu_tanh(v[0]), gelu_tanh(v[1])); w.y = cvt_pk_bf16(gelu_tanh(v[2]), gelu_tanh(v[3]));
                            *(u32x2*)(rowp + bj * HALF + n * 16) = w; }
                    asm volatile("" ::: "memory");
                }
        }
    }
};
struct EpiResid {
    static constexpr bool PERM = false, AFTER_DRAIN = false;
    const float* base; float* out; const float* gate; int gate_bstride;
    __device__ __forceinline__ void operator()(const f32x4 (&acc)[2][2][4][2], const Unit& u, int wr, int wc, int fr, int fq) const {
        const int col0 = u.pn * BM + wc * 32 + 4 * fq, row0 = u.pm * BM + wr * 64 + fr; const float* gp = gate + (size_t)((u.pm * BM) >> 14) * gate_bstride + col0;
        f32x4 gv[2][2];
#pragma unroll
        for (int bj = 0; bj < 2; ++bj)
#pragma unroll
            for (int n = 0; n < 2; ++n) gv[bj][n] = *(const f32x4*)(gp + bj * HALF + n * 16);
#pragma unroll
        for (int ai = 0; ai < 2; ++ai) {
            f32x4 bs[4][2][2];
#pragma unroll
            for (int m = 0; m < 4; ++m) { const size_t off = (size_t)(row0 + ai * HALF + m * 16) * 2048 + col0;
#pragma unroll
                for (int bj = 0; bj < 2; ++bj)
#pragma unroll
                    for (int n = 0; n < 2; ++n) bs[m][bj][n] = *(const f32x4*)(base + off + bj * HALF + n * 16); }
#pragma unroll
            for (int m = 0; m < 4; ++m) { const size_t off = (size_t)(row0 + ai * HALF + m * 16) * 2048 + col0;
#pragma unroll
                for (int bj = 0; bj < 2; ++bj)
#pragma unroll
                    for (int n = 0; n < 2; ++n) *(f32x4*)(out + off + bj * HALF + n * 16) = bs[m][bj][n] + gv[bj][n] * acc[ai][bj][m][n]; }
            asm volatile("" ::: "memory");
        }
    }
};
struct EpiSwiglu {
    static constexpr bool PERM = true, AFTER_DRAIN = false;
    unsigned short* O;
    __device__ __forceinline__ void operator()(const f32x4 (&acc)[2][2][4][2], const Unit& u, int wr, int wc, int fr, int fq) const {
        const int col0 = u.pn * HALF + wc * 32 + 8 * fq, row0 = u.pm * BM + wr * 64 + fr;
#pragma unroll
        for (int ai = 0; ai < 2; ++ai)
#pragma unroll
            for (int m = 0; m < 4; ++m) {
                float o[8];
#pragma unroll
                for (int n = 0; n < 2; ++n)
#pragma unroll
                    for (int j = 0; j < 4; ++j) o[4 * n + j] = silu_f(acc[ai][0][m][n][j]) * acc[ai][1][m][n][j];
                u32x4 w; w.x = cvt_pk_bf16(o[0], o[1]); w.y = cvt_pk_bf16(o[2], o[3]); w.z = cvt_pk_bf16(o[4], o[5]); w.w = cvt_pk_bf16(o[6], o[7]);
                *(u32x4*)(O + (size_t)(row0 + ai * HALF + m * 16) * DFF + col0) = w;
                asm volatile("" ::: "memory");
            }
    }
};
template <class Epi, class Sched, bool ALIGN_EPI = false, bool SP2 = false>
__device__ __forceinline__ void gemm_phase(PG8_LAS unsigned char* lds, const Gemm g, const Sched& S, const Epi& E) {
    const int tid = opaque_tid(), wid = __builtin_amdgcn_readfirstlane(tid >> 6), lane = tid & 63, wr = wid >> 2, wc = wid & 3, fr = lane & 15, fq = lane >> 4;
    const int K = g.K, nt = K / BK;
    unsigned voffA[2], voffB[2];
#pragma unroll
    for (int i = 0; i < 2; ++i) { int R, C; stage_rc(tid * 16 + i * 8192, R, C); const int Rb = Epi::PERM ? ((R & ~31) + perm32(R & 31)) : R;
        voffA[i] = (unsigned)(R * K + C) * 2u; voffB[i] = (unsigned)(Rb * K + C) * 2u; }
    const size_t kstep = (size_t)(BK * 2);
    const size_t hstep = (size_t)HALF * K * 2;
    const size_t tstep = 2 * hstep;
    const unsigned ldsw = (unsigned)wid * 1024u;
    const int aoff = lds_byte(wr * 64 + fr, fq * 8), boff = lds_byte(wc * 32 + fr, fq * 8);
#define PG8_SA(b, h) (((b) * 2 + (h)) * HTB)
#define PG8_SB(b, h) ((4 + (b) * 2 + (h)) * HTB)
#define PG8_STAGE(bufoff, gbase, voff) do { _Pragma("unroll") for (int _i = 0; _i < 2; ++_i) \
        __builtin_amdgcn_global_load_lds((const unsigned*)((const char*)(gbase) + (voff)[_i]), (PG8_LAS unsigned*)(lds + (bufoff) + ldsw + _i * 8192), 16, 0, 0); } while (0)
#define PG8_LDA(dst, b, h) do { _Pragma("unroll") for (int m = 0; m < 4; ++m) _Pragma("unroll") for (int k = 0; k < 2; ++k) dst[m][k] = *(const PG8_LAS bf16x8*)(lds + PG8_SA(b, h) + aoff + m * 2048 + k * 1024); } while (0)
#define PG8_LDB(dst, b, h) do { _Pragma("unroll") for (int n = 0; n < 2; ++n) _Pragma("unroll") for (int k = 0; k < 2; ++k) dst[n][k] = *(const PG8_LAS bf16x8*)(lds + PG8_SB(b, h) + boff + n * 2048 + k * 1024); } while (0)
#define PG8_MMA(ai, bj, At, Bt) do { __builtin_amdgcn_s_setprio(1); _Pragma("unroll") for (int m = 0; m < 4; ++m) _Pragma("unroll") for (int n = 0; n < 2; ++n) _Pragma("unroll") for (int k = 0; k < 2; ++k) \
        acc[ai][bj][m][n] = __builtin_amdgcn_mfma_f32_16x16x32_bf16(Bt[n][k], At[m][k], acc[ai][bj][m][n], 0, 0, 0); __builtin_amdgcn_s_setprio(0); } while (0)
#define PG8_WAIT_V(n) asm volatile("s_waitcnt vmcnt(" #n ")" ::: "memory")
#define PG8_WAIT_L(n) asm volatile("s_waitcnt lgkmcnt(" #n ")" ::: "memory")
#define PG8_BAR __builtin_amdgcn_s_barrier()
#define PG8_SCHED __builtin_amdgcn_sched_barrier(0)
    Unit cur, nxt; int ui = 0;
    if (!S.next(0, cur)) return;
    f32x4 acc[2][2][4][2];
#pragma unroll
    for (int a = 0; a < 2; ++a)
#pragma unroll
        for (int b = 0; b < 2; ++b)
#pragma unroll
            for (int m = 0; m < 4; ++m)
#pragma unroll
                for (int n = 0; n < 2; ++n) acc[a][b][m][n] = (f32x4){0.f, 0.f, 0.f, 0.f};
    bf16x8 At[4][2], B0[2][2], B1[2][2];
    const char* cA = (const char*)g.A + (size_t)cur.pm * tstep; const char* cB = (const char*)g.Bt + (size_t)cur.pn * tstep;
    S.a_ready(cur);
    if constexpr (SP2) {
        PG8_STAGE(PG8_SB(0, 0), cB, voffB); PG8_STAGE(PG8_SB(0, 1), cB + hstep, voffB); PG8_STAGE(PG8_SA(0, 0), cA, voffA); PG8_STAGE(PG8_SA(0, 1), cA + hstep, voffA);
        if (wr == 1) PG8_BAR;
        PG8_WAIT_V(2); PG8_BAR;
        PG8_STAGE(PG8_SB(1, 0), cB + kstep, voffB); PG8_STAGE(PG8_SA(1, 0), cA + kstep, voffA); PG8_STAGE(PG8_SB(1, 1), cB + hstep + kstep, voffB);
        PG8_WAIT_V(6); PG8_BAR;
    } else {
        PG8_STAGE(PG8_SB(0, 0), cB, voffB); PG8_STAGE(PG8_SA(0, 0), cA, voffA); PG8_STAGE(PG8_SB(0, 1), cB + hstep, voffB); PG8_STAGE(PG8_SA(0, 1), cA + hstep, voffA);
        if (wr == 1) PG8_BAR;
        PG8_WAIT_V(4); PG8_BAR;
        PG8_STAGE(PG8_SB(1, 0), cB + kstep, voffB); PG8_STAGE(PG8_SA(1, 0), cA + kstep, voffA); PG8_STAGE(PG8_SB(1, 1), cB + hstep + kstep, voffB);
        PG8_WAIT_V(6); PG8_BAR;
    }
    for (;;) {
        const bool has_next = S.next(ui + 1, nxt);
        const char* nA = has_next ? (const char*)g.A + (size_t)nxt.pm * tstep : cA; const char* nB = has_next ? (const char*)g.Bt + (size_t)nxt.pn * tstep : cB;
        for (int t = 0; t < nt; t += 2) {
            const bool last = (t == nt - 2);
            const char* a1 = cA + (size_t)(t + 1) * kstep;
            const char* a2 = last ? nA : cA + (size_t)(t + 2) * kstep; const char* b2 = last ? nB : cB + (size_t)(t + 2) * kstep;
            const char* a3 = a2 + kstep; const char* b3 = b2 + kstep;
            if (last && has_next) S.a_ready(nxt);
            if constexpr (SP2) {
            PG8_LDB(B0, 0, 0); PG8_LDB(B1, 0, 1); PG8_SCHED; PG8_LDA(At, 0, 0); PG8_STAGE(PG8_SA(1, 1), a1 + hstep, voffA);
            PG8_WAIT_V(8); PG8_WAIT_L(0); PG8_BAR; PG8_MMA(0, 0, At, B0); PG8_MMA(0, 1, At, B1); PG8_BAR; PG8_SCHED;
            PG8_LDA(At, 0, 1); PG8_STAGE(PG8_SB(0, 0), b2, voffB); PG8_STAGE(PG8_SB(0, 1), b2 + hstep, voffB); PG8_STAGE(PG8_SA(0, 0), a2, voffA);
            PG8_WAIT_V(8); PG8_WAIT_L(0); PG8_BAR; PG8_MMA(1, 0, At, B0); PG8_MMA(1, 1, At, B1); PG8_BAR; PG8_SCHED;
            PG8_LDB(B0, 1, 0); PG8_LDB(B1, 1, 1); PG8_SCHED; PG8_LDA(At, 1, 0); PG8_STAGE(PG8_SA(0, 1), a2 + hstep, voffA);
            PG8_WAIT_V(8); PG8_WAIT_L(0); PG8_BAR; PG8_MMA(0, 0, At, B0); PG8_MMA(0, 1, At, B1); PG8_BAR; PG8_SCHED;
            PG8_LDA(At, 1, 1); PG8_STAGE(PG8_SB(1, 0), b3, voffB); PG8_STAGE(PG8_SB(1, 1), b3 + hstep, voffB); PG8_STAGE(PG8_SA(1, 0), a3, voffA);
            PG8_WAIT_V(8); PG8_WAIT_L(0); PG8_BAR; PG8_MMA(1, 0, At, B0); PG8_MMA(1, 1, At, B1); PG8_BAR; PG8_SCHED;
            } else {
            PG8_LDB(B0, 0, 0); PG8_SCHED; PG8_LDA(At, 0, 0); PG8_STAGE(PG8_SA(1, 1), a1 + hstep, voffA);
            PG8_WAIT_L(8); PG8_BAR; PG8_WAIT_L(0); PG8_MMA(0, 0, At, B0); PG8_BAR; PG8_SCHED;
            PG8_LDB(B1, 0, 1); PG8_STAGE(PG8_SB(0, 0), b2, voffB);
            PG8_BAR; PG8_WAIT_L(0); PG8_MMA(0, 1, At, B1); PG8_BAR;
            PG8_LDA(At, 0, 1); PG8_STAGE(PG8_SA(0, 0), a2, voffA);
            PG8_BAR; PG8_WAIT_L(0); PG8_MMA(1, 0, At, B0); PG8_BAR; PG8_SCHED;
            PG8_STAGE(PG8_SB(0, 1), b2 + hstep, voffB);
            PG8_WAIT_V(6); PG8_BAR; PG8_MMA(1, 1, At, B1); PG8_BAR;
            PG8_LDB(B0, 1, 0); PG8_SCHED; PG8_LDA(At, 1, 0); PG8_STAGE(PG8_SA(0, 1), a2 + hstep, voffA);
            PG8_WAIT_L(8); PG8_BAR; PG8_WAIT_L(0); PG8_MMA(0, 0, At, B0); PG8_BAR; PG8_SCHED;
            PG8_LDB(B1, 1, 1); PG8_STAGE(PG8_SB(1, 0), b3, voffB);
            PG8_BAR; PG8_WAIT_L(0); PG8_MMA(0, 1, At, B1); PG8_BAR;
            PG8_LDA(At, 1, 1); PG8_STAGE(PG8_SA(1, 0), a3, voffA);
            PG8_BAR; PG8_WAIT_L(0); PG8_MMA(1, 0, At, B0); PG8_BAR; PG8_SCHED;
            PG8_STAGE(PG8_SB(1, 1), b3 + hstep, voffB);
            PG8_WAIT_V(6); PG8_BAR; PG8_MMA(1, 1, At, B1); PG8_BAR;
            }
        }
        if constexpr (ALIGN_EPI) { if (wr == 0) PG8_BAR; }
        if constexpr (!Epi::AFTER_DRAIN) { E(acc, cur, wr, wc, fr, fq); S.done(cur); }
        if (!has_next) break;
#pragma unroll
        for (int a = 0; a < 2; ++a)
#pragma unroll
            for (int b = 0; b < 2; ++b)
#pragma unroll
                for (int m = 0; m < 4; ++m)
#pragma unroll
                    for (int n = 0; n < 2; ++n) acc[a][b][m][n] = (f32x4){0.f, 0.f, 0.f, 0.f};
        cur = nxt; cA = nA; cB = nB; ++ui;
        if constexpr (ALIGN_EPI) { if (wr == 1) PG8_BAR; }
    }
    PG8_WAIT_V(0);
    if constexpr (!ALIGN_EPI) { if (wr == 0) PG8_BAR; }
    PG8_BAR;
    if constexpr (Epi::AFTER_DRAIN) { E.fused(acc, cur, wr, wc, fr, fq, lds, wid, lane); S.done(cur); }
#undef PG8_SA
#undef PG8_SB
#undef PG8_STAGE
#undef PG8_LDA
#undef PG8_LDB
#undef PG8_MMA
#undef PG8_WAIT_V
#undef PG8_WAIT_L
#undef PG8_BAR
#undef PG8_SCHED
}
}
#define LAS __attribute__((address_space(3)))
typedef unsigned short bf16;
typedef float f32x4 __attribute__((ext_vector_type(4)));
typedef float f32x2 __attribute__((ext_vector_type(2)));
typedef float f32x16 __attribute__((ext_vector_type(16)));
typedef short bf16x8 __attribute__((ext_vector_type(8)));
typedef unsigned u32x4 __attribute__((ext_vector_type(4)));
typedef unsigned u32x2 __attribute__((ext_vector_type(2)));
typedef _Float16 f16x2 __attribute__((ext_vector_type(2)));
constexpr int NWAVES = 8, NTHR = 512;
constexpr int LDS_BYTES = 147456;
constexpr size_t MiB = 1u << 20;
constexpr size_t WS_MODS = 0;
constexpr size_t WS_H3X = 1 * MiB;
constexpr size_t WS_W4X = 9 * MiB;
constexpr size_t WS_WIN = 16 * MiB;
constexpr size_t WS_WOUT0 = 36 * MiB;
constexpr size_t WS_WGU0 = 44 * MiB;
constexpr size_t WS_WD0 = 88 * MiB;
constexpr size_t WS_HYSCR = 16 * MiB;
constexpr size_t WS_OIN = 110 * MiB;
constexpr size_t WS_OOUT = 134 * MiB;
constexpr size_t WS_WGU1 = 142 * MiB;
constexpr size_t WS_WD1 = 186 * MiB;
constexpr size_t WS_X = 208 * MiB;
constexpr size_t WS_H = 464 * MiB;
constexpr size_t WS_OV = 594 * MiB;
constexpr size_t WS_K = WS_OV, WS_VT = WS_OV + 65 * MiB, WS_Q = WS_OV + 130 * MiB, WS_U = WS_OV + 194 * MiB, WS_G = WS_OV + 258 * MiB;
constexpr size_t WS_END = 978 * MiB;
static_assert(WS_U - WS_Q == WS_G - WS_U, "Q/U/G equally spaced");

struct Args { const float* in[33]; float* out; unsigned char* ws; int ph_lo, ph_hi; };
constexpr int TAB_OFF = 143360;
__device__ __forceinline__ unsigned long long tab_ld(const LAS unsigned long long* tab, int i) {
    const unsigned long long v = tab[i]; const unsigned lo = __builtin_amdgcn_readfirstlane((unsigned)v), hi = __builtin_amdgcn_readfirstlane((unsigned)(v >> 32));
    return ((unsigned long long)hi << 32) | lo; }
struct LArgs { const LAS unsigned long long* tab; float* out; unsigned char* ws;
    __device__ __forceinline__ const float* in(int i) const { return (const float*)(const __attribute__((address_space(1))) float*)tab_ld(tab, i); } };
enum { I_X = 0, I_C, I_CTX, I_CCTX, I_ADAW, I_ADAB, I_NORM1, I_NORM2, I_FG, I_FU, I_FD, I_EWIN, I_EWOUT, I_ELAM, I_ESUBLN, I_ESNG, I_ESNB, I_ESW, I_ESB,
       I_OWIN, I_OCW, I_OCB, I_FW1, I_FB1, I_FW2, I_FB2, I_FW3, I_FB3, I_FFREQ, I_FW4, I_FBIAS, I_OWOUT, I_FNORM };

template <int O> __device__ __forceinline__ float swz_xor(float v) { return __builtin_bit_cast(float, __builtin_amdgcn_ds_swizzle(__builtin_bit_cast(int, v), (O << 10) | 0x1f)); }
__device__ __forceinline__ float xor32_get(float v, int xaddr) { return __builtin_bit_cast(float, __builtin_amdgcn_ds_bpermute(xaddr, __builtin_bit_cast(int, v))); }
__device__ __forceinline__ float wave_sum(float v) {
    v += swz_xor<1>(v); v += swz_xor<2>(v); v += swz_xor<4>(v); v += swz_xor<8>(v); v += swz_xor<16>(v);
    return __builtin_bit_cast(float, __builtin_amdgcn_readlane(__builtin_bit_cast(int, v), 0)) + __builtin_bit_cast(float, __builtin_amdgcn_readlane(__builtin_bit_cast(int, v), 32));
}
__device__ __forceinline__ unsigned f2bf(float f) { unsigned u = __builtin_bit_cast(unsigned, f); return (u + 0x7fffu + ((u >> 16) & 1u)) >> 16; }
__device__ __forceinline__ unsigned pk2(float lo, float hi) { return f2bf(lo) | (f2bf(hi) << 16); }
__device__ __forceinline__ float bf2f(unsigned h) { return __builtin_bit_cast(float, h << 16); }
__device__ __forceinline__ f32x2 cmul(f32x2 a, f32x2 b) { const f32x2 ar = {-a.y, a.x}; return ar * b.y + a * b.x; }

__device__ __forceinline__ void transpose_item(const float* W, int K, int N, bf16* WT, int dst_row0, LAS float* scr, int k0, int n0, int lane) {
#pragma unroll 8
    for (int i = 0; i < 32; ++i) { const int kk = 2 * i + (lane >> 5); scr[kk * 33 + (lane & 31)] = W[(size_t)(k0 + kk) * N + n0 + (lane & 31)]; }
    asm volatile("s_waitcnt vmcnt(0) lgkmcnt(0)" ::: "memory");
    const int c = lane & 7;
#pragma unroll
    for (int j = 0; j < 4; ++j) { const int n = (lane >> 3) + 8 * j; const LAS float* s = scr + (8 * c) * 33 + n;
        u32x4 o; o.x = pk2(s[0 * 33], s[1 * 33]); o.y = pk2(s[2 * 33], s[3 * 33]); o.z = pk2(s[4 * 33], s[5 * 33]); o.w = pk2(s[6 * 33], s[7 * 33]);
        *(u32x4*)(WT + (size_t)(dst_row0 + n) * K + k0 + 8 * c) = o; }
    asm volatile("s_waitcnt lgkmcnt(0)" ::: "memory");
}
template <int MAP> __device__ __forceinline__ void transpose_matrix(const float* W, int K, int N, bf16* WT, LAS float* scr, int gw, int NGW, int lane) {
    const int nblk = N / 32, nitems = (K / 64) * nblk;
    for (int it = gw; it < nitems; it += NGW) {
        const int kb = it / nblk, nb = it % nblk, n0 = nb * 32; int d = n0;
        if (MAP == 1) d = n0 < 1024 ? n0 + 2048 : (n0 < 3072 ? n0 - 1024 : n0);
        if (MAP == 2) d = 256 * (n0 >> 7) + (n0 & 127);
        if (MAP == 3) d = 256 * (n0 >> 7) + 128 + (n0 & 127);
        transpose_item(W, K, N, WT, d, scr, kb * 64, n0, lane);
    }
}
__device__ __forceinline__ void p0_prologue(const LArgs& a, LAS unsigned char* lds) {
    const int tid = opaque_tid(), lane = tid & 63, wid = tid >> 6;
    const int gw = blockIdx.x * NWAVES + wid, NGW = gridDim.x * NWAVES;
    unsigned char* ws = a.ws;
    LAS float* scr = (LAS float*)(lds + wid * 16384);
    {
        float* mods = (float*)(ws + WS_MODS);
        for (int it = gw; it < 3072; it += NGW) {
            const int layer = it / 1536, r = it % 1536, cc = r >> 3, kc = r & 7, col = cc * 64 + lane;
            const float* w = a.in(I_ADAW) + (size_t)layer * 2048 * 12288 + (size_t)(kc * 256) * 12288 + col;
            const float* c0 = a.in(I_C) + kc * 256; const float* c1 = c0 + 2048; const float* c2 = a.in(I_CCTX) + kc * 256;
            float a0 = 0.f, a1 = 0.f, a2 = 0.f;
#pragma unroll 8
            for (int k = 0; k < 256; ++k) { const float wv = w[(size_t)k * 12288]; a0 += pg8::silu_f(c0[k]) * wv; a1 += pg8::silu_f(c1[k]) * wv; a2 += pg8::silu_f(c2[k]) * wv; }
            if (kc == 0) { const float bb = a.in(I_ADAB)[layer * 12288 + col]; a0 += bb; a1 += bb; a2 += bb; }
            float* m = mods + (size_t)layer * 3 * 12288 + col;
            atomicAdd(m, a0); atomicAdd(m + 12288, a1); atomicAdd(m + 2 * 12288, a2);
        }
    }
    transpose_matrix<1>(a.in(I_EWIN), 2048, EVEN_IN, (bf16*)(ws + WS_WIN), scr, gw, NGW, lane);
    transpose_matrix<0>(a.in(I_EWOUT), 2048, 2048, (bf16*)(ws + WS_WOUT0), scr, gw, NGW, lane);
    transpose_matrix<0>(a.in(I_OWIN), 2048, HY_IN, (bf16*)(ws + WS_OIN), scr, gw, NGW, lane);
    transpose_matrix<0>(a.in(I_OWOUT), 2048, 2048, (bf16*)(ws + WS_OOUT), scr, gw, NGW, lane);
    for (int l = 0; l < 2; ++l) {
        bf16* gu = (bf16*)(ws + (l ? WS_WGU1 : WS_WGU0)); bf16* dn = (bf16*)(ws + (l ? WS_WD1 : WS_WD0));
        transpose_matrix<2>(a.in(I_FG) + (size_t)l * 2048 * DFF, 2048, DFF, gu, scr, gw, NGW, lane);
        transpose_matrix<3>(a.in(I_FU) + (size_t)l * 2048 * DFF, 2048, DFF, gu, scr, gw, NGW, lane);
        transpose_matrix<0>(a.in(I_FD) + (size_t)l * 2048 * DFF, DFF, 2048, dn, scr, gw, NGW, lane);
    }
    {
        bf16* W4X = (bf16*)(ws + WS_W4X); const float* w4 = a.in(I_FW4);
        for (int e = blockIdx.x * NTHR + tid; e < 64 * 8192; e += gridDim.x * NTHR) {
            const int k = e >> 13, col = e & 8191; const float w = w4[e]; const unsigned hi = f2bf(w); const unsigned lo = f2bf(w - bf2f(hi));
            bf16* o = W4X + (size_t)col * 256 + k; o[0] = (bf16)hi; o[64] = (bf16)hi; o[128] = (bf16)lo; o[192] = (bf16)lo;
        }
    }
    {
        bf16* H3X = (bf16*)(ws + WS_H3X);
        const float* w1 = a.in(I_FW1); const float* w2 = a.in(I_FW2); const float* w3 = a.in(I_FW3);
        const float b1 = a.in(I_FB1)[lane], b2 = a.in(I_FB2)[lane], b3 = a.in(I_FB3)[lane];
        const float fr0 = a.in(I_FFREQ)[lane] * 0.15915494309189535f, fr1 = a.in(I_FFREQ)[64 + lane] * 0.15915494309189535f, fr2 = a.in(I_FFREQ)[128 + lane] * 0.15915494309189535f;
        float w1c[33], w2c[64], w3c[64];
#pragma unroll
        for (int f = 0; f < 33; ++f) w1c[f] = w1[f * 64 + lane];
#pragma unroll
        for (int k = 0; k < 64; ++k) { w2c[k] = w2[k * 64 + lane]; w3c[k] = w3[k * 64 + lane]; }
        for (int pos = gw; pos < SEQ; pos += NGW) {
            float feat = 0.f;
            { const int bidx = (lane >= 17) ? lane - 17 : lane - 1; const float fb = 1e-4f + (float)(bidx < 0 ? 0 : bidx) * ((15.f - 1e-4f) / 15.f);
              double rv = (double)fb * (double)pos * (1.0 / 16384.0); rv -= __builtin_floor(rv); const float rf = (float)rv;
              if (lane == 0) feat = (float)pos * (1.f / 16383.f); else if (lane <= 16) feat = __builtin_amdgcn_cosf(rf); else if (lane <= 32) feat = -__builtin_amdgcn_sinf(rf); }
            float acc = b1;
#pragma unroll
            for (int f = 0; f < 33; ++f) acc += __builtin_bit_cast(float, __builtin_amdgcn_readlane(__builtin_bit_cast(int, feat), f)) * w1c[f];
            float h = __builtin_amdgcn_sinf(__builtin_amdgcn_fractf(fr0 * acc));
            acc = b2;
#pragma unroll
            for (int k = 0; k < 64; ++k) acc += __builtin_bit_cast(float, __builtin_amdgcn_readlane(__builtin_bit_cast(int, h), k)) * w2c[k];
            h = __builtin_amdgcn_sinf(__builtin_amdgcn_fractf(fr1 * acc));
            acc = b3;
#pragma unroll
            for (int k = 0; k < 64; ++k) acc += __builtin_bit_cast(float, __builtin_amdgcn_readlane(__builtin_bit_cast(int, h), k)) * w3c[k];
            h = __builtin_amdgcn_sinf(__builtin_amdgcn_fractf(fr2 * acc));
            const unsigned hi = f2bf(h), lo = f2bf(h - bf2f(hi));
            bf16* o = H3X + (size_t)pos * 256 + lane; o[0] = (bf16)hi; o[64] = (bf16)lo; o[128] = (bf16)hi; o[192] = (bf16)lo;
        }
    }
}

template <int SRC> __device__ __forceinline__ void prenorm_rows(const LArgs& a, int nrows, const float* nw, const float* mods_layer, int shift_part, bf16* dst) {
    const int tid = opaque_tid(), lane = tid & 63, wid = tid >> 6, gw = blockIdx.x * NWAVES + wid, NGW = gridDim.x * NWAVES;
    for (int chunk = gw; chunk < nrows / 16; chunk += NGW) {
        const int row0 = chunk * 16; const float* src0; int cond;
        if (SRC == 0) { if (row0 < MCTX) { src0 = a.in(I_CTX) + (size_t)row0 * DM; cond = 2; } else { src0 = a.in(I_X) + (size_t)(row0 - MCTX) * DM; cond = (row0 - MCTX) >> 14; } }
        else { src0 = (const float*)(a.ws + WS_X) + (size_t)row0 * DM; cond = row0 >> 14; }
        const float* sh = mods_layer + (size_t)cond * 12288 + shift_part * 2048; const float* sc = sh + 2048;
        f32x4 cs[8], sv[8];
#pragma unroll
        for (int j = 0; j < 8; ++j) { const int col = 4 * lane + 256 * j; cs[j] = *(const f32x4*)(nw + col) * (*(const f32x4*)(sc + col) + 1.f); sv[j] = *(const f32x4*)(sh + col); }
#pragma unroll 2
        for (int r = 0; r < 16; ++r) {
            const float* src = src0 + (size_t)r * DM; f32x4 v[8]; float ss = 0.f;
#pragma unroll
            for (int j = 0; j < 8; ++j) { v[j] = *(const f32x4*)(src + 4 * lane + 256 * j); ss += (v[j].x * v[j].x + v[j].y * v[j].y) + (v[j].z * v[j].z + v[j].w * v[j].w); }
            const float rn = 1.f / sqrtf(wave_sum(ss) * (1.f / DM) + 1e-6f);
#pragma unroll
            for (int j = 0; j < 8; ++j) { const int col = 4 * lane + 256 * j; const f32x4 o = v[j] * rn * cs[j] + sv[j]; u32x2 pq; pq.x = pk2(o.x, o.y); pq.y = pk2(o.z, o.w); *(u32x2*)(dst + (size_t)(row0 + r) * DM + col) = pq; }
        }
    }
}
__device__ __forceinline__ void final_norm_rows(const LArgs& a) {
    const int tid = opaque_tid(), lane = tid & 63, wid = tid >> 6, gw = blockIdx.x * NWAVES + wid, NGW = gridDim.x * NWAVES;
    const float* nw = a.in(I_FNORM);
    f32x4 cs[8];
#pragma unroll
    for (int j = 0; j < 8; ++j) cs[j] = *(const f32x4*)(nw + 4 * lane + 256 * j);
    for (int chunk = gw; chunk < MLAT / 16; chunk += NGW) {
#pragma unroll 2
        for (int r = 0; r < 16; ++r) {
            const int row = chunk * 16 + r; const float* src = (const float*)(a.ws + WS_X) + (size_t)row * DM; f32x4 v[8]; float ss = 0.f;
#pragma unroll
            for (int j = 0; j < 8; ++j) { v[j] = *(const f32x4*)(src + 4 * lane + 256 * j); ss += (v[j].x * v[j].x + v[j].y * v[j].y) + (v[j].z * v[j].z + v[j].w * v[j].w); }
            const float rn = 1.f / sqrtf(wave_sum(ss) * (1.f / DM) + 1e-6f);
#pragma unroll
            for (int j = 0; j < 8; ++j) { const int col = 4 * lane + 256 * j; *(f32x4*)(a.out + (size_t)row * DM + col) = v[j] * rn * cs[j]; }
        }
    }
}

__device__ __forceinline__ void attn_phase(const LArgs& a, LAS unsigned char* lds) {
    const int tid = opaque_tid(), lane = tid & 63, wid = tid >> 6, pr = wid >> 1, mp = wid & 1, r32 = lane & 31, hi = lane >> 5;
    const bf16* Qg = (const bf16*)(a.ws + WS_Q); const bf16* Kg = (const bf16*)(a.ws + WS_K); const bf16* Vt = (const bf16*)(a.ws + WS_VT);
    bf16* act = (bf16*)(a.ws + WS_H);
    float lam;
    { const float* lp = a.in(I_ELAM); const float v = wave_sum(lp[lane] * lp[64 + lane]), w = wave_sum(lp[128 + lane] * lp[192 + lane]); lam = __expf(v) - __expf(w) + 0.2f; }
    constexpr int KROW = 272, VROW = 144, KBUF = 64 * KROW, VBUF = 128 * VROW, NT = 260;
    const int xaddr = (lane ^ 32) << 2;
    const int kappa = (r32 & 16) | ((r32 & 4) << 1) | ((r32 & 8) >> 1) | (r32 & 3);
    const int krow_t = tid >> 4, kch = tid & 15, vrow_t = tid >> 3, vch = tid & 7;
    const float* subln = a.in(I_ESUBLN);
    for (int u = blockIdx.x; u < 2048; u += gridDim.x) {
        const int bh = u >> 7, qb = u & 127, b = bh >> 3, h = bh & 7;
        const bf16* Qp = Qg + (size_t)(b * SEQ + qb * 128 + pr * 32 + r32) * 1024 + h * 128 + mp * 64 + hi * 8;
        bf16x8 qf[4];
#pragma unroll
        for (int ks = 0; ks < 4; ++ks) qf[ks] = *(const bf16x8*)(Qp + ks * 16);
        f32x16 o[4];
#pragma unroll
        for (int d = 0; d < 4; ++d)
#pragma unroll
            for (int r = 0; r < 16; ++r) o[d][r] = 0.f;
        float mrun = -1e30f, lrun = 0.f;
        const bf16* kgp = Kg + (size_t)krow_t * 1024 + h * 128 + kch * 8;
        const bf16* vgp = Vt + (size_t)(h * 128 + vrow_t) * MALL + vch * 8;
        u32x4 kreg[2], vreg[2];
#define ATT_LOAD(j) do { const int kb0_ = (j) < 4 ? b * NCTX + (j) * 64 : MCTX + b * SEQ + ((j) - 4) * 64; \
            kreg[0] = *(const u32x4*)(kgp + (size_t)kb0_ * 1024); kreg[1] = *(const u32x4*)(kgp + (size_t)(kb0_ + 32) * 1024); \
            vreg[0] = *(const u32x4*)(vgp + kb0_); vreg[1] = *(const u32x4*)(vgp + (size_t)64 * MALL + kb0_); } while (0)
#define ATT_STORE(kbuf, vbuf) do { LAS unsigned char* kb_ = lds + (kbuf) * KBUF; LAS unsigned char* vb_ = lds + 2 * KBUF + (vbuf) * VBUF; \
            *(LAS u32x4*)(kb_ + krow_t * KROW + kch * 16) = kreg[0]; *(LAS u32x4*)(kb_ + (krow_t + 32) * KROW + kch * 16) = kreg[1]; \
            *(LAS u32x4*)(vb_ + vrow_t * VROW + vch * 16) = vreg[0]; *(LAS u32x4*)(vb_ + (vrow_t + 64) * VROW + vch * 16) = vreg[1]; } while (0)
#define ATT_VRD(DST, vb_, kstep) do { _Pragma("unroll") for (int d = 0; d < 4; ++d) DST[d] = *(const LAS bf16x8*)((vb_) + (32 * d + r32) * VROW + (kstep) * 32 + hi * 16); } while (0)
#define ATT_VMM(SRC, kstep) do { const bf16x8 pf = __builtin_bit_cast(bf16x8, pw[kstep]); _Pragma("unroll") for (int d = 0; d < 4; ++d) o[d] = __builtin_amdgcn_mfma_f32_32x32x16_bf16(SRC[d], pf, o[d], 0, 0, 0); } while (0)
#define ATT_PV_PRE(vbuf) do { const LAS unsigned char* vb_ = lds + 2 * KBUF + (vbuf) * VBUF; ATT_VRD(vfa, vb_, 0); __builtin_amdgcn_sched_barrier(0); } while (0)
#define ATT_PV(vbuf, PRE) do { const LAS unsigned char* vb_ = lds + 2 * KBUF + (vbuf) * VBUF; \
            if (!(PRE)) ATT_VRD(vfa, vb_, 0); \
            ATT_VRD(vfb, vb_, 1); __builtin_amdgcn_sched_barrier(0); ATT_VMM(vfa, 0); __builtin_amdgcn_sched_barrier(0); \
            ATT_VRD(vfa, vb_, 2); __builtin_amdgcn_sched_barrier(0); ATT_VMM(vfb, 1); __builtin_amdgcn_sched_barrier(0); \
            ATT_VRD(vfb, vb_, 3); __builtin_amdgcn_sched_barrier(0); ATT_VMM(vfa, 2); __builtin_amdgcn_sched_barrier(0); \
            ATT_VMM(vfb, 3); } while (0)
        const bool late = wid >= 4;
        u32x4 pw[4]; bf16x8 vfa[4], vfb[4];
#pragma unroll
        for (int i = 0; i < 4; ++i) pw[i] = (u32x4){0u, 0u, 0u, 0u};
        ATT_LOAD(0); ATT_STORE(0, 0); __syncthreads();
        int vprev = 2, vcur = 0, vnext = 1;
        for (int j = 0; j < NT; ++j) {
            const int cur = j & 1;
            if (j + 1 < NT) ATT_LOAD(j + 1);
            if (late && j > 0) ATT_PV(vprev, 0);
            const LAS unsigned char* kb_ = lds + cur * KBUF;
            f32x16 s[2];
#pragma unroll
            for (int kb = 0; kb < 2; ++kb) {
#pragma unroll
                for (int r = 0; r < 16; ++r) s[kb][r] = 0.f;
#pragma unroll
                for (int ks = 0; ks < 4; ++ks) { const bf16x8 kf = *(const LAS bf16x8*)(kb_ + (32 * kb + kappa) * KROW + mp * 128 + ks * 32 + hi * 16);
                    s[kb] = __builtin_amdgcn_mfma_f32_32x32x16_bf16(kf, qf[ks], s[kb], 0, 0, 0); }
            }
            if (!late) ATT_PV_PRE(vcur);
            float mx = s[0][0];
#pragma unroll
            for (int r = 1; r < 16; ++r) mx = fmaxf(mx, s[0][r]);
#pragma unroll
            for (int r = 0; r < 16; ++r) mx = fmaxf(mx, s[1][r]);
            mx = fmaxf(mx, xor32_get(mx, xaddr));
            const float mnew = fmaxf(mrun, mx);
            if (__any(mnew > mrun)) {
                const float alpha = __builtin_amdgcn_exp2f(mrun - mnew); lrun *= alpha;
#pragma unroll
                for (int d = 0; d < 4; ++d)
#pragma unroll
                    for (int r = 0; r < 16; ++r) o[d][r] *= alpha;
                mrun = mnew;
            }
            float psum = 0.f;
#pragma unroll
            for (int kb = 0; kb < 2; ++kb)
#pragma unroll
                for (int r = 0; r < 16; ++r) { const float pv = __builtin_amdgcn_exp2f(s[kb][r] - mrun); s[kb][r] = pv; psum += pv; }
            lrun += psum;
#pragma unroll
            for (int kb = 0; kb < 2; ++kb)
#pragma unroll
                for (int g = 0; g < 2; ++g) {
                    u32x4 w4; w4.x = pg8::cvt_pk_bf16(s[kb][8 * g + 0], s[kb][8 * g + 1]); w4.y = pg8::cvt_pk_bf16(s[kb][8 * g + 2], s[kb][8 * g + 3]);
                    w4.z = pg8::cvt_pk_bf16(s[kb][8 * g + 4], s[kb][8 * g + 5]); w4.w = pg8::cvt_pk_bf16(s[kb][8 * g + 6], s[kb][8 * g + 7]);
                    pw[2 * kb + g] = w4;
                }
            if (!late) ATT_PV(vcur, 1);
            if (j + 1 < NT) ATT_STORE(cur ^ 1, vnext);
            __syncthreads();
            { const int t_ = vprev; vprev = vcur; vcur = vnext; vnext = t_; }
        }
        if (late) ATT_PV(vprev, 0);
        __syncthreads();
#undef ATT_LOAD
#undef ATT_STORE
#undef ATT_PV
#undef ATT_PV_PRE
#undef ATT_VRD
#undef ATT_VMM
        const float ltot = lrun + xor32_get(lrun, xaddr); const float inv = 1.f / ltot;
        LAS float* xch = (LAS float*)lds + pr * 4096;
        if (mp == 1) { const float f = inv * lam;
#pragma unroll
            for (int d = 0; d < 4; ++d)
#pragma unroll
                for (int r = 0; r < 16; ++r) xch[(d * 16 + r) * 64 + lane] = o[d][r] * f; }
        __syncthreads();
        if (mp == 0) {
            float ss = 0.f;
#pragma unroll
            for (int d = 0; d < 4; ++d)
#pragma unroll
                for (int r = 0; r < 16; ++r) { const float dv = o[d][r] * inv - xch[(d * 16 + r) * 64 + lane]; o[d][r] = dv; ss += dv * dv; }
            ss += xor32_get(ss, xaddr);
            const float rn = (1.f / sqrtf(ss * (1.f / 128.f) + 1e-5f)) * 0.8f;
            bf16* orow = act + (size_t)(b * SEQ + qb * 128 + pr * 32 + r32) * DM + h * 128;
#pragma unroll
            for (int d = 0; d < 4; ++d)
#pragma unroll
                for (int j4 = 0; j4 < 4; ++j4) { const int dv0 = 32 * d + 8 * j4 + 4 * hi; const f32x4 g = *(const f32x4*)(subln + dv0);
                    u32x2 w; w.x = pk2(o[d][4 * j4 + 0] * rn * g.x, o[d][4 * j4 + 1] * rn * g.y); w.y = pk2(o[d][4 * j4 + 2] * rn * g.z, o[d][4 * j4 + 3] * rn * g.w);
                    *(u32x2*)(orow + dv0) = w; }
        }
        __syncthreads();
    }
}

__device__ __forceinline__ void sgu_phase(const LArgs& a, LAS unsigned char* lds) {
    const int tid = opaque_tid(), lane = tid & 63, wid = tid >> 6, r32 = lane & 31, hi = lane >> 5;
    constexpr int ROWB = 272;
    LAS unsigned char* WsB = lds; LAS unsigned char* VVt = lds + 128 * ROWB;
    const bf16* Ug = (const bf16*)(a.ws + WS_U); const bf16* Gg = (const bf16*)(a.ws + WS_G); bf16* act = (bf16*)(a.ws + WS_H);
    const bool same_g = (gridDim.x & 7) == 0;
    for (int u = blockIdx.x, first = 1; u < 2048; u += gridDim.x, first = 0) {
        const int g = u & 7, row0 = (u >> 3) * 128;
        if (first || !same_g) {
            const f32x4* wsrc = (const f32x4*)(a.in(I_ESW) + (size_t)g * 16384);
#pragma unroll
            for (int i = 0; i < 8; ++i) { const int idx = tid + NTHR * i; const f32x4 w = wsrc[idx]; const int pr_ = idx >> 5, q4 = (idx & 31) * 4;
                u32x2 pk; pk.x = pk2(w.x, w.y); pk.y = pk2(w.z, w.w); *(LAS u32x2*)(WsB + pr_ * ROWB + q4 * 2) = pk; }
        }
        const float ng0 = a.in(I_ESNG)[g * 128 + 2 * lane], ng1 = a.in(I_ESNG)[g * 128 + 2 * lane + 1], nb0 = a.in(I_ESNB)[g * 128 + 2 * lane], nb1 = a.in(I_ESNB)[g * 128 + 2 * lane + 1];
#pragma unroll
        for (int rr = 0; rr < 16; ++rr) {
            const int r = wid * 16 + rr; const unsigned pk = *(const unsigned*)(Gg + (size_t)(row0 + r) * 1024 + g * 128 + 2 * lane);
            const float x0 = bf2f(pk & 0xffffu), x1 = bf2f(pk >> 16);
            const float mean = wave_sum(x0 + x1) * (1.f / 128.f); const float d0 = x0 - mean, d1 = x1 - mean;
            const float rstd = 1.f / sqrtf(wave_sum(d0 * d0 + d1 * d1) * (1.f / 128.f) + 1e-5f);
            *(LAS bf16*)(VVt + (2 * lane) * ROWB + r * 2) = (bf16)f2bf(d0 * rstd * ng0 + nb0); *(LAS bf16*)(VVt + (2 * lane + 1) * ROWB + r * 2) = (bf16)f2bf(d1 * rstd * ng1 + nb1);
        }
        __syncthreads();
        const int cblk = wid >> 1;
        f32x16 acc[2];
#pragma unroll
        for (int i = 0; i < 2; ++i)
#pragma unroll
            for (int r = 0; r < 16; ++r) acc[i][r] = 0.f;
#pragma unroll
        for (int ks = 0; ks < 8; ++ks) {
            const bf16x8 af = *(const LAS bf16x8*)(VVt + (32 * cblk + r32) * ROWB + ks * 32 + hi * 16);
#pragma unroll
            for (int i = 0; i < 2; ++i) { const int pblk = (wid & 1) * 2 + i; const bf16x8 bfr = *(const LAS bf16x8*)(WsB + (32 * pblk + r32) * ROWB + ks * 32 + hi * 16);
                acc[i] = __builtin_amdgcn_mfma_f32_32x32x16_bf16(af, bfr, acc[i], 0, 0, 0); }
        }
#pragma unroll
        for (int i = 0; i < 2; ++i) {
            const int p = 32 * ((wid & 1) * 2 + i) + r32; const float bs = a.in(I_ESB)[g * 128 + p];
            const bf16* up = Ug + (size_t)(row0 + p) * 1024 + g * 128 + 32 * cblk + 4 * hi; bf16* op = act + (size_t)(row0 + p) * DM + 1024 + g * 128 + 32 * cblk + 4 * hi;
#pragma unroll
            for (int j4 = 0; j4 < 4; ++j4) {
                const u32x2 uu = *(const u32x2*)(up + 8 * j4);
                const f32x4 mix = {acc[i][4 * j4 + 0] + bs, acc[i][4 * j4 + 1] + bs, acc[i][4 * j4 + 2] + bs, acc[i][4 * j4 + 3] + bs};
                const f32x4 o = (f32x4){bf2f(uu.x & 0xffffu), bf2f(uu.x >> 16), bf2f(uu.y & 0xffffu), bf2f(uu.y >> 16)} * mix;
                u32x2 w; w.x = pk2(o.x, o.y); w.y = pk2(o.z, o.w); *(u32x2*)(op + 8 * j4) = w;
            }
        }
        __syncthreads();
    }
}

__device__ __forceinline__ void bfly_fwd(f32x2& x0, f32x2& x1, f32x2& x2, f32x2& x3, const f32x2 w1) {
    const f32x2 w2 = cmul(w1, w1);
    const f32x2 y0 = x0 + x2, y1 = x1 + x3, y2 = cmul(x0 - x2, w1), t = cmul(x1 - x3, w1); const f32x2 y3 = {t.y, -t.x};
    x0 = y0 + y1; x1 = cmul(y0 - y1, w2); x2 = y2 + y3; x3 = cmul(y2 - y3, w2);
}
__device__ __forceinline__ void bfly_inv(f32x2& x0, f32x2& x1, f32x2& x2, f32x2& x3, const f32x2 w2) {
    const f32x2 w = cmul(w2, w2);
    const f32x2 t1 = cmul(x1, w), t3 = cmul(x3, w);
    const f32x2 y0 = x0 + t1, y1 = x0 - t1, y2 = x2 + t3, y3 = x2 - t3;
    const f32x2 u2 = cmul(y2, w2), u3 = cmul(y3, w2); const f32x2 u3i = {-u3.y, u3.x};
    x0 = y0 + u2; x1 = y1 + u3i; x2 = y0 - u2; x3 = y1 - u3i;
}
__device__ __forceinline__ void fft_fwd(LAS f32x2* X, int tid) {
    const f32x2 R1 = {0.92387953251128674f, -0.38268343236508977f}, R2 = {0.70710678118654752f, -0.70710678118654752f}, R3 = {0.38268343236508977f, -0.92387953251128674f};
    for (int lgb = 10; lgb >= 2; lgb -= 4) {
        const int h = 1 << lgb; const float inv16h = 1.f / (float)(16 * h);
#pragma unroll 2
        for (int G = tid; G < 1024; G += NTHR) {
            const int j = G & (h - 1), base = ((G >> lgb) << (lgb + 4)) + j;
            f32x2 x[4][4];
#pragma unroll
            for (int a = 0; a < 4; ++a)
#pragma unroll
                for (int bb = 0; bb < 4; ++bb) x[a][bb] = X[base + a * 4 * h + bb * h];
            const float rev = (float)j * inv16h; const f32x2 wb = {__builtin_amdgcn_cosf(rev), -__builtin_amdgcn_sinf(rev)};
            bfly_fwd(x[0][0], x[1][0], x[2][0], x[3][0], wb);
            bfly_fwd(x[0][1], x[1][1], x[2][1], x[3][1], cmul(wb, R1));
            bfly_fwd(x[0][2], x[1][2], x[2][2], x[3][2], cmul(wb, R2));
            bfly_fwd(x[0][3], x[1][3], x[2][3], x[3][3], cmul(wb, R3));
            const f32x2 wb2 = cmul(wb, wb), wl = cmul(wb2, wb2);
#pragma unroll
            for (int a = 0; a < 4; ++a) bfly_fwd(x[a][0], x[a][1], x[a][2], x[a][3], wl);
#pragma unroll
            for (int a = 0; a < 4; ++a)
#pragma unroll
                for (int bb = 0; bb < 4; ++bb) X[base + a * 4 * h + bb * h] = x[a][bb];
        }
        __syncthreads();
    }
#pragma unroll 4
    for (int q = tid; q < 4096; q += NTHR) {
        const int i0 = 4 * q; f32x2 x0 = X[i0], x1 = X[i0 + 1], x2 = X[i0 + 2], x3 = X[i0 + 3];
        bfly_fwd(x0, x1, x2, x3, (f32x2){1.f, 0.f});
        X[i0] = x0; X[i0 + 1] = x1; X[i0 + 2] = x2; X[i0 + 3] = x3;
    }
    __syncthreads();
}
__device__ __forceinline__ void fft_inv(LAS f32x2* X, int tid) {
    const f32x2 R1 = {0.92387953251128674f, 0.38268343236508977f}, R2 = {0.70710678118654752f, 0.70710678118654752f}, R3 = {0.38268343236508977f, 0.92387953251128674f};
    for (int lga = 0; lga <= 8; lga += 4) {
        const int h = 1 << lga; const float inv16h = 1.f / (float)(16 * h);
#pragma unroll 2
        for (int G = tid; G < 1024; G += NTHR) {
            const int j = G & (h - 1), base = ((G >> lga) << (lga + 4)) + j;
            f32x2 x[4][4];
#pragma unroll
            for (int a = 0; a < 4; ++a)
#pragma unroll
                for (int bb = 0; bb < 4; ++bb) x[a][bb] = X[base + a * 4 * h + bb * h];
            const float rev = (float)j * inv16h; const f32x2 wb = {__builtin_amdgcn_cosf(rev), __builtin_amdgcn_sinf(rev)};
            const f32x2 wb2 = cmul(wb, wb), wl = cmul(wb2, wb2);
#pragma unroll
            for (int a = 0; a < 4; ++a) bfly_inv(x[a][0], x[a][1], x[a][2], x[a][3], wl);
            bfly_inv(x[0][0], x[1][0], x[2][0], x[3][0], wb);
            bfly_inv(x[0][1], x[1][1], x[2][1], x[3][1], cmul(wb, R1));
            bfly_inv(x[0][2], x[1][2], x[2][2], x[3][2], cmul(wb, R2));
            bfly_inv(x[0][3], x[1][3], x[2][3], x[3][3], cmul(wb, R3));
#pragma unroll
            for (int a = 0; a < 4; ++a)
#pragma unroll
                for (int bb = 0; bb < 4; ++bb) X[base + a * 4 * h + bb * h] = x[a][bb];
        }
        __syncthreads();
    }
#pragma unroll 4
    for (int q = tid; q < 4096; q += NTHR) {
        f32x2 x0 = X[q], x1 = X[q + 4096], x2 = X[q + 8192], x3 = X[q + 12288];
        const float rev = (float)q * (1.f / 16384.f);
        bfly_inv(x0, x1, x2, x3, (f32x2){__builtin_amdgcn_cosf(rev), __builtin_amdgcn_sinf(rev)});
        X[q] = x0; X[q + 4096] = x1; X[q + 8192] = x2; X[q + 12288] = x3;
    }
    __syncthreads();
}
__device__ __forceinline__ void pointwise_filter(const LAS f32x2* X, f32x4* Hs, float scale, int tid) {
#pragma unroll 2
    for (int s = tid; s < 8192; s += NTHR) {
        if (s == 0) { const f32x2 A = X[0], Cm = X[1]; Hs[0] = (f32x4){(A.x + A.y) * scale, (A.x - A.y) * scale, Cm.x * scale, -Cm.y * scale}; }
        else {
            const int i1 = 2 * s, i2 = i1 ^ ((1 << (31 - __clz(i1))) - 1); const int p = (int)(__brev((unsigned)i1) >> 18);
            const f32x2 A = X[i1], B = X[i2];
            const f32x2 E = {0.5f * (A.x + B.x), 0.5f * (A.y - B.y)}; const f32x2 Dm = {A.x - B.x, A.y + B.y}; const f32x2 O = {0.5f * Dm.y, -0.5f * Dm.x};
            const float rev = (float)p * (1.f / 32768.f); const float c = __builtin_amdgcn_cosf(rev), sn = __builtin_amdgcn_sinf(rev);
            const f32x2 WO = cmul((f32x2){c, -sn}, O);
            Hs[s] = (f32x4){(E.x + WO.x) * scale, (E.y + WO.y) * scale, (E.x - WO.x) * scale, -(E.y - WO.y) * scale};
        }
    }
    __syncthreads();
}
__device__ __forceinline__ void pointwise_data(LAS f32x2* X, const f32x4* Hs, int tid) {
#pragma unroll 4
    for (int s = tid; s < 8192; s += NTHR) {
        const f32x4 hh = Hs[s];
        if (s == 0) {
            const f32x2 A = X[0]; const float Y0 = (A.x + A.y) * hh.x, YM = (A.x - A.y) * hh.y; X[0] = (f32x2){0.5f * (Y0 + YM), 0.5f * (Y0 - YM)};
            const f32x2 Cm = X[1]; const f32x2 Y = cmul((f32x2){Cm.x, -Cm.y}, (f32x2){hh.z, hh.w}); X[1] = (f32x2){Y.x, -Y.y};
        } else {
            const int i1 = 2 * s, i2 = i1 ^ ((1 << (31 - __clz(i1))) - 1); const int p = (int)(__brev((unsigned)i1) >> 18);
            const f32x2 A = X[i1], B = X[i2];
            const f32x2 E = {0.5f * (A.x + B.x), 0.5f * (A.y - B.y)}; const f32x2 Dm = {A.x - B.x, A.y + B.y}; const f32x2 O = {0.5f * Dm.y, -0.5f * Dm.x};
            const float rev = (float)p * (1.f / 32768.f); const float c = __builtin_amdgcn_cosf(rev), sn = __builtin_amdgcn_sinf(rev);
            const f32x2 WO = cmul((f32x2){c, -sn}, O);
            const f32x2 Xk = E + WO; const f32x2 Xk2 = {E.x - WO.x, -(E.y - WO.y)};
            const f32x2 Yk = cmul(Xk, (f32x2){hh.x, hh.y}), Yk2 = cmul(Xk2, (f32x2){hh.z, hh.w});
            const f32x2 Ye = {0.5f * (Yk.x + Yk2.x), 0.5f * (Yk.y - Yk2.y)}; const f32x2 Dd = {Yk.x - Yk2.x, Yk.y + Yk2.y};
            const f32x2 Yo = cmul((f32x2){0.5f * c, 0.5f * sn}, Dd);
            X[i1] = (f32x2){Ye.x - Yo.y, Ye.y + Yo.x}; X[i2] = (f32x2){Ye.x + Yo.y, Yo.x - Ye.y};
        }
    }
    __syncthreads();
}
__device__ __forceinline__ void h8_to_f(const u32x4 raw, float* e) {
#pragma unroll
    for (int i = 0; i < 4; ++i) { const unsigned w = raw[i];
        e[2 * i] = (float)__builtin_bit_cast(_Float16, (unsigned short)(w & 0xffffu)); e[2 * i + 1] = (float)__builtin_bit_cast(_Float16, (unsigned short)(w >> 16)); }
}
struct Z10 { u32x4 raw; _Float16 zm, zp; };
__device__ __forceinline__ Z10 sconv8_load(const _Float16* z, int t0) {
    Z10 r; r.raw = *(const u32x4*)(z + t0); r.zm = z[t0 > 0 ? t0 - 1 : 0]; r.zp = z[t0 + 8 < SEQ ? t0 + 8 : SEQ - 1]; return r;
}
__device__ __forceinline__ void sconv8_calc(const Z10& r, int t0, float w0, float w1, float w2, float bias, float* y) {
    float e[10]; e[0] = t0 > 0 ? (float)r.zm : 0.f; e[9] = (t0 + 8 < SEQ) ? (float)r.zp : 0.f; h8_to_f(r.raw, e + 1);
#pragma unroll
    for (int i = 0; i < 8; ++i) y[i] = bias + w0 * e[i] + w1 * e[i + 1] + w2 * e[i + 2];
}
constexpr size_t HY_WG_BYTES = 262144 + 65536;
__device__ __forceinline__ void hyena_phase(const LArgs& a, LAS unsigned char* lds) {
    const int tid0 = opaque_tid(), lane = tid0 & 63, wid = tid0 >> 6;
    LAS f32x2* X = (LAS f32x2*)lds; LAS float* red = (LAS float*)(lds + 131072);
    const _Float16* ZT = (const _Float16*)(a.ws + WS_OV); const _Float16* KT = (const _Float16*)a.out;
    bf16* YT = (bf16*)(a.ws + WS_H);
    f32x4* Hs = (f32x4*)(a.ws + WS_HYSCR + (size_t)blockIdx.x * HY_WG_BYTES); f32x4* Ys = Hs + 16384;
    const float* cw = a.in(I_OCW); const float* cb = a.in(I_OCB);
    for (int c = blockIdx.x; c < 2048; c += gridDim.x) {
        int tid = tid0; asm volatile("" : "+v"(tid));
        const float dkc = -__builtin_fabsf(MIN_DECAY_F + (float)c * ((MAX_DECAY_F - MIN_DECAY_F) / 2047.f)) * (1.4426950408889634f / 16383.f);
        for (int n = 0; n < 2; ++n) {
            const _Float16* fw = KT + (size_t)(n * 4096 + c) * SEQ; const _Float16* bw = KT + (size_t)(n * 4096 + 2048 + c) * SEQ;
            float l1 = 0.f;
            u32x4 rf[4], rb[4]; _Float16 rt[4];
#pragma unroll
            for (int j = 0; j < 4; ++j) { const int mm0 = 4 * (tid + NTHR * j); rf[j] = *(const u32x4*)(fw + 2 * mm0); rb[j] = *(const u32x4*)(bw + 16376 - 2 * mm0); rt[j] = bw[mm0 > 0 ? 16384 - 2 * mm0 : 16383]; }
#pragma unroll
            for (int j = 0; j < 4; ++j) {
                const int mm0 = 4 * (tid + NTHR * j);
                float e[8], cc[8]; h8_to_f(rf[j], e); h8_to_f(rb[j], cc);
                float top = mm0 > 0 ? (float)rt[j] : 0.f;
                {
                    const float tf = (float)(2 * mm0), tb = (float)(16376 - 2 * mm0);
#pragma unroll
                    for (int i = 0; i < 8; ++i) { e[i] *= __builtin_amdgcn_exp2f(dkc * (tf + (float)i)); cc[i] *= __builtin_amdgcn_exp2f(dkc * (tb + (float)i)); }
                    top *= __builtin_amdgcn_exp2f(dkc * (tb + 8.f));
                }
#pragma unroll
                for (int i = 0; i < 8; ++i) l1 += __builtin_fabsf(e[i]);
#pragma unroll
                for (int i = 1; i < 8; ++i) l1 += __builtin_fabsf(cc[i]);
                l1 += __builtin_fabsf(top);
                *(LAS f32x4*)(X + mm0) = (f32x4){e[0], e[1], e[2], e[3]}; *(LAS f32x4*)(X + mm0 + 2) = (f32x4){e[4], e[5], e[6], e[7]};
                *(LAS f32x4*)(X + 8192 + mm0) = (f32x4){top, cc[7], cc[6], cc[5]}; *(LAS f32x4*)(X + 8192 + mm0 + 2) = (f32x4){cc[4], cc[3], cc[2], cc[1]};
            }
            l1 = wave_sum(l1); if (lane == 0) red[wid] = l1;
            __syncthreads();
            float tot = 0.f;
#pragma unroll
            for (int w = 0; w < NWAVES; ++w) tot += red[w];
            fft_fwd(X, tid);
            pointwise_filter(X, Hs + n * 8192, 1.f / (16384.f * tot), tid);
        }
        const float w00 = cw[c], w01 = cw[HY_IN + c], w02 = cw[2 * HY_IN + c], b0 = cb[c];
        const float w10 = cw[2048 + c], w11 = cw[HY_IN + 2048 + c], w12 = cw[2 * HY_IN + 2048 + c], b1 = cb[2048 + c];
        const float w20 = cw[4096 + c], w21 = cw[HY_IN + 4096 + c], w22 = cw[2 * HY_IN + 4096 + c], b2 = cb[4096 + c];
        const float fb0 = a.in(I_FBIAS)[c], fb1 = a.in(I_FBIAS)[2048 + c];
        for (int b = 0; b < NB; ++b) {
            const _Float16* zv = ZT + (size_t)c * MLAT + b * SEQ; const _Float16* zx1 = ZT + (size_t)(2048 + c) * MLAT + b * SEQ; const _Float16* zx2 = ZT + (size_t)(4096 + c) * MLAT + b * SEQ;
            {
                Z10 zr[4];
#pragma unroll
                for (int j = 0; j < 4; ++j) zr[j] = sconv8_load(zv, 8 * (tid + NTHR * j));
#pragma unroll
                for (int j = 0; j < 4; ++j) { const int mm0 = 4 * (tid + NTHR * j); float y[8]; sconv8_calc(zr[j], 2 * mm0, w00, w01, w02, b0, y);
                    *(LAS f32x4*)(X + mm0) = (f32x4){y[0], y[1], y[2], y[3]}; *(LAS f32x4*)(X + mm0 + 2) = (f32x4){y[4], y[5], y[6], y[7]};
                    *(LAS f32x4*)(X + 8192 + mm0) = (f32x4){0.f, 0.f, 0.f, 0.f}; *(LAS f32x4*)(X + 8192 + mm0 + 2) = (f32x4){0.f, 0.f, 0.f, 0.f}; }
            }
            __syncthreads();
            fft_fwd(X, tid); pointwise_data(X, Hs, tid); fft_inv(X, tid);
            Z10 za[4], zb[4];
#pragma unroll
            for (int j = 0; j < 4; ++j) { za[j] = sconv8_load(zv, 8 * (tid + NTHR * j)); zb[j] = sconv8_load(zx1, 8 * (tid + NTHR * j)); }
#pragma unroll
            for (int j = 0; j < 4; ++j) { const int mm0 = 4 * (tid + NTHR * j); float y0[8], g[8]; sconv8_calc(za[j], 2 * mm0, w00, w01, w02, b0, y0); sconv8_calc(zb[j], 2 * mm0, w10, w11, w12, b1, g);
                const f32x4 r0 = *(const LAS f32x4*)(X + mm0), r1 = *(const LAS f32x4*)(X + mm0 + 2);
                const f32x4 o0 = (f32x4){g[0], g[1], g[2], g[3]} * (r0 + (f32x4){y0[0], y0[1], y0[2], y0[3]} * fb0), o1 = (f32x4){g[4], g[5], g[6], g[7]} * (r1 + (f32x4){y0[4], y0[5], y0[6], y0[7]} * fb0);
                *(LAS f32x4*)(X + mm0) = o0; *(LAS f32x4*)(X + mm0 + 2) = o1; Ys[mm0 / 2] = o0; Ys[mm0 / 2 + 1] = o1;
                *(LAS f32x4*)(X + 8192 + mm0) = (f32x4){0.f, 0.f, 0.f, 0.f}; *(LAS f32x4*)(X + 8192 + mm0 + 2) = (f32x4){0.f, 0.f, 0.f, 0.f}; }
            __syncthreads();
            fft_fwd(X, tid); pointwise_data(X, Hs + 8192, tid); fft_inv(X, tid);
#pragma unroll
            for (int j = 0; j < 4; ++j) za[j] = sconv8_load(zx2, 8 * (tid + NTHR * j));
            f32x4 qv[4][2];
#pragma unroll
            for (int j = 0; j < 4; ++j) { const int mm0 = 4 * (tid + NTHR * j); qv[j][0] = Ys[mm0 / 2]; qv[j][1] = Ys[mm0 / 2 + 1]; }
#pragma unroll
            for (int j = 0; j < 4; ++j) { const int mm0 = 4 * (tid + NTHR * j); float g[8]; sconv8_calc(za[j], 2 * mm0, w20, w21, w22, b2, g);
                const f32x4 r0 = *(const LAS f32x4*)(X + mm0), r1 = *(const LAS f32x4*)(X + mm0 + 2);
                const f32x4 o0 = (f32x4){g[0], g[1], g[2], g[3]} * (r0 + qv[j][0] * fb1), o1 = (f32x4){g[4], g[5], g[6], g[7]} * (r1 + qv[j][1] * fb1);
                u32x4 w; w.x = pk2(o0.x, o0.y); w.y = pk2(o0.z, o0.w); w.z = pk2(o1.x, o1.y); w.w = pk2(o1.z, o1.w);
                *(u32x4*)(YT + (size_t)c * MLAT + b * SEQ + 2 * mm0) = w; }
            __syncthreads();
        }
    }
}
__device__ __forceinline__ void transpose_phase(const LArgs& a, LAS unsigned char* lds) {
    const int tid = opaque_tid(), lane = tid & 63, wid = tid >> 6, gw = blockIdx.x * NWAVES + wid, NGW = gridDim.x * NWAVES;
    const bf16* YT = (const bf16*)(a.ws + WS_H); bf16* Y = (bf16*)(a.ws + WS_OV);
    LAS bf16* T = (LAS bf16*)(lds + wid * 16384);
    for (int it = gw; it < 32 * 512; it += NGW) {
        const int c0 = (it & 31) * 64, t0 = (it >> 5) * 64;
#pragma unroll
        for (int i = 0; i < 8; ++i) { const int ch = 8 * i + (lane >> 3), k = lane & 7; *(LAS u32x4*)(T + ch * 72 + 8 * k) = *(const u32x4*)(YT + (size_t)(c0 + ch) * MLAT + t0 + 8 * k); }
        asm volatile("s_waitcnt vmcnt(0) lgkmcnt(0)" ::: "memory");
#pragma unroll
        for (int i = 0; i < 8; ++i) { const int t = 8 * i + (lane >> 3), k = lane & 7; unsigned short e[8];
#pragma unroll
            for (int q = 0; q < 8; ++q) e[q] = T[(8 * k + q) * 72 + t];
            u32x4 w; w.x = e[0] | ((unsigned)e[1] << 16); w.y = e[2] | ((unsigned)e[3] << 16); w.z = e[4] | ((unsigned)e[5] << 16); w.w = e[6] | ((unsigned)e[7] << 16);
            *(u32x4*)(Y + (size_t)(t0 + t) * DM + c0 + 8 * k) = w; }
        asm volatile("s_waitcnt lgkmcnt(0)" ::: "memory");
    }
}

#define XB_TMO      128
#define XB_XCNT(j)  (256  + 64 * (j))
#define XB_XSUB(j)  (1280 + 64 * (j))
#define XB_XGEN(j)  (2304 + 64 * (j))
#define XB_TOP      3328
#define XB_TOPGEN   3392
#define XCD_BAR_WORDS 3456
#define XB_SPIN_CAP (1u << 18)

__device__ __forceinline__ unsigned xb_ld(unsigned* p)              { return __hip_atomic_load(p, __ATOMIC_RELAXED, __HIP_MEMORY_SCOPE_AGENT); }
__device__ __forceinline__ unsigned xb_add(unsigned* p, unsigned v) { return __hip_atomic_fetch_add(p, v, __ATOMIC_RELAXED, __HIP_MEMORY_SCOPE_AGENT); }
__device__ __forceinline__ unsigned xb_xcc_id() { return (unsigned)__builtin_amdgcn_s_getreg((3 << 11) | 20) & 0xFu; }
#define XB_SPIN(cond, bar) do { unsigned _sp = 0; while (cond) { __builtin_amdgcn_s_sleep(1); \
    if ((++_sp & 255u) == 0u) { if (xb_ld(&(bar)[XB_TMO])) break; if (_sp > XB_SPIN_CAP) { atomicAdd(&(bar)[XB_TMO], 1u); break; } } } } while (0)

struct XcdBarrier {
    unsigned* bar; unsigned x;
    volatile LAS unsigned* st;
};

__device__ __forceinline__ XcdBarrier xcd_barrier_post(unsigned* bar, volatile LAS unsigned* st) {
    XcdBarrier b; b.bar = bar; b.x = xb_xcc_id(); b.st = st;
    if (threadIdx.x == 0) (void)xb_add(&bar[XB_XCNT(b.x)], 1u);
    return b;
}
__device__ __forceinline__ void xcd_barrier_complete(unsigned* bar, unsigned x, unsigned& nloc, unsigned& nx) {
    const unsigned G = gridDim.x * gridDim.y * gridDim.z;
    unsigned sum, cnt, mine, sp = 0u;
    for (;;) {
        sum = 0u; cnt = 0u; mine = 0u;
#pragma unroll
        for (unsigned j = 0; j < 16; ++j) { const unsigned c = xb_ld(&bar[XB_XCNT(j)]); sum += c; cnt += (c > 0u) ? 1u : 0u; mine = (j == x) ? c : mine; }
        if (sum == G) break;
        __builtin_amdgcn_s_sleep(1);
        if ((++sp & 255u) == 0u) { if (xb_ld(&bar[XB_TMO])) break; if (sp > XB_SPIN_CAP) { atomicAdd(&bar[XB_TMO], 1u); break; } }
    }
    nloc = mine > 0u ? mine : 1u; nx = cnt > 0u ? cnt : 1u;
}

__device__ __forceinline__ void xcd_barrier(const XcdBarrier& b) {
    asm volatile("s_waitcnt vmcnt(0)" ::: "memory");
    __syncthreads();
    if (threadIdx.x == 0) {
        unsigned* bar = b.bar;
        __builtin_amdgcn_s_waitcnt(0);
        unsigned nloc = b.st[0], nx = b.st[1];
        if (nloc == 0u) { xcd_barrier_complete(bar, b.x, nloc, nx); b.st[0] = nloc; b.st[1] = nx; }
        const unsigned old = xb_add(&bar[XB_XSUB(b.x)], 1u);
        const unsigned gen = old / nloc;
        if (old + 1u == (gen + 1u) * nloc) {
            __builtin_amdgcn_fence(__ATOMIC_RELEASE, "agent");
            asm volatile("s_waitcnt vmcnt(0)" ::: "memory");
            const unsigned og = xb_add(&bar[XB_TOP], 1u);
            const unsigned tg = og / nx;
            if (og + 1u == (tg + 1u) * nx) xb_add(&bar[XB_TOPGEN], 1u);
            else XB_SPIN(xb_ld(&bar[XB_TOPGEN]) == tg, bar);
            __builtin_amdgcn_fence(__ATOMIC_ACQUIRE, "agent");
            xb_add(&bar[XB_XGEN(b.x)], 1u);
            asm volatile("s_waitcnt vmcnt(0)" ::: "memory");
        } else {
            XB_SPIN(xb_ld(&bar[XB_XGEN(b.x)]) == gen, bar);
            __builtin_amdgcn_fence(__ATOMIC_ACQUIRE, "agent");
            asm volatile("s_waitcnt vmcnt(0)" ::: "memory");
        }
    }
    __syncthreads();
}

constexpr size_t WS_BAR = 524288;
constexpr int XB_LDS_OFF = TAB_OFF + 512;
#ifndef GU_WGM
#define GU_WGM 8
#endif
#ifndef ZT_WGM
#define ZT_WGM 2
#endif
#ifndef VT_WGM
#define VT_WGM 2
#endif
#ifndef RS_WGM
#define RS_WGM 1
#endif
constexpr int N_PHASES = 20;
constexpr unsigned SYNC_AFTER = 0xFFFFFu & ~((1u << 2) | (1u << 3) | (1u << 5) | (1u << 19));
#ifndef PHSEL
#define PHSEL 0xfffff
#endif
#define PHON(k) ((PHSEL >> (k)) & 1)
__global__ void __launch_bounds__(NTHR, 2) mega_fwd(Args a_in) {
    extern __shared__ __attribute__((aligned(16))) unsigned char lds[];
    PG8_LAS unsigned char* ldsl = (PG8_LAS unsigned char*)lds;
    const int G = gridDim.x, cid = blockIdx.x;
    LAS unsigned long long* tab = (LAS unsigned long long*)(ldsl + TAB_OFF);
    if (threadIdx.x == 0) {
#pragma unroll
        for (int i = 0; i < 33; ++i) tab[i] = (unsigned long long)a_in.in[i];
        tab[33] = (unsigned long long)a_in.out; tab[34] = (unsigned long long)a_in.ws;
    }
    if (threadIdx.x == 0) { ((LAS unsigned*)(ldsl + XB_LDS_OFF))[0] = 0u; ((LAS unsigned*)(ldsl + XB_LDS_OFF))[1] = 0u; }
    __syncthreads();
    const int ph_lo = a_in.ph_lo, ph_hi = a_in.ph_hi;
    (void)xcd_barrier_post((unsigned*)(a_in.ws + WS_BAR), (volatile LAS unsigned*)(ldsl + XB_LDS_OFF));
#ifndef REPEAT_MASK
#define REPEAT_MASK 0
#endif
    for (int ph2 = 2 * ph_lo; ph2 < 2 * ph_hi; ++ph2) {
        const int ph = ph2 >> 1;
        if ((ph2 & 1) && !((REPEAT_MASK >> ph) & 1)) continue;
        const bool last_pass = (ph2 & 1) || !((REPEAT_MASK >> ph) & 1);
        unsigned tab_off = TAB_OFF; asm volatile("" : "+s"(tab_off) :: "memory");
        const LAS unsigned long long* tabl = (const LAS unsigned long long*)(ldsl + tab_off);
        const LArgs a{tabl, (float*)(__attribute__((address_space(1))) float*)tab_ld(tabl, 33), (unsigned char*)(__attribute__((address_space(1))) unsigned char*)tab_ld(tabl, 34)};
        unsigned char* ws = a.ws;
        const float* mods = (const float*)(ws + WS_MODS);
        const int layer = ph >= 11 ? 1 : 0;
        const float* modsL = mods + (size_t)layer * 3 * 12288;
        switch (ph) {
        case 0: if (PHON(0)) p0_prologue(a, ldsl); break;
        case 1: if (PHON(1)) prenorm_rows<0>(a, MALL, a.in(I_NORM1), modsL, 0, (bf16*)(ws + WS_H)); break;
        case 2: if (PHON(2)) {
            {
                pg8::Gemm g{(const bf16*)(ws + WS_H), (const bf16*)(ws + WS_WIN), MALL, 1024, 2048};
                pg8::EpiIn0 E; E.out0 = (bf16*)(ws + WS_K); E.grp_stride = 0; E.scale0 = 1.f; E.lat0 = MCTX;
                pg8::StaticOrder S; S.init(g.M, g.N, G, cid);
                pg8::gemm_phase<pg8::EpiIn0, pg8::StaticOrder, true, true>(ldsl, g, S, E);
            }
            {
                pg8::Gemm g{(const bf16*)(ws + WS_H) + (size_t)MCTX * DM, (const bf16*)(ws + WS_WIN) + (size_t)2048 * DM, MLAT, 3072, 2048};
                pg8::EpiIn0 E; E.out0 = (bf16*)(ws + WS_Q); E.grp_stride = (WS_U - WS_Q) / 2; E.scale0 = 0.125f * 1.4426950408889634f; E.lat0 = 0;
                pg8::StaticOrder S; S.init(g.M, g.N, G, cid);
                pg8::gemm_phase<pg8::EpiIn0, pg8::StaticOrder, true, true>(ldsl, g, S, E);
            }
        } break;
        case 3: if (PHON(3)) {
            pg8::Gemm g{(const bf16*)(ws + WS_WIN) + (size_t)1024 * DM, (const bf16*)(ws + WS_H), 1024, MALL, 2048}; pg8::EpiPlain16<0> E; E.O = (bf16*)(ws + WS_VT); E.ldc = MALL;
            pg8::StaticOrder S; S.init(g.M, g.N, G, (cid + G / 2) % G, VT_WGM);
            pg8::gemm_phase<pg8::EpiPlain16<0>, pg8::StaticOrder, true, true>(ldsl, g, S, E);
        } break;
        case 4: if (PHON(4)) {
            pg8::Gemm g{(const bf16*)(ws + WS_W4X), (const bf16*)(ws + WS_H3X), 8192, SEQ, 256}; pg8::EpiPlain16<1> E; E.O = (bf16*)a.out; E.ldc = SEQ;
            pg8::StaticOrder S; S.init(g.M, g.N, G, cid);
            pg8::gemm_phase<pg8::EpiPlain16<1>, pg8::StaticOrder, true, true>(ldsl, g, S, E);
        } break;
        case 5: if (PHON(5)) attn_phase(a, ldsl); break;
        case 6: if (PHON(6)) sgu_phase(a, ldsl); break;
        case 7: case 10: case 15: case 18: if (PHON(7)) {
            pg8::Gemm g; pg8::EpiResid E; E.gate_bstride = 12288; E.out = (float*)(ws + WS_X);
            if (ph == 7) { g = pg8::Gemm{(const bf16*)(ws + WS_H), (const bf16*)(ws + WS_WOUT0), MLAT, 2048, 2048}; E.base = a.in(I_X); E.gate = modsL + 2 * 2048; }
            else if (ph == 15) { g = pg8::Gemm{(const bf16*)(ws + WS_OV), (const bf16*)(ws + WS_OOUT), MLAT, 2048, 2048}; E.base = (const float*)(ws + WS_X); E.gate = modsL + 2 * 2048; }
            else { g = pg8::Gemm{(const bf16*)(ws + WS_OV), (const bf16*)(ws + (layer ? WS_WD1 : WS_WD0)), MLAT, 2048, DFF}; E.base = (const float*)(ws + WS_X); E.gate = modsL + 5 * 2048; }
            pg8::StaticOrder S; S.init(g.M, g.N, G, cid, RS_WGM);
            pg8::gemm_phase<pg8::EpiResid, pg8::StaticOrder, true, true>(ldsl, g, S, E);
        } break;
        case 8: case 16: if (PHON(8)) prenorm_rows<1>(a, MLAT, a.in(I_NORM2) + layer * DM, modsL, 3, (bf16*)(ws + WS_H)); break;
        case 9: case 17: if (PHON(9)) {
            pg8::Gemm g{(const bf16*)(ws + WS_H), (const bf16*)(ws + (layer ? WS_WGU1 : WS_WGU0)), MLAT, 2 * DFF, 2048}; pg8::EpiSwiglu E; E.O = (bf16*)(ws + WS_OV);
            pg8::StaticOrder S; S.init(g.M, g.N, G, cid, GU_WGM);
            pg8::gemm_phase<pg8::EpiSwiglu, pg8::StaticOrder, true, true>(ldsl, g, S, E);
        } break;
        case 11: if (PHON(11)) prenorm_rows<1>(a, MLAT, a.in(I_NORM1) + DM, modsL, 0, (bf16*)(ws + WS_H)); break;
        case 12: if (PHON(12)) {
            pg8::Gemm g{(const bf16*)(ws + WS_OIN), (const bf16*)(ws + WS_H), HY_IN, MLAT, 2048}; pg8::EpiPlain16<1> E; E.O = (bf16*)(ws + WS_OV); E.ldc = MLAT;
            pg8::StaticOrder S; S.init(g.M, g.N, G, cid, ZT_WGM);
            pg8::gemm_phase<pg8::EpiPlain16<1>, pg8::StaticOrder, true, true>(ldsl, g, S, E);
        } break;
        case 13: if (PHON(13)) hyena_phase(a, ldsl); break;
        case 14: if (PHON(14)) transpose_phase(a, ldsl); break;
        case 19: if (PHON(19)) final_norm_rows(a); break;
        default: break;
        }
        if (ph + 1 < ph_hi && (((SYNC_AFTER >> ph) & 1u) || !last_pass)) { if (ph == 0) cg::this_grid().sync();
            else { XcdBarrier xb; xb.bar = (unsigned*)(a.ws + WS_BAR); xb.x = xb_xcc_id(); xb.st = (volatile LAS unsigned*)(ldsl + XB_LDS_OFF); xcd_barrier(xb); } }
        else if (ph + 1 < ph_hi) __syncthreads();
    }
}

extern "C" void kernel_launch(void* const* d_in, const int* in_sizes, int n_in, void* d_out, int out_size, void* d_ws, size_t ws_size, hipStream_t stream) {
    static int grid = 0;
    if (grid == 0) {
        if (n_in != 33 || out_size != MLAT * DM || ws_size < WS_END) { fprintf(stderr, "kernel_launch: unexpected shapes (n_in %d, out %d, ws %zu)\n", n_in, out_size, ws_size); grid = -1; return; }
        int dev = 0, cus = 0, per_cu = 0;
        hipGetDevice(&dev); hipDeviceGetAttribute(&cus, hipDeviceAttributeMultiprocessorCount, dev);
        hipFuncSetAttribute((const void*)mega_fwd, hipFuncAttributeMaxDynamicSharedMemorySize, LDS_BYTES);
        if (hipOccupancyMaxActiveBlocksPerMultiprocessor(&per_cu, (const void*)mega_fwd, NTHR, LDS_BYTES) != hipSuccess || per_cu < 1) per_cu = 1;
        (void)hipGetLastError();
        grid = cus * per_cu;
    }
    if (grid < 0) return;
    hipMemsetAsync(d_ws, 0, 1 * MiB, stream);
    Args a{};
    for (int i = 0; i < 33; ++i) a.in[i] = (const float*)d_in[i];
    a.out = (float*)d_out; a.ws = (unsigned char*)d_ws;
#if N_LAUNCH_MODE == 1
    a.ph_lo = 0; a.ph_hi = N_PHASES;
    void* args[] = {&a};
    hipError_t e = hipLaunchCooperativeKernel((const void*)mega_fwd, dim3(grid), dim3(NTHR), args, LDS_BYTES, stream);
    if (e != hipSuccess) fprintf(stderr, "cooperative launch failed: %s (grid %d)\n", hipGetErrorString(e), grid);
#else
    for (int ph = 0; ph < N_PHASES; ++ph) { a.ph_lo = ph; a.ph_hi = ph + 1; hipLaunchKernelGGL(mega_fwd, dim3(grid), dim3(NTHR), LDS_BYTES, stream, a); }
#endif
}
```
